# Optimizing an MI355X kernel written in HIP

```python
import math
import jax, jax.numpy as jnp
from jax import lax
import numpy as np

D_MODEL = 1024
BATCH = 8
SEQ = 8192
DEPTH = 2

N_MIXERS = 2
N_A_LAYERS = (DEPTH + 1) // 2
N_B_LAYERS = DEPTH // 2

DIL_CONFIGS = ((128, 1), (512, 4), (2048, 16))
N_GROUPS = len(DIL_CONFIGS)
A_HEADS = 8
A_HEAD_DIM = 128
A_WIDTH = A_HEADS * A_HEAD_DIM
A_QKV_COLS = 3 * N_GROUPS * A_WIDTH

B_HEADS = 8
Q_LORA = 256
KV_LORA = 128
NOPE_DIM = 128
ROPE_DIM = 64
V_DIM = 128
QK_DIM = NOPE_DIM + ROPE_DIM
B_IN_COLS = Q_LORA + KV_LORA + ROPE_DIM

D_FF = 4 * D_MODEL

ROPE_THETA = 10000.0
EPS = 1e-6
Q_BLOCK = 128
NEG_FILL = -1e30

kernel_name = "hybrid_dilated_mla_encoder"


def rms_norm(x, gain):
    xf = x.astype(jnp.float32)
    y = xf * lax.rsqrt(jnp.mean(xf * xf, axis=-1, keepdims=True) + EPS)
    return (y * gain.astype(jnp.float32)).astype(x.dtype)


def rope(x, seq_len):
    d = x.shape[-1]
    pos = jnp.arange(seq_len, dtype=jnp.float32)
    freqs = ROPE_THETA ** (-jnp.arange(0, d, 2, dtype=jnp.float32) / d)
    ang = pos[:, None] * freqs[None, :]
    cos = jnp.concatenate([jnp.cos(ang), jnp.cos(ang)], -1)[:, None, :]
    sin = jnp.concatenate([jnp.sin(ang), jnp.sin(ang)], -1)[:, None, :]
    xf = x.astype(jnp.float32)
    x1, x2 = xf[..., : d // 2], xf[..., d // 2:]
    rot = jnp.concatenate([-x2, x1], -1)
    return (xf * cos + rot * sin).astype(x.dtype)


def dilated_group(q, k, v, window, dilation):
    B, S, H, dh = q.shape
    half = window // (2 * dilation)
    span = dilation * half
    s_pad = -(-S // span) * span
    L = s_pad // dilation
    nb = L // half
    scale = 1.0 / math.sqrt(dh)

    def strided(t, extra):
        t = jnp.pad(t, ((0, 0), (0, s_pad - S), (0, 0), (0, 0))).reshape(B, L, dilation, H, dh)
        return jnp.pad(t, ((0, 0), (extra, extra), (0, 0), (0, 0), (0, 0)))

    qs = strided(q, 0).reshape(B, nb, half, dilation, H, dh).transpose(1, 0, 2, 3, 4, 5)
    ks = strided(k, half)
    vs = strided(v, half)
    qi = jnp.arange(half)[:, None]
    kj = jnp.arange(3 * half)[None, :]
    res = jnp.arange(dilation)[:, None, None]
    band = jnp.abs(qi + half - kj) <= half

    def block(args):
        n, qb = args
        kb = lax.dynamic_slice_in_dim(ks, n * half, 3 * half, axis=1)
        vb = lax.dynamic_slice_in_dim(vs, n * half, 3 * half, axis=1)
        m_k = (n - 1) * half + kj
        pos_k = m_k[None] * dilation + res
        valid = band[None] & (m_k[None] >= 0) & (pos_k < S)
        s = jnp.einsum('bqchd,bkchd->bchqk', qb, kb).astype(jnp.float32) * scale
        s = jnp.where(valid[None, :, None], s, NEG_FILL)
        mx = jnp.max(s, axis=-1, keepdims=True)
        p = jnp.exp(s - mx)
        den = jnp.sum(p, axis=-1)
        o = jnp.einsum('bchqk,bkchd->bqchd', p.astype(vb.dtype), vb).astype(jnp.float32)
        o = o / den.transpose(0, 3, 1, 2)[..., None]
        lse = (mx[..., 0] + jnp.log(den)).transpose(0, 3, 1, 2)
        return o, lse

    o, lse = lax.map(block, (jnp.arange(nb), qs))
    o = o.transpose(1, 0, 2, 3, 4, 5).reshape(B, s_pad, H, dh)[:, :S]
    lse = lse.transpose(1, 0, 2, 3, 4).reshape(B, s_pad, H)[:, :S]
    return o, lse


def dilated_mixer(h, w_qkv, q_gain, k_gain, w_o):
    B, S, _ = h.shape
    qkv = (h @ w_qkv).reshape(B, S, 3, N_GROUPS, A_HEADS, A_HEAD_DIM)
    outs, lses = [], []
    for g, (window, dil) in enumerate(DIL_CONFIGS):
        q = rope(rms_norm(qkv[:, :, 0, g], q_gain[g]), S)
        k = rope(rms_norm(qkv[:, :, 1, g], k_gain[g]), S)
        v = qkv[:, :, 2, g]
        o, lse = dilated_group(q, k, v, window, dil)
        outs.append(o)
        lses.append(lse)
    wts = jax.nn.softmax(jnp.stack(lses, 0), axis=0)
    o = wts[0][..., None] * outs[0]
    for g in range(1, N_GROUPS):
        o = o + wts[g][..., None] * outs[g]
    return o.reshape(B, S, A_WIDTH).astype(h.dtype) @ w_o


def mla_mixer(h, w_in, q_a_gain, w_qb, kv_a_gain, w_kvb, q_gain, k_gain, w_o):
    B, S, _ = h.shape
    lat = h @ w_in
    c_q = lat[..., :Q_LORA]
    c_kv = lat[..., Q_LORA:Q_LORA + KV_LORA]
    k_rope = lat[..., Q_LORA + KV_LORA:]
    q = (rms_norm(c_q, q_a_gain) @ w_qb).reshape(B, S, B_HEADS, QK_DIM)
    kv = (rms_norm(c_kv, kv_a_gain) @ w_kvb).reshape(B, S, B_HEADS, NOPE_DIM + V_DIM)
    k_nope, v = kv[..., :NOPE_DIM], kv[..., NOPE_DIM:]
    k = jnp.concatenate(
        [k_nope, jnp.broadcast_to(k_rope[:, :, None, :], (B, S, B_HEADS, ROPE_DIM))], -1)
    q = rms_norm(q, q_gain)
    k = rms_norm(k, k_gain)
    q = jnp.concatenate([q[..., :NOPE_DIM], rope(q[..., NOPE_DIM:], S)], -1)
    k = jnp.concatenate([k[..., :NOPE_DIM], rope(k[..., NOPE_DIM:], S)], -1)
    scale = 1.0 / math.sqrt(QK_DIM)
    nblk = S // Q_BLOCK
    qb = q.reshape(B, nblk, Q_BLOCK, B_HEADS, QK_DIM).transpose(1, 0, 2, 3, 4)

    def attend(qblk):
        s = jnp.einsum('bqhd,bkhd->bhqk', qblk, k).astype(jnp.float32) * scale
        p = jax.nn.softmax(s, axis=-1)
        return jnp.einsum('bhqk,bkhd->bqhd', p.astype(v.dtype), v)

    o = lax.map(attend, qb)
    o = o.transpose(1, 0, 2, 3, 4).reshape(B, S, B_HEADS * V_DIM)
    return o @ w_o


def sq_relu_mlp(h, w1, w2):
    a = jax.nn.relu(h @ w1)
    return (a * a) @ w2


def setup_inputs(seed: int = 0) -> dict:
    key = jax.random.key(seed)
    ks = jax.random.split(key, 16)

    def w(k, shape, fan_in):
        return jax.random.normal(k, shape, jnp.float32) * (fan_in ** -0.5)

    def gain(k, shape):
        return 1.0 + 0.05 * jax.random.normal(k, shape, jnp.float32)

    return {
        "x": jax.random.normal(ks[0], (BATCH, SEQ, D_MODEL), jnp.float32),
        "norm_mix": gain(ks[1], (DEPTH, D_MODEL)),
        "norm_ffn": gain(ks[2], (DEPTH, D_MODEL)),
        "a_w_qkv": w(ks[3], (N_A_LAYERS, D_MODEL, A_QKV_COLS), D_MODEL),
        "a_q_gain": gain(ks[4], (N_A_LAYERS, N_GROUPS, A_HEAD_DIM)),
        "a_k_gain": gain(ks[5], (N_A_LAYERS, N_GROUPS, A_HEAD_DIM)),
        "a_w_o": w(ks[6], (N_A_LAYERS, A_WIDTH, D_MODEL), A_WIDTH),
        "b_w_in": w(ks[7], (N_B_LAYERS, D_MODEL, B_IN_COLS), D_MODEL),
        "b_q_a_gain": gain(ks[8], (N_B_LAYERS, Q_LORA)),
        "b_w_qb": w(ks[9], (N_B_LAYERS, Q_LORA, B_HEADS * QK_DIM), Q_LORA),
        "b_kv_a_gain": gain(ks[10], (N_B_LAYERS, KV_LORA)),
        "b_w_kvb": w(ks[11], (N_B_LAYERS, KV_LORA, B_HEADS * (NOPE_DIM + V_DIM)), KV_LORA),
        "b_q_gain": gain(ks[12], (N_B_LAYERS, QK_DIM)),
        "b_k_gain": gain(ks[13], (N_B_LAYERS, QK_DIM)),
        "b_w_o": w(ks[14], (N_B_LAYERS, B_HEADS * V_DIM, D_MODEL), B_HEADS * V_DIM),
        "ffn_w1": w(jax.random.fold_in(ks[15], 0), (DEPTH, D_MODEL, D_FF), D_MODEL),
        "ffn_w2": w(jax.random.fold_in(ks[15], 1), (DEPTH, D_FF, D_MODEL), D_FF),
    }


def reference(x, norm_mix, norm_ffn, a_w_qkv, a_q_gain, a_k_gain, a_w_o,
              b_w_in, b_q_a_gain, b_w_qb, b_kv_a_gain, b_w_kvb, b_q_gain, b_k_gain, b_w_o,
              ffn_w1, ffn_w2):
    for i in range(DEPTH):
        h = rms_norm(x, norm_mix[i])
        j = i // N_MIXERS
        if i % N_MIXERS == 0:
            y = dilated_mixer(h, a_w_qkv[j], a_q_gain[j], a_k_gain[j], a_w_o[j])
        else:
            y = mla_mixer(h, b_w_in[j], b_q_a_gain[j], b_w_qb[j], b_kv_a_gain[j],
                          b_w_kvb[j], b_q_gain[j], b_k_gain[j], b_w_o[j])
        x = x + y
        h = rms_norm(x, norm_ffn[i])
        x = x + sq_relu_mlp(h, ffn_w1[i], ffn_w2[i])
    return x
```

```cpp
#include <hip/hip_runtime.h>
#include <hip/hip_cooperative_groups.h>
#include <cstdio>
#include <cstdint>
namespace cg = cooperative_groups;
__device__ __forceinline__ int mk_lane() { int l; asm volatile("v_mbcnt_lo_u32_b32 %0, -1, 0\n\tv_mbcnt_hi_u32_b32 %0, -1, %0" : "=v"(l)); return l; }
namespace pg8 {
#define PG8_LAS __attribute__((address_space(3)))
typedef unsigned short bf16_t;
typedef short bf16x8 __attribute__((ext_vector_type(8)));
typedef float f32x4 __attribute__((ext_vector_type(4)));
typedef unsigned u32x4 __attribute__((ext_vector_type(4)));
constexpr int BM = 256, BK = 64, HALF = 128, HTB = HALF * BK * 2  , STAGE_BYTES = 8 * HTB, NXCD = 8, WGM = 8;

__host__ __device__ __forceinline__ int lds_byte(int r, int c) { const int st = (r >> 4) * 2 + (c >> 5), rr = r & 15, cc = c & 31, ob = rr * 64 + cc * 2; return st * 1024 + (ob ^ (((ob >> 9) & 1) << 5)); }
__host__ __device__ __forceinline__ void stage_rc(int b, int& R, int& C) { const int st = b / 1024, sb = b % 1024, swz = sb ^ (((sb >> 9) & 1) << 5); R = (st >> 1) * 16 + swz / 64; C = (st & 1) * 32 + (swz % 64) / 2; }
__host__ __device__ __forceinline__ int perm32(int rho) { const int n = rho >> 4, i = rho & 15; return 8 * (i >> 2) + 4 * n + (i & 3); }

struct Unit { int pm, pn; };
struct Gemm { const bf16_t* A; const bf16_t* Bt; int M, N, K; };

struct StaticOrder {
    int nM, nN, nwg, G, c;
    __host__ __device__ void init(int M, int N, int G_, int c_) { nM = M / BM; nN = N / BM; nwg = nM * nN; G = G_; c = c_; }
    __host__ __device__ bool next(int i, Unit& u) const {
        const long L = (long)i * G + c; if (L >= nwg) return false;
        int wgid = (int)L; { const int q = nwg / NXCD, r = nwg % NXCD, xcd = wgid % NXCD, off = wgid / NXCD; wgid = (xcd < r ? xcd * (q + 1) : r * (q + 1) + (xcd - r) * q) + off; }
        const int nig = WGM * nN, gid = wgid / nig, fm = gid * WGM, gsz = (nM - fm) < WGM ? (nM - fm) : WGM;
        u.pm = fm + ((wgid % nig) % gsz); u.pn = (wgid % nig) / gsz; return true;
    }
    __device__ __forceinline__ void a_ready(const Unit&) const {}
    __device__ __forceinline__ void done(const Unit&) const {}
};

__device__ __forceinline__ unsigned cvt_pk_bf16(float lo, float hi) { unsigned r; asm volatile("v_cvt_pk_bf16_f32 %0, %1, %2" : "=v"(r) : "v"(lo), "v"(hi)); return r; }
typedef float f32x2 __attribute__((ext_vector_type(2)));
typedef unsigned u32x2 __attribute__((ext_vector_type(2)));
constexpr float RMS_EPS = 1e-6f;
__device__ __forceinline__ u32x4 pack8(const f32x4& a, const f32x4& b) { u32x4 w; w.x = cvt_pk_bf16(a[0], a[1]); w.y = cvt_pk_bf16(a[2], a[3]); w.z = cvt_pk_bf16(b[0], b[1]); w.w = cvt_pk_bf16(b[2], b[3]); return w; }
__device__ __forceinline__ u32x2 pack4(const f32x4& a) { u32x2 w; w.x = cvt_pk_bf16(a[0], a[1]); w.y = cvt_pk_bf16(a[2], a[3]); return w; }
__device__ __forceinline__ float hsum4(const f32x4& t) { return (t[0] + t[1]) + (t[2] + t[3]); }


__device__ __forceinline__ float row_rstd(const float* rs, int row) { const f32x4 t = *(const f32x4*)(rs + (size_t)row * 4); return rsqrtf(hsum4(t) * (1.0f / 1024.0f) + RMS_EPS); }
__device__ __forceinline__ f32x4 bf2f_lo(const u32x2 u) { f32x4 r; r[0] = __uint_as_float(u.x << 16); r[1] = __uint_as_float(u.x & 0xffff0000u); r[2] = __uint_as_float(u.y << 16); r[3] = __uint_as_float(u.y & 0xffff0000u); return r; }
__device__ __forceinline__ void ss_exchange(const f32x4 (&acc)[2][2][4][2], int wr, int wc, int fr, int fq, PG8_LAS float* P) {
#pragma unroll
    for (int ai = 0; ai < 2; ++ai)
#pragma unroll
        for (int m = 0; m < 4; ++m)
#pragma unroll
            for (int bj = 0; bj < 2; ++bj) {
                const f32x4 a = acc[ai][bj][m][0], b = acc[ai][bj][m][1];
                float s = ((a[0] * a[0] + a[1] * a[1]) + (a[2] * a[2] + a[3] * a[3])) + ((b[0] * b[0] + b[1] * b[1]) + (b[2] * b[2] + b[3] * b[3]));
                s += __shfl_xor(s, 16); s += __shfl_xor(s, 32);
                if (fq == 0) P[((ai * HALF + wr * 64 + m * 16 + fr) * 2 + bj) * 4 + wc] = s;
            }
    asm volatile("s_waitcnt lgkmcnt(0)" ::: "memory"); __builtin_amdgcn_s_barrier(); asm volatile("" ::: "memory");
}

struct EpiResB {
    static constexpr bool PERM = true, AFTER_DRAIN = false;
    const bf16_t* base; bf16_t* out; float* rs; PG8_LAS float* P; const float* rs_in;
    __device__ __forceinline__ void operator()(const f32x4 (&acc)[2][2][4][2], const Unit& u, int wr, int wc, int fr, int fq) const {
        asm volatile("" : "+v"(fr), "+v"(fq));
        const int row0 = u.pm * BM + wr * 64 + fr, col0 = u.pn * BM + wc * 32 + 8 * fq;
        float r2[2][4];
#pragma unroll
        for (int ai = 0; ai < 2; ++ai)
#pragma unroll
            for (int m = 0; m < 4; ++m) { r2[ai][m] = 1.f; if (rs_in != nullptr) { const float r_ = row_rstd(rs_in, row0 + ai * HALF + m * 16); r2[ai][m] = r_ * r_; } }
#pragma unroll
        for (int ai = 0; ai < 2; ++ai) {
            u32x4 pre[4][2];
#pragma unroll
            for (int m = 0; m < 4; ++m)
#pragma unroll
                for (int bj = 0; bj < 2; ++bj) pre[m][bj] = *(const u32x4*)(base + (size_t)(row0 + ai * HALF + m * 16) * 1024 + col0 + bj * HALF);
#pragma unroll
            for (int m = 0; m < 4; ++m) { float ss = 0.f;
#pragma unroll
                for (int bj = 0; bj < 2; ++bj) { const u32x4 b = pre[m][bj];
                    const f32x4 x0 = bf2f_lo((u32x2){b.x, b.y}) + acc[ai][bj][m][0] * r2[ai][m], x1 = bf2f_lo((u32x2){b.z, b.w}) + acc[ai][bj][m][1] * r2[ai][m];
                    ss += ((x0[0] * x0[0] + x0[1] * x0[1]) + (x0[2] * x0[2] + x0[3] * x0[3])) + ((x1[0] * x1[0] + x1[1] * x1[1]) + (x1[2] * x1[2] + x1[3] * x1[3]));
                    *(u32x4*)(out + (size_t)(row0 + ai * HALF + m * 16) * 1024 + col0 + bj * HALF) = pack8(x0, x1); }
                ss += __shfl_xor(ss, 16); ss += __shfl_xor(ss, 32);
                if (fq == 0) P[(ai * HALF + wr * 64 + m * 16 + fr) * 4 + wc] = ss; }
            asm volatile("" ::: "memory"); }
        asm volatile("s_waitcnt lgkmcnt(0)" ::: "memory"); __builtin_amdgcn_s_barrier(); asm volatile("" ::: "memory");
        if (wr == 0) { const int rl = wc * 64 + fq * 16 + fr; const f32x4 t = *(const PG8_LAS f32x4*)(P + rl * 4); rs[(size_t)(u.pm * BM + rl) * 4 + u.pn] = hsum4(t); }
    }
};
struct EpiResF {
    static constexpr bool PERM = false, AFTER_DRAIN = false;
    const bf16_t* base; float* out; const float* rs_in;
    __device__ __forceinline__ void operator()(const f32x4 (&acc)[2][2][4][2], const Unit& u, int wr, int wc, int fr, int fq) const {
        asm volatile("" : "+v"(fr), "+v"(fq));
        const int col0 = u.pn * BM + wc * 32 + 4 * fq;
#pragma unroll
        for (int ai = 0; ai < 2; ++ai) {
            u32x2 pre[4][2][2]; float r2[4];
#pragma unroll
            for (int m = 0; m < 4; ++m) { const float r_ = row_rstd(rs_in, u.pm * BM + ai * HALF + wr * 64 + m * 16 + fr); r2[m] = r_ * r_; }
#pragma unroll
            for (int m = 0; m < 4; ++m) { const size_t off = (size_t)(u.pm * BM + ai * HALF + wr * 64 + m * 16 + fr) * 1024 + col0;
#pragma unroll
                for (int bj = 0; bj < 2; ++bj)
#pragma unroll
                    for (int n = 0; n < 2; ++n) pre[m][bj][n] = *(const u32x2*)(base + off + bj * HALF + n * 16); }
#pragma unroll
            for (int m = 0; m < 4; ++m) { const size_t off = (size_t)(u.pm * BM + ai * HALF + wr * 64 + m * 16 + fr) * 1024 + col0;
#pragma unroll
                for (int bj = 0; bj < 2; ++bj)
#pragma unroll
                    for (int n = 0; n < 2; ++n) *(f32x4*)(out + off + bj * HALF + n * 16) = bf2f_lo(pre[m][bj][n]) + acc[ai][bj][m][n] * r2[m]; }
            asm volatile("" ::: "memory"); }
    }
};
struct EpiRelu2 {
    static constexpr bool PERM = true, AFTER_DRAIN = false;
    bf16_t* O; int ldc; int dry;
    __device__ __forceinline__ void operator()(const f32x4 (&acc)[2][2][4][2], const Unit& u, int wr, int wc, int fr, int fq) const {
        asm volatile("" : "+v"(fr), "+v"(fq));
        const int row0 = u.pm * BM + wr * 64 + fr, col0 = u.pn * BM + wc * 32 + 8 * fq;
#pragma unroll
        for (int ai = 0; ai < 2; ++ai)
#pragma unroll
            for (int m = 0; m < 4; ++m) { bf16_t* rowp = O + (size_t)(row0 + ai * HALF + m * 16) * ldc + col0;
#pragma unroll
                for (int bj = 0; bj < 2; ++bj) { f32x4 v0 = acc[ai][bj][m][0], v1 = acc[ai][bj][m][1];
                    v0 = __builtin_elementwise_max(v0, (f32x4){0.f, 0.f, 0.f, 0.f}); v1 = __builtin_elementwise_max(v1, (f32x4){0.f, 0.f, 0.f, 0.f});
                    v0 = v0 * v0; v1 = v1 * v1; const u32x4 w8_ = pack8(v0, v1); if (!dry) __builtin_nontemporal_store(w8_, (u32x4*)(rowp + bj * HALF)); } }
    }
};
struct EpiQKVA {
    static constexpr bool PERM = true, AFTER_DRAIN = false;
    bf16_t* O; const float* qg; const float* kg; const float* cosT; const float* sinT; PG8_LAS float* P; const float* rs; int rs_row0;
    __device__ __forceinline__ void operator()(const f32x4 (&acc)[2][2][4][2], const Unit& u, int wr, int wc, int fr, int fq) const {
        asm volatile("" : "+v"(fr), "+v"(fq));
        const int c0 = u.pn * BM, which = c0 / 3072;
        float rr[2][4];
#pragma unroll
        for (int ai = 0; ai < 2; ++ai)
#pragma unroll
            for (int m = 0; m < 4; ++m) rr[ai][m] = row_rstd(rs, rs_row0 + u.pm * BM + ai * HALF + wr * 64 + m * 16 + fr);
        if (which == 2) {
            const int row0 = u.pm * BM + wr * 64 + fr, col0 = c0 + wc * 32 + 8 * fq;
#pragma unroll
            for (int ai = 0; ai < 2; ++ai)
#pragma unroll
                for (int m = 0; m < 4; ++m) { bf16_t* rowp = O + (size_t)(row0 + ai * HALF + m * 16) * 9216 + col0;
#pragma unroll
                    for (int bj = 0; bj < 2; ++bj) *(u32x4*)(rowp + bj * HALF) = pack8(acc[ai][bj][m][0] * rr[ai][m], acc[ai][bj][m][1] * rr[ai][m]); }
            return;
        }
        const int g = (c0 % 3072) / 1024; const float* gain = (which == 0 ? qg : kg) + g * 128;
        const int d0 = 16 * wc + 4 * fq;
        const f32x4 g0 = *(const f32x4*)(gain + d0), g1 = *(const f32x4*)(gain + 64 + d0);
        f32x4 cs[2][4], sn[2][4];
#pragma unroll
        for (int ai = 0; ai < 2; ++ai)
#pragma unroll
            for (int m = 0; m < 4; ++m) { const int pos = (u.pm * BM + ai * HALF + wr * 64 + m * 16 + fr) & 8191;
                cs[ai][m] = *(const f32x4*)(cosT + pos * 64 + d0); sn[ai][m] = *(const f32x4*)(sinT + pos * 64 + d0); }
        ss_exchange(acc, wr, wc, fr, fq, P);
#pragma unroll
        for (int ai = 0; ai < 2; ++ai)
#pragma unroll
            for (int m = 0; m < 4; ++m) { const int rl = ai * HALF + wr * 64 + m * 16 + fr, row = u.pm * BM + rl;
#pragma unroll
                for (int bj = 0; bj < 2; ++bj) { const f32x4 t = *(const PG8_LAS f32x4*)(P + (rl * 2 + bj) * 4);
                    const float rw = rr[ai][m], rstd = rw * rsqrtf(rw * rw * hsum4(t) * (1.0f / 128.0f) + RMS_EPS);
                    const f32x4 x1 = acc[ai][bj][m][0] * rstd * g0, x2 = acc[ai][bj][m][1] * rstd * g1;
                    const f32x4 y1 = x1 * cs[ai][m] - x2 * sn[ai][m], y2 = x2 * cs[ai][m] + x1 * sn[ai][m];
                    bf16_t* op = O + (size_t)row * 9216 + c0 + bj * HALF + d0;
                    *(u32x2*)op = pack4(y1); *(u32x2*)(op + 64) = pack4(y2); } }
    }
};
struct EpiLat {
    static constexpr bool PERM = true, AFTER_DRAIN = false;
    bf16_t* cqn; bf16_t* ckvn; float* kr; float* ssr; const float* qag; const float* kvag; const float* kg; const float* cos64; const float* sin64; PG8_LAS float* P; const float* rs;
    __device__ __forceinline__ void operator()(const f32x4 (&acc)[2][2][4][2], const Unit& u, int wr, int wc, int fr, int fq) const {
        asm volatile("" : "+v"(fr), "+v"(fq));
        float rr[2][4];
#pragma unroll
        for (int ai = 0; ai < 2; ++ai)
#pragma unroll
            for (int m = 0; m < 4; ++m) rr[ai][m] = row_rstd(rs, u.pm * BM + ai * HALF + wr * 64 + m * 16 + fr);
        ss_exchange(acc, wr, wc, fr, fq, P);
        const int col0 = wc * 32 + 8 * fq;
        if (u.pn == 0) {
            f32x4 ga[2][2];
#pragma unroll
            for (int bj = 0; bj < 2; ++bj) { ga[bj][0] = *(const f32x4*)(qag + bj * HALF + col0); ga[bj][1] = *(const f32x4*)(qag + bj * HALF + col0 + 4); }
#pragma unroll
            for (int ai = 0; ai < 2; ++ai)
#pragma unroll
                for (int m = 0; m < 4; ++m) { const int rl = ai * HALF + wr * 64 + m * 16 + fr, row = u.pm * BM + rl;
                    const f32x4 t0 = *(const PG8_LAS f32x4*)(P + (rl * 2 + 0) * 4), t1 = *(const PG8_LAS f32x4*)(P + (rl * 2 + 1) * 4);
                    const float rw = rr[ai][m], rstd = rw * rsqrtf(rw * rw * (hsum4(t0) + hsum4(t1)) * (1.0f / 256.0f) + RMS_EPS);
#pragma unroll
                    for (int bj = 0; bj < 2; ++bj) *(u32x4*)(cqn + (size_t)row * 256 + bj * HALF + col0) = pack8(acc[ai][bj][m][0] * rstd * ga[bj][0], acc[ai][bj][m][1] * rstd * ga[bj][1]);
                    asm volatile("" ::: "memory"); }
        } else {
            const f32x4 gv0 = *(const f32x4*)(kvag + col0), gv1 = *(const f32x4*)(kvag + col0 + 4);
            const int i0 = (16 * wc + 4 * fq) & 31;
            const f32x4 gk0 = *(const f32x4*)(kg + 128 + i0), gk1 = *(const f32x4*)(kg + 160 + i0);
#pragma unroll
            for (int ai = 0; ai < 2; ++ai)
#pragma unroll
                for (int m = 0; m < 4; ++m) { const int rl = ai * HALF + wr * 64 + m * 16 + fr, row = u.pm * BM + rl, pos = row & 8191;
                    const f32x4 t0 = *(const PG8_LAS f32x4*)(P + (rl * 2 + 0) * 4), t1 = *(const PG8_LAS f32x4*)(P + (rl * 2 + 1) * 4);
                    const float rw = rr[ai][m], rstd = rw * rsqrtf(rw * rw * hsum4(t0) * (1.0f / 128.0f) + RMS_EPS);
                    { const u32x4 w8 = pack8(acc[ai][0][m][0] * rstd * gv0, acc[ai][0][m][1] * rstd * gv1);
                      *(u32x4*)(ckvn + (size_t)row * 256 + col0) = w8; *(u32x4*)(ckvn + (size_t)row * 256 + HALF + col0) = w8; }
                    if (wc < 2) { const f32x4 cs = *(const f32x4*)(cos64 + pos * 32 + i0), sn = *(const f32x4*)(sin64 + pos * 32 + i0);
                        const f32x4 x1 = acc[ai][1][m][0] * rw * gk0, x2 = acc[ai][1][m][1] * rw * gk1;
                        *(f32x4*)(kr + (size_t)row * 64 + i0) = x1 * cs - x2 * sn; *(f32x4*)(kr + (size_t)row * 64 + 32 + i0) = x2 * cs + x1 * sn; }
                    if (wc == 0 && fq == 0) ssr[row] = rw * rw * hsum4(t1);
                    asm volatile("" ::: "memory"); }
        }
    }
};
struct EpiQB {
    static constexpr bool PERM = true, AFTER_DRAIN = false;
    bf16_t* Q; const float* qg; const float* cos64; const float* sin64; PG8_LAS float* P;
    __device__ __forceinline__ void operator()(const f32x4 (&acc)[2][2][4][2], const Unit& u, int wr, int wc, int fr, int fq) const {
        asm volatile("" : "+v"(fr), "+v"(fq));
        const int h = u.pn, col0 = wc * 32 + 8 * fq, i0 = (16 * wc + 4 * fq) & 31;
        const f32x4 ga = *(const f32x4*)(qg + col0), gb = *(const f32x4*)(qg + col0 + 4), gr0 = *(const f32x4*)(qg + 128 + i0), gr1 = *(const f32x4*)(qg + 160 + i0);
        f32x4 csv[2][4], snv[2][4];
        if (wc < 2) {
#pragma unroll
            for (int ai = 0; ai < 2; ++ai)
#pragma unroll
                for (int m = 0; m < 4; ++m) { const int s_ = (u.pm * BM + ai * HALF + wr * 64 + m * 16 + fr) & 8191; csv[ai][m] = *(const f32x4*)(cos64 + s_ * 32 + i0); snv[ai][m] = *(const f32x4*)(sin64 + s_ * 32 + i0); }
        }
        ss_exchange(acc, wr, wc, fr, fq, P);
#pragma unroll
        for (int ai = 0; ai < 2; ++ai)
#pragma unroll
            for (int m = 0; m < 4; ++m) { const int rl = ai * HALF + wr * 64 + m * 16 + fr, row = u.pm * BM + rl, b = row >> 13, s = row & 8191;
                const f32x4 t0 = *(const PG8_LAS f32x4*)(P + (rl * 2 + 0) * 4), t1 = *(const PG8_LAS f32x4*)(P + (rl * 2 + 1) * 4);
                const float rstd = rsqrtf((hsum4(t0) + hsum4(t1)) * (1.0f / 192.0f) + RMS_EPS);
                bf16_t* qp = Q + ((size_t)(b * 8 + h) * 8192 + s) * 192;
                *(u32x4*)(qp + col0) = pack8(acc[ai][0][m][0] * rstd * ga, acc[ai][0][m][1] * rstd * gb);
                if (wc < 2) { const f32x4 cs = csv[ai][m], sn = snv[ai][m];
                    const f32x4 x1 = acc[ai][1][m][0] * rstd * gr0, x2 = acc[ai][1][m][1] * rstd * gr1;
                    *(u32x2*)(qp + 128 + i0) = pack4(x1 * cs - x2 * sn); *(u32x2*)(qp + 160 + i0) = pack4(x2 * cs + x1 * sn); } }
    }
};
struct EpiKVB {
    static constexpr bool PERM = true, AFTER_DRAIN = false;
    bf16_t* K; bf16_t* V; const float* kg; const float* kr; const float* ssr; PG8_LAS float* P;
    __device__ __forceinline__ void operator()(const f32x4 (&acc)[2][2][4][2], const Unit& u, int wr, int wc, int fr, int fq) const {
        asm volatile("" : "+v"(fr), "+v"(fq));
        const int h = u.pn, col0 = wc * 32 + 8 * fq, c4 = 4 * (4 * wc + fq);
        const f32x4 ga = *(const f32x4*)(kg + col0), gb = *(const f32x4*)(kg + col0 + 4);
        f32x4 krv[2][4]; float ssv[2][4];
#pragma unroll
        for (int ai = 0; ai < 2; ++ai)
#pragma unroll
            for (int m = 0; m < 4; ++m) { const int row = u.pm * BM + ai * HALF + wr * 64 + m * 16 + fr; ssv[ai][m] = ssr[row]; krv[ai][m] = *(const f32x4*)(kr + (size_t)row * 64 + c4); }
        ss_exchange(acc, wr, wc, fr, fq, P);
#pragma unroll
        for (int ai = 0; ai < 2; ++ai)
#pragma unroll
            for (int m = 0; m < 4; ++m) { const int rl = ai * HALF + wr * 64 + m * 16 + fr, row = u.pm * BM + rl, b = row >> 13, s = row & 8191;
                const f32x4 t0 = *(const PG8_LAS f32x4*)(P + (rl * 2 + 0) * 4);
                const float rstd = rsqrtf((hsum4(t0) + ssv[ai][m]) * (1.0f / 192.0f) + RMS_EPS);
                const size_t tok = (size_t)(b * 8 + h) * 8192 + s;
                bf16_t* kp = K + tok * 192;
                *(u32x4*)(kp + col0) = pack8(acc[ai][0][m][0] * rstd * ga, acc[ai][0][m][1] * rstd * gb);
                const f32x4 r4 = krv[ai][m] * rstd;
                *(u32x2*)(kp + 128 + c4) = pack4(r4);
                *(u32x4*)(V + tok * 128 + col0) = pack8(acc[ai][1][m][0], acc[ai][1][m][1]); }
    }
};

template <class Epi, class Sched, bool ALIGN_EPI = false, bool SP2 = false>
__device__ __forceinline__ void gemm_phase(PG8_LAS unsigned char* lds, const Gemm g, const Sched& S, const Epi& E, int wave_s) {
    int tid_l = wave_s * 64 + mk_lane(); asm volatile("" : "+v"(tid_l));
    const int tid = tid_l, wid = __builtin_amdgcn_readfirstlane(tid >> 6), lane = tid & 63, wr = wid >> 2, wc = wid & 3, fr = lane & 15, fq = lane >> 4;
    int K_l = g.K; asm volatile("" : "+s"(K_l));
    const int K = K_l, nt = K / BK;
    unsigned voffA[2], voffB[2];
#pragma unroll
    for (int i = 0; i < 2; ++i) { int R, C; stage_rc(tid * 16 + i * 8192, R, C); const int Rb = Epi::PERM ? ((R & ~31) + perm32(R & 31)) : R;
        voffA[i] = (unsigned)(R * K + C) * 2u; voffB[i] = (unsigned)(Rb * K + C) * 2u; }
    const size_t kstep = (size_t)(BK * 2);
    const size_t hstep = (size_t)HALF * K * 2;
    const size_t tstep = 2 * hstep;
    const unsigned ldsw = (unsigned)wid * 1024u;
    const int aoff = lds_byte(wr * 64 + fr, fq * 8), boff = lds_byte(wc * 32 + fr, fq * 8);
#define PG8_SA(b, h) (((b) * 2 + (h)) * HTB)
#define PG8_SB(b, h) ((4 + (b) * 2 + (h)) * HTB)
#define PG8_STAGE(bufoff, gbase, voff) do { _Pragma("unroll") for (int _i = 0; _i < 2; ++_i) \
        __builtin_amdgcn_global_load_lds((const unsigned*)((const char*)(gbase) + (voff)[_i]), (PG8_LAS unsigned*)(lds + (bufoff) + ldsw + _i * 8192), 16, 0, 0); } while (0)
#define PG8_LDA(dst, b, h) do { _Pragma("unroll") for (int m = 0; m < 4; ++m) _Pragma("unroll") for (int k = 0; k < 2; ++k) dst[m][k] = *(const PG8_LAS bf16x8*)(lds + PG8_SA(b, h) + aoff + m * 2048 + k * 1024); } while (0)
#define PG8_LDB(dst, b, h) do { _Pragma("unroll") for (int n = 0; n < 2; ++n) _Pragma("unroll") for (int k = 0; k < 2; ++k) dst[n][k] = *(const PG8_LAS bf16x8*)(lds + PG8_SB(b, h) + boff + n * 2048 + k * 1024); } while (0)
#define PG8_MMA(ai, bj, At, Bt) do { __builtin_amdgcn_s_setprio(1); _Pragma("unroll") for (int m = 0; m < 4; ++m) _Pragma("unroll") for (int n = 0; n < 2; ++n) _Pragma("unroll") for (int k = 0; k < 2; ++k) \
        acc[ai][bj][m][n] = __builtin_amdgcn_mfma_f32_16x16x32_bf16(Bt[n][k], At[m][k], acc[ai][bj][m][n], 0, 0, 0); __builtin_amdgcn_s_setprio(0); } while (0)
#define PG8_WAIT_V(n) asm volatile("s_waitcnt vmcnt(" #n ")" ::: "memory")
#define PG8_WAIT_L(n) asm volatile("s_waitcnt lgkmcnt(" #n ")" ::: "memory")
#define PG8_BAR __builtin_amdgcn_s_barrier()
#define PG8_SCHED __builtin_amdgcn_sched_barrier(0)
    Unit cur, nxt; int ui = 0;
    if (!S.next(0, cur)) return;
    f32x4 acc[2][2][4][2];
#pragma unroll
    for (int a = 0; a < 2; ++a)
#pragma unroll
        for (int b = 0; b < 2; ++b)
#pragma unroll
            for (int m = 0; m < 4; ++m)
#pragma unroll
                for (int n = 0; n < 2; ++n) acc[a][b][m][n] = (f32x4){0.f, 0.f, 0.f, 0.f};
    bf16x8 At[4][2], B0[2][2], B1[2][2];
    const char* cA = (const char*)g.A + (size_t)cur.pm * tstep; const char* cB = (const char*)g.Bt + (size_t)cur.pn * tstep;
    S.a_ready(cur);
    if constexpr (SP2) {
        PG8_STAGE(PG8_SB(0, 0), cB, voffB); PG8_STAGE(PG8_SB(0, 1), cB + hstep, voffB); PG8_STAGE(PG8_SA(0, 0), cA, voffA); PG8_STAGE(PG8_SA(0, 1), cA + hstep, voffA);
        if (wr == 1) PG8_BAR;
        PG8_WAIT_V(2); PG8_BAR;
        PG8_STAGE(PG8_SB(1, 0), cB + kstep, voffB); PG8_STAGE(PG8_SA(1, 0), cA + kstep, voffA); PG8_STAGE(PG8_SB(1, 1), cB + hstep + kstep, voffB);
        PG8_WAIT_V(6); PG8_BAR;
    } else {
        PG8_STAGE(PG8_SB(0, 0), cB, voffB); PG8_STAGE(PG8_SA(0, 0), cA, voffA); PG8_STAGE(PG8_SB(0, 1), cB + hstep, voffB); PG8_STAGE(PG8_SA(0, 1), cA + hstep, voffA);
        if (wr == 1) PG8_BAR;
        PG8_WAIT_V(4); PG8_BAR;
        PG8_STAGE(PG8_SB(1, 0), cB + kstep, voffB); PG8_STAGE(PG8_SA(1, 0), cA + kstep, voffA); PG8_STAGE(PG8_SB(1, 1), cB + hstep + kstep, voffB);
        PG8_WAIT_V(6); PG8_BAR;
    }
    for (;;) {
        const bool has_next = S.next(ui + 1, nxt);
        const char* nA = has_next ? (const char*)g.A + (size_t)nxt.pm * tstep : cA; const char* nB = has_next ? (const char*)g.Bt + (size_t)nxt.pn * tstep : cB;
        for (int t = 0; t < nt; t += 2) {
            const bool last = (t == nt - 2);
            const char* a1 = cA + (size_t)(t + 1) * kstep;
            const char* a2 = last ? nA : cA + (size_t)(t + 2) * kstep; const char* b2 = last ? nB : cB + (size_t)(t + 2) * kstep;
            const char* a3 = a2 + kstep; const char* b3 = b2 + kstep;
            if (last && has_next) S.a_ready(nxt);
            if constexpr (SP2) {
            PG8_LDB(B0, 0, 0); PG8_LDB(B1, 0, 1); PG8_SCHED; PG8_LDA(At, 0, 0); PG8_STAGE(PG8_SA(1, 1), a1 + hstep, voffA);
            PG8_WAIT_V(8); PG8_WAIT_L(0); PG8_BAR; PG8_MMA(0, 0, At, B0); PG8_MMA(0, 1, At, B1); PG8_BAR; PG8_SCHED;
            PG8_LDA(At, 0, 1); PG8_STAGE(PG8_SB(0, 0), b2, voffB); PG8_STAGE(PG8_SB(0, 1), b2 + hstep, voffB); PG8_STAGE(PG8_SA(0, 0), a2, voffA);
            PG8_WAIT_V(8); PG8_WAIT_L(0); PG8_BAR; PG8_MMA(1, 0, At, B0); PG8_MMA(1, 1, At, B1); PG8_BAR; PG8_SCHED;
            PG8_LDB(B0, 1, 0); PG8_LDB(B1, 1, 1); PG8_SCHED; PG8_LDA(At, 1, 0); PG8_STAGE(PG8_SA(0, 1), a2 + hstep, voffA);
            PG8_WAIT_V(8); PG8_WAIT_L(0); PG8_BAR; PG8_MMA(0, 0, At, B0); PG8_MMA(0, 1, At, B1); PG8_BAR; PG8_SCHED;
            PG8_LDA(At, 1, 1); PG8_STAGE(PG8_SB(1, 0), b3, voffB); PG8_STAGE(PG8_SB(1, 1), b3 + hstep, voffB); PG8_STAGE(PG8_SA(1, 0), a3, voffA);
            PG8_WAIT_V(8); PG8_WAIT_L(0); PG8_BAR; PG8_MMA(1, 0, At, B0); PG8_MMA(1, 1, At, B1); PG8_BAR; PG8_SCHED;
            } else {
            PG8_LDB(B0, 0, 0); PG8_SCHED; PG8_LDA(At, 0, 0); PG8_STAGE(PG8_SA(1, 1), a1 + hstep, voffA);
            PG8_WAIT_L(8); PG8_BAR; PG8_WAIT_L(0); PG8_MMA(0, 0, At, B0); PG8_BAR; PG8_SCHED;
            PG8_LDB(B1, 0, 1); PG8_STAGE(PG8_SB(0, 0), b2, voffB);
            PG8_BAR; PG8_WAIT_L(0); PG8_MMA(0, 1, At, B1); PG8_BAR;
            PG8_LDA(At, 0, 1); PG8_STAGE(PG8_SA(0, 0), a2, voffA);
            PG8_BAR; PG8_WAIT_L(0); PG8_MMA(1, 0, At, B0); PG8_BAR; PG8_SCHED;
            PG8_STAGE(PG8_SB(0, 1), b2 + hstep, voffB);
            PG8_WAIT_V(6); PG8_BAR; PG8_MMA(1, 1, At, B1); PG8_BAR;
            PG8_LDB(B0, 1, 0); PG8_SCHED; PG8_LDA(At, 1, 0); PG8_STAGE(PG8_SA(0, 1), a2 + hstep, voffA);
            PG8_WAIT_L(8); PG8_BAR; PG8_WAIT_L(0); PG8_MMA(0, 0, At, B0); PG8_BAR; PG8_SCHED;
            PG8_LDB(B1, 1, 1); PG8_STAGE(PG8_SB(1, 0), b3, voffB);
            PG8_BAR; PG8_WAIT_L(0); PG8_MMA(0, 1, At, B1); PG8_BAR;
            PG8_LDA(At, 1, 1); PG8_STAGE(PG8_SA(1, 0), a3, voffA);
            PG8_BAR; PG8_WAIT_L(0); PG8_MMA(1, 0, At, B0); PG8_BAR; PG8_SCHED;
            PG8_STAGE(PG8_SB(1, 1), b3 + hstep, voffB);
            PG8_WAIT_V(6); PG8_BAR; PG8_MMA(1, 1, At, B1); PG8_BAR;
            }
        }
        if constexpr (ALIGN_EPI) { if (wr == 0) PG8_BAR; }
        if constexpr (!Epi::AFTER_DRAIN) { E(acc, cur, wr, wc, fr, fq); S.done(cur); }
        if (!has_next) break;
#pragma unroll
        for (int a = 0; a < 2; ++a)
#pragma unroll
            for (int b = 0; b < 2; ++b)
#pragma unroll
                for (int m = 0; m < 4; ++m)
#pragma unroll
                    for (int n = 0; n < 2; ++n) acc[a][b][m][n] = (f32x4){0.f, 0.f, 0.f, 0.f};
        cur = nxt; cA = nA; cB = nB; ++ui;
        if constexpr (ALIGN_EPI) { if (wr == 1) PG8_BAR; }
    }
    PG8_WAIT_V(0);
    if constexpr (!ALIGN_EPI) { if (wr == 0) PG8_BAR; }
    PG8_BAR;
    if constexpr (Epi::AFTER_DRAIN) { E.fused(acc, cur, wr, wc, fr, fq, lds, wid, lane); S.done(cur); }
#undef PG8_SA
#undef PG8_SB
#undef PG8_STAGE
#undef PG8_LDA
#undef PG8_LDB
#undef PG8_MMA
#undef PG8_WAIT_V
#undef PG8_WAIT_L
#undef PG8_BAR
#undef PG8_SCHED
}
}
namespace att {
#define ATT_LAS __attribute__((address_space(3)))
typedef unsigned short bf16_t;
typedef short bf16x8 __attribute__((ext_vector_type(8)));
typedef short s16x4 __attribute__((ext_vector_type(4)));
typedef float f32x16 __attribute__((ext_vector_type(16)));
typedef unsigned u32x4 __attribute__((ext_vector_type(4)));
#define SBAR() __builtin_amdgcn_sched_barrier(0)
__device__ __forceinline__ int crow(int r, int hi) { return (r & 3) + 8 * (r >> 2) + 4 * hi; }
__device__ __forceinline__ unsigned cvtpk(float lo, float hi) { unsigned r; asm volatile("v_cvt_pk_bf16_f32 %0, %1, %2" : "=v"(r) : "v"(lo), "v"(hi)); return r; }
__device__ __forceinline__ unsigned short f2bf(float f) { return (unsigned short)(cvtpk(f, f) & 0xffffu); }

template <int THRON>
__device__ __forceinline__ void partialSM(f32x16& p0, f32x16& p1, float& m_reg, float& mn, float& alpha, float C, float thr_raw) {
  float pmax = p0[0];
#pragma unroll
  for (int r = 1; r < 16; ++r) pmax = fmaxf(pmax, p0[r]);
#pragma unroll
  for (int r = 0; r < 16; ++r) pmax = fmaxf(pmax, p1[r]);
  { auto rr = __builtin_amdgcn_permlane32_swap(__float_as_uint(pmax), __float_as_uint(pmax), false, false);
    pmax = fmaxf(__uint_as_float(rr[0]), __uint_as_float(rr[1])); }
  if (THRON && __builtin_expect(__all(pmax - m_reg <= thr_raw), 1)) { mn = m_reg; alpha = 1.f; }
  else { mn = fmaxf(m_reg, pmax); alpha = __builtin_amdgcn_exp2f((m_reg - mn) * C); m_reg = mn; }
  const float mnC = -mn * C;
#pragma unroll
  for (int r = 0; r < 16; ++r) p0[r] = fmaf(p0[r], C, mnC);
#pragma unroll
  for (int r = 0; r < 16; ++r) p1[r] = fmaf(p1[r], C, mnC);
#pragma unroll
  for (int r = 0; r < 16; ++r) p0[r] = __builtin_amdgcn_exp2f(p0[r]);
}
__device__ __forceinline__ void finishSM(f32x16& p0, f32x16& p1, float alpha, float& l_reg, bf16x8& pa0, bf16x8& pa1, bf16x8& pa2, bf16x8& pa3) {
#pragma unroll
  for (int r = 0; r < 16; ++r) p1[r] = __builtin_amdgcn_exp2f(p1[r]);
  float ps = 0;
#pragma unroll
  for (int r = 0; r < 16; ++r) ps += p0[r];
#pragma unroll
  for (int r = 0; r < 16; ++r) ps += p1[r];
  { auto rr = __builtin_amdgcn_permlane32_swap(__float_as_uint(ps), __float_as_uint(ps), false, false);
    ps = __uint_as_float(rr[0]) + __uint_as_float(rr[1]); }
  l_reg = l_reg * alpha + ps;
#define PK4(P, BASE, OUT) do { unsigned a0 = cvtpk(P[BASE + 0], P[BASE + 1]), a1 = cvtpk(P[BASE + 2], P[BASE + 3]);   \
    unsigned b0 = cvtpk(P[BASE + 4], P[BASE + 5]), b1 = cvtpk(P[BASE + 6], P[BASE + 7]);                              \
    auto r0 = __builtin_amdgcn_permlane32_swap(a0, b0, false, false); auto r1 = __builtin_amdgcn_permlane32_swap(a1, b1, false, false); \
    u32x4 w = {r0[0], r1[0], r0[1], r1[1]}; OUT = __builtin_bit_cast(bf16x8, w); } while (0)
  PK4(p0, 0, pa0); PK4(p0, 8, pa1); PK4(p1, 0, pa2); PK4(p1, 8, pa3);
#undef PK4
}
template <int DQK> __device__ __forceinline__ constexpr int kstride() { return DQK * 2 + 16; }
template <int DQK> __device__ __forceinline__ int kswz(int row, int colB) { return row * kstride<DQK>() + colB; }
template <int DQK, int LA = 2> __device__ __forceinline__ void qkt(f32x16& p0, f32x16& p1, const ATT_LAS char* Ks, const bf16x8* qr, int r32, int hi) {
  constexpr int N = DQK / 16;
  const ATT_LAS char* k0 = Ks + r32 * kstride<DQK>(); const ATT_LAS char* k1 = Ks + (32 + r32) * kstride<DQK>(); const int sw = 0;
  bf16x8 kf[N][2];
  p0 = f32x16{}; p1 = f32x16{};
#pragma unroll
  for (int d0 = 0; d0 < LA; ++d0) { const int cb = ((d0 * 16 + hi * 8) * 2) ^ sw; kf[d0][0] = *(const ATT_LAS bf16x8*)(k0 + cb); kf[d0][1] = *(const ATT_LAS bf16x8*)(k1 + cb); }
  SBAR();
#pragma unroll
  for (int d0 = 0; d0 < N; ++d0) {
    if (d0 + LA < N) { const int cb = (((d0 + LA) * 16 + hi * 8) * 2) ^ sw; kf[d0 + LA][0] = *(const ATT_LAS bf16x8*)(k0 + cb); kf[d0 + LA][1] = *(const ATT_LAS bf16x8*)(k1 + cb); }
    SBAR();
    p0 = __builtin_amdgcn_mfma_f32_32x32x16_bf16(kf[d0][0], qr[d0], p0, 0, 0, 0);
    p1 = __builtin_amdgcn_mfma_f32_32x32x16_bf16(kf[d0][1], qr[d0], p1, 0, 0, 0);
    SBAR();
  }
}
__device__ __forceinline__ int v_st(int k, int c) { const int kk = (k & ~0xC) | ((k & 4) << 1) | ((k & 8) >> 1); return ((kk >> 3) * 4 + (c >> 5)) * 512 + ((kk & 7) * 32 + (c & 31)) * 2; }
__device__ __forceinline__ int v_rd_base(int lane) { return ((lane & 3) << 3) | (((lane >> 2) & 3) << 6) | (((lane >> 4) & 1) << 5) | (((lane >> 5) & 1) << 8); }
constexpr int v_rd_off(int d0, int ks, int half) { return d0 * 512 + ks * 4096 + half * 2048; }
template <int OFF> __device__ __forceinline__ s16x4 tr_read(int vb) { s16x4 r; asm volatile("ds_read_b64_tr_b16 %0, %1 offset:%2" : "=&v"(r) : "v"(vb), "i"(OFF) : "memory"); return r; }
template <int D0> __device__ __forceinline__ void pv_one(f32x16& od, int vb, bf16x8 pa0, bf16x8 pa1, bf16x8 pa2, bf16x8 pa3) {
  const s16x4 l0 = tr_read<v_rd_off(D0, 0, 0)>(vb), h0 = tr_read<v_rd_off(D0, 0, 1)>(vb), l1 = tr_read<v_rd_off(D0, 1, 0)>(vb), h1 = tr_read<v_rd_off(D0, 1, 1)>(vb);
  const s16x4 l2 = tr_read<v_rd_off(D0, 2, 0)>(vb), h2 = tr_read<v_rd_off(D0, 2, 1)>(vb), l3 = tr_read<v_rd_off(D0, 3, 0)>(vb), h3 = tr_read<v_rd_off(D0, 3, 1)>(vb);
  asm volatile("s_waitcnt lgkmcnt(0)" ::: "memory"); SBAR();
#define PK(L, H) (bf16x8){L[0], L[1], L[2], L[3], H[0], H[1], H[2], H[3]}
  od = __builtin_amdgcn_mfma_f32_32x32x16_bf16(pa0, PK(l0, h0), od, 0, 0, 0);
  od = __builtin_amdgcn_mfma_f32_32x32x16_bf16(pa1, PK(l1, h1), od, 0, 0, 0);
  od = __builtin_amdgcn_mfma_f32_32x32x16_bf16(pa2, PK(l2, h2), od, 0, 0, 0);
  od = __builtin_amdgcn_mfma_f32_32x32x16_bf16(pa3, PK(l3, h3), od, 0, 0, 0);
#undef PK
}
__device__ __forceinline__ void pv_d0(f32x16* o, int vb, bf16x8 pa0, bf16x8 pa1, bf16x8 pa2, bf16x8 pa3) {
  pv_one<0>(o[0], vb, pa0, pa1, pa2, pa3); pv_one<1>(o[1], vb, pa0, pa1, pa2, pa3); pv_one<2>(o[2], vb, pa0, pa1, pa2, pa3); pv_one<3>(o[3], vb, pa0, pa1, pa2, pa3);
}

template <int D0> __device__ __forceinline__ void pv_reads(s16x4 (&l)[4], s16x4 (&h)[4], int vb) {
  l[0] = tr_read<v_rd_off(D0, 0, 0)>(vb); h[0] = tr_read<v_rd_off(D0, 0, 1)>(vb); l[1] = tr_read<v_rd_off(D0, 1, 0)>(vb); h[1] = tr_read<v_rd_off(D0, 1, 1)>(vb);
  l[2] = tr_read<v_rd_off(D0, 2, 0)>(vb); h[2] = tr_read<v_rd_off(D0, 2, 1)>(vb); l[3] = tr_read<v_rd_off(D0, 3, 0)>(vb); h[3] = tr_read<v_rd_off(D0, 3, 1)>(vb);
}
__device__ __forceinline__ void pv_mma(f32x16& od, const s16x4 (&l)[4], const s16x4 (&h)[4], bf16x8 pa0, bf16x8 pa1, bf16x8 pa2, bf16x8 pa3) {
#define PK(L, H) (bf16x8){L[0], L[1], L[2], L[3], H[0], H[1], H[2], H[3]}
  od = __builtin_amdgcn_mfma_f32_32x32x16_bf16(pa0, PK(l[0], h[0]), od, 0, 0, 0);
  od = __builtin_amdgcn_mfma_f32_32x32x16_bf16(pa1, PK(l[1], h[1]), od, 0, 0, 0);
  od = __builtin_amdgcn_mfma_f32_32x32x16_bf16(pa2, PK(l[2], h[2]), od, 0, 0, 0);
  od = __builtin_amdgcn_mfma_f32_32x32x16_bf16(pa3, PK(l[3], h[3]), od, 0, 0, 0);
#undef PK
}
__device__ __forceinline__ void pv_d0_la(f32x16* o, int vb, bf16x8 pa0, bf16x8 pa1, bf16x8 pa2, bf16x8 pa3) {
  s16x4 la[4], ha[4], lb[4], hb[4];
  pv_reads<0>(la, ha, vb); pv_reads<1>(lb, hb, vb);
  asm volatile("s_waitcnt lgkmcnt(8)" ::: "memory"); SBAR(); pv_mma(o[0], la, ha, pa0, pa1, pa2, pa3); SBAR();
  pv_reads<2>(la, ha, vb);
  asm volatile("s_waitcnt lgkmcnt(8)" ::: "memory"); SBAR(); pv_mma(o[1], lb, hb, pa0, pa1, pa2, pa3); SBAR();
  pv_reads<3>(lb, hb, vb);
  asm volatile("s_waitcnt lgkmcnt(8)" ::: "memory"); SBAR(); pv_mma(o[2], la, ha, pa0, pa1, pa2, pa3); SBAR();
  asm volatile("s_waitcnt lgkmcnt(0)" ::: "memory"); SBAR(); pv_mma(o[3], lb, hb, pa0, pa1, pa2, pa3);
}

template <int DQK, bool BAND>
__device__ __forceinline__ void attn_unit(const bf16_t* Qb, long ldq, const bf16_t* Kb, long ldk, const bf16_t* Vb, long ldv, bf16_t* Ob, long ldo, float* lse, long ldl,
                                          int kt0, int kt1, int qtile0, float scale, ATT_LAS char* lds, int wave_s) {
  constexpr int KB_BYTES = 64 * DQK * 2, VB_BYTES = 64 * 128 * 2, KCH = DQK / 8, NKC = DQK / 64;
  int tid_l = wave_s * 64 + mk_lane(); asm volatile("" : "+v"(tid_l));
  const int tid = tid_l, wid = __builtin_amdgcn_readfirstlane(tid >> 6), lane = tid & 63, r32 = lane & 31, hi = lane >> 5;
  ATT_LAS char* V_lds = lds; ATT_LAS char* K_lds = lds + 2 * VB_BYTES;
  ATT_LAS float* wsf = (ATT_LAS float*)(lds + 2 * VB_BYTES + 2 * KB_BYTES) + wid * 64; ATT_LAS float* li_l = wsf; ATT_LAS float* al_l = wsf + 32;
  const float C = scale * 1.4426950408889634f, thr_raw = 8.0f / scale;
  bf16x8 qr[DQK / 16];
  { const bf16_t* Qw = Qb + (long)(wid * 32 + r32) * ldq + hi * 8;
#pragma unroll
    for (int d0 = 0; d0 < DQK / 16; ++d0) qr[d0] = *(const bf16x8*)(Qw + d0 * 16); }
  float m_reg = -1e30f, l_reg = 0.f; f32x16 o[4] = {};
  const int qb = qtile0 + (wid >> 1), qi = (wid & 1) * 32 + r32;
  const int vb0 = (int)(unsigned)(uintptr_t)V_lds + v_rd_base(lane);
  bf16x8 ks[NKC], vs[2];
  const int vrow = tid >> 4, vcol = (tid & 15) * 8;
#define SLOAD(t) do { _Pragma("unroll") for (int i_ = 0; i_ < NKC; ++i_) { const int id_ = tid + 512 * i_, row_ = id_ / KCH, c8_ = id_ % KCH; ks[i_] = *(const bf16x8*)(Kb + (long)((t) * 64 + row_) * ldk + c8_ * 8); } \
    _Pragma("unroll") for (int i_ = 0; i_ < 2; ++i_) vs[i_] = *(const bf16x8*)(Vb + (long)((t) * 64 + vrow + 32 * i_) * ldv + vcol); } while (0)
#define SWRITE(b) do { _Pragma("unroll") for (int i_ = 0; i_ < NKC; ++i_) { const int id_ = tid + 512 * i_, row_ = id_ / KCH, c8_ = id_ % KCH; *(ATT_LAS bf16x8*)(K_lds + (b) * KB_BYTES + kswz<DQK>(row_, c8_ * 16)) = ks[i_]; } \
    _Pragma("unroll") for (int i_ = 0; i_ < 2; ++i_) *(ATT_LAS bf16x8*)(V_lds + (b) * VB_BYTES + v_st(vrow + 32 * i_, vcol)) = vs[i_]; } while (0)
  SLOAD(kt0); SWRITE(0); __syncthreads();
  for (int t = kt0; t < kt1; ++t) {
    const int b = (t - kt0) & 1; const bool more = (t + 1 < kt1);
    if (more) SLOAD(t + 1);
    const bool act = !BAND || (t >= qb - 1 && t <= qb + 1);
    if (act) {
      f32x16 p0, p1; qkt<DQK>(p0, p1, K_lds + b * KB_BYTES, qr, r32, hi);
      if (BAND) {
        if (t == qb - 1) {
#pragma unroll
          for (int r = 0; r < 16; ++r) { const int k0 = crow(r, hi); if (k0 < qi) p0[r] = -1e30f; if (k0 + 32 < qi) p1[r] = -1e30f; }
        } else if (t == qb + 1) {
#pragma unroll
          for (int r = 0; r < 16; ++r) { const int k0 = crow(r, hi); if (k0 > qi) p0[r] = -1e30f; if (k0 + 32 > qi) p1[r] = -1e30f; }
        }
      }
      float mn, alpha; partialSM<1>(p0, p1, m_reg, mn, alpha, C, thr_raw);
      bf16x8 pa0, pa1, pa2, pa3; finishSM(p0, p1, alpha, l_reg, pa0, pa1, pa2, pa3);
      if (__any(alpha < 1.f)) { if (hi == 0) al_l[r32] = alpha; asm volatile("s_waitcnt lgkmcnt(0)" ::: "memory");
#pragma unroll
        for (int d = 0; d < 4; ++d)
#pragma unroll
          for (int r = 0; r < 16; ++r) o[d][r] *= al_l[crow(r, hi)]; }
      pv_d0(o, vb0 + b * VB_BYTES, pa0, pa1, pa2, pa3);
    }
    if (more) SWRITE(b ^ 1);
    __syncthreads();
  }
#undef SLOAD
#undef SWRITE
  if (hi == 0) li_l[r32] = l_reg;
  asm volatile("s_waitcnt lgkmcnt(0)" ::: "memory");
  float rli[16];
#pragma unroll
  for (int r = 0; r < 16; ++r) rli[r] = __builtin_amdgcn_rcpf(li_l[crow(r, hi)]);
  bf16_t* Ow = Ob + (long)(wid * 32) * ldo;
#pragma unroll
  for (int r = 0; r < 16; ++r) { const int orow = crow(r, hi);
#pragma unroll
    for (int d0 = 0; d0 < 4; ++d0) Ow[(long)orow * ldo + d0 * 32 + r32] = f2bf(o[d0][r] * rli[r]); }
  if (lse != nullptr && hi == 0) lse[(long)(wid * 32 + r32) * ldl] = m_reg * scale + __logf(l_reg);
}

__device__ __forceinline__ void glds16(const void* gsrc, unsigned lds_dst) { unsigned keep;
  asm volatile("s_mov_b32 %0, m0\n\ts_mov_b32 m0, %2\n\ts_nop 0\n\tglobal_load_lds_dwordx4 %1, off\n\ts_mov_b32 m0, %0" : "=&s"(keep) : "v"(gsrc), "s"(lds_dst) : "memory"); }
#define WAIT_BAR(N) asm volatile("s_waitcnt vmcnt(" #N ") lgkmcnt(0)\n\ts_barrier" ::: "memory")
#define WAIT_BAR2(N0, N) do { if (wid == 0) WAIT_BAR(N0); else WAIT_BAR(N); } while (0)
#ifndef MLA_LA
#define MLA_LA 1
#endif
#ifndef MLA_PP_LA
#define MLA_PP_LA 6
#endif
constexpr int MLA_KSLOT = 64 * 400, MLA_KTILE = 64 * 192 * 2, MLA_VSLOT = 64 * 128 * 2, MLA_K0 = 0, MLA_V0 = 3 * MLA_KSLOT, MLA_WS = MLA_V0 + 3 * MLA_VSLOT, MLA_LDS = MLA_WS + 8 * 256;
template <int MODE = 0> __device__ __forceinline__ void mla_unit(const bf16_t* Qb, const bf16_t* Kh, const bf16_t* Vh, bf16_t* Ob, long ldo, int NT, float scale, ATT_LAS char* lds, int wave_s, bool do_store = true) {
  int tid_l = wave_s * 64 + mk_lane(); asm volatile("" : "+v"(tid_l));
  const int tid = tid_l, wid = __builtin_amdgcn_readfirstlane(tid >> 6), lane = tid & 63, r32 = lane & 31, hi = lane >> 5;
  const unsigned lds0 = (unsigned)(uintptr_t)lds;
  ATT_LAS float* wsf = (ATT_LAS float*)(lds + MLA_WS) + wid * 64; ATT_LAS float* li_l = wsf; ATT_LAS float* al_l = wsf + 32;
  const float C = scale * 1.4426950408889634f, thr_raw = 8.0f / scale;
  int ksrc[4], vsrc[2];
#pragma unroll
  for (int i = 0; i < 4; ++i) { const int gch = 64 * (wid + 8 * i) + lane, row = gch / 25, cc = gch % 25; ksrc[i] = row * 384 + (cc < 24 ? cc * 16 : 0); }
#pragma unroll
  for (int i = 0; i < 2; ++i) { const int B = 1024 * (2 * wid + i) + 16 * lane, sub = B >> 9, e = (B & 511) >> 1, kk = (sub >> 2) * 8 + (e >> 5), c = (sub & 3) * 32 + (e & 31);
    const int k = (kk & ~0xC) | ((kk & 4) << 1) | ((kk & 8) >> 1); vsrc[i] = (k * 128 + c) * 2; }
#define DMA_K(t, slot) do { const int t_ = (t) < NT ? (t) : NT - 1; const char* g_ = (const char*)Kh + (long)t_ * MLA_KTILE; \
    _Pragma("unroll") for (int i_ = 0; i_ < 4; ++i_) if ((i_ < 3 || wid == 0) && !(MODE & 2)) glds16(g_ + ksrc[i_], (unsigned)__builtin_amdgcn_readfirstlane(lds0 + MLA_K0 + (slot) * MLA_KSLOT + 1024 * (wid + 8 * i_))); } while (0)
#define DMA_V(t, slot) do { const int t_ = (t) < NT ? (t) : NT - 1; const char* g_ = (const char*)Vh + (long)t_ * MLA_VSLOT; \
    _Pragma("unroll") for (int i_ = 0; i_ < 2; ++i_) if (!(MODE & 2)) glds16(g_ + vsrc[i_], (unsigned)__builtin_amdgcn_readfirstlane(lds0 + MLA_V0 + (slot) * MLA_VSLOT + 1024 * (2 * wid + i_))); } while (0)
  DMA_K(0, 0); DMA_V(0, 0); DMA_K(1, 1); DMA_V(1, 1); DMA_K(2, 2);
  bf16x8 qr[12];
  { const bf16_t* Qw = Qb + (long)(wid * 32 + r32) * 192 + hi * 8;
#pragma unroll
    for (int d0 = 0; d0 < 12; ++d0) qr[d0] = *(const bf16x8*)(Qw + d0 * 16); }
  float m_reg = -1e30f, l_reg = 0.f; f32x16 o[4] = {};
  const int vb0 = (int)(lds0 + MLA_V0) + v_rd_base(lane);
  f32x16 pA0, pA1, pB0, pB1; float mnA, mnB, alA, alB; bf16x8 pa0, pa1, pa2, pa3;
#define RESC(a) do { if (__any((a) < 1.f)) { if (hi == 0) al_l[r32] = (a); asm volatile("s_waitcnt lgkmcnt(0)" ::: "memory"); \
    _Pragma("unroll") for (int d = 0; d < 4; ++d) _Pragma("unroll") for (int r = 0; r < 16; ++r) o[d][r] *= al_l[crow(r, hi)]; } } while (0)
  WAIT_BAR(0);
  if (wid >= 4) __builtin_amdgcn_s_setprio(1);
  qkt<192, MLA_LA>(pA0, pA1, lds + MLA_K0, qr, r32, hi); partialSM<1>(pA0, pA1, m_reg, mnA, alA, C, thr_raw);
  WAIT_BAR(0);
  int s_m1 = 0, s_0 = 1, s_p1 = 2;
#define ROT() do { const int t_ = s_m1; s_m1 = s_0; s_0 = s_p1; s_p1 = t_; } while (0)
#define STEP(X0, X1, mnX, alX, Y0, Y1, alY, j) do { \
    SBAR(); qkt<192, MLA_LA>(X0, X1, lds + MLA_K0 + s_0 * MLA_KSLOT, qr, r32, hi); \
    if (MODE & 1) { pa0 = __builtin_bit_cast(bf16x8, (u32x4){__float_as_uint(Y0[0]), __float_as_uint(Y0[1]), __float_as_uint(Y0[2]), __float_as_uint(Y0[3])}); pa1 = __builtin_bit_cast(bf16x8, (u32x4){__float_as_uint(Y0[4]), __float_as_uint(Y0[5]), __float_as_uint(Y0[6]), __float_as_uint(Y0[7])}); \
      pa2 = __builtin_bit_cast(bf16x8, (u32x4){__float_as_uint(Y1[0]), __float_as_uint(Y1[1]), __float_as_uint(Y1[2]), __float_as_uint(Y1[3])}); pa3 = __builtin_bit_cast(bf16x8, (u32x4){__float_as_uint(Y1[4]), __float_as_uint(Y1[5]), __float_as_uint(Y1[6]), __float_as_uint(Y1[7])}); } \
    else finishSM(Y0, Y1, alY, l_reg, pa0, pa1, pa2, pa3); SBAR(); \
    DMA_K((j) + 2, s_m1); SBAR(); \
    pv_d0(o, vb0 + s_m1 * MLA_VSLOT, pa0, pa1, pa2, pa3); if (MODE & 1) { alX = 1.f; } else partialSM<1>(X0, X1, m_reg, mnX, alX, C, thr_raw); SBAR(); \
    DMA_V((j) + 1, s_p1); \
    WAIT_BAR2(6, 5); RESC(alX); ROT(); } while (0)
  for (int j = 1; j + 1 < NT; j += 2) {
    STEP(pB0, pB1, mnB, alB, pA0, pA1, alA, j);
    STEP(pA0, pA1, mnA, alA, pB0, pB1, alB, j + 1);
  }
  STEP(pB0, pB1, mnB, alB, pA0, pA1, alA, NT - 1);
  finishSM(pB0, pB1, alB, l_reg, pa0, pa1, pa2, pa3); SBAR();
  pv_d0(o, vb0 + s_m1 * MLA_VSLOT, pa0, pa1, pa2, pa3);
  __builtin_amdgcn_s_setprio(0);
  (void)mnA; (void)mnB;
#undef STEP
#undef ROT
#undef RESC
#undef DMA_K
#undef DMA_V
  if (hi == 0) li_l[r32] = l_reg;
  WAIT_BAR(0);
  float rli[16];
#pragma unroll
  for (int r = 0; r < 16; ++r) rli[r] = __builtin_amdgcn_rcpf(li_l[crow(r, hi)]);
  ATT_LAS bf16_t* stg = (ATT_LAS bf16_t*)(lds + MLA_K0) + wid * 4096;
#pragma unroll
  for (int r = 0; r < 16; ++r) { const int orow = crow(r, hi);
#pragma unroll
    for (int d0 = 0; d0 < 4; ++d0) stg[orow * 128 + d0 * 32 + r32] = f2bf(o[d0][r] * rli[r]); }
  asm volatile("s_waitcnt lgkmcnt(0)" ::: "memory");
  bf16_t* Ow = Ob + (long)(wid * 32) * ldo;
#pragma unroll
  for (int i = 0; i < 8; ++i) { const int row = i * 4 + (lane >> 4), ch = lane & 15; const u32x4 v = *(const ATT_LAS u32x4*)(stg + row * 128 + ch * 8); if (do_store) *(u32x4*)(Ow + (long)row * ldo + ch * 8) = v; }
  WAIT_BAR(0);
}

__device__ __forceinline__ void mla_unit_pp(const bf16_t* Qb, const bf16_t* Kh, const bf16_t* Vh, bf16_t* Ob, long ldo, int NT, float scale, ATT_LAS char* lds, int wave_s) {
  int tid_l = wave_s * 64 + mk_lane(); asm volatile("" : "+v"(tid_l));
  const int tid = tid_l, wid = __builtin_amdgcn_readfirstlane(tid >> 6), lane = tid & 63, r32 = lane & 31, hi = lane >> 5;
  const bool H1 = wid >= 4;
  const unsigned lds0 = (unsigned)(uintptr_t)lds;
  ATT_LAS float* wsf = (ATT_LAS float*)(lds + MLA_WS) + wid * 64; ATT_LAS float* li_l = wsf; ATT_LAS float* al_l = wsf + 32;
  const float C = scale * 1.4426950408889634f, thr_raw = 8.0f / scale;
  int ksrc[4], vsrc[2];
#pragma unroll
  for (int i = 0; i < 4; ++i) { const int gch = 64 * (wid + 8 * i) + lane, row = gch / 25, cc = gch % 25; ksrc[i] = row * 384 + (cc < 24 ? cc * 16 : 0); }
#pragma unroll
  for (int i = 0; i < 2; ++i) { const int B = 1024 * (2 * wid + i) + 16 * lane, sub = B >> 9, e = (B & 511) >> 1, kk = (sub >> 2) * 8 + (e >> 5), c = (sub & 3) * 32 + (e & 31);
    const int k = (kk & ~0xC) | ((kk & 4) << 1) | ((kk & 8) >> 1); vsrc[i] = (k * 128 + c) * 2; }
#define DMA_T(t, slot) do { const int t_ = (t) < NT ? (t) : NT - 1; const char* gk_ = (const char*)Kh + (long)t_ * MLA_KTILE; const char* gv_ = (const char*)Vh + (long)t_ * MLA_VSLOT; \
    _Pragma("unroll") for (int i_ = 0; i_ < 4; ++i_) if (i_ < 3 || wid == 0) glds16(gk_ + ksrc[i_], (unsigned)__builtin_amdgcn_readfirstlane(lds0 + MLA_K0 + (slot) * MLA_KSLOT + 1024 * (wid + 8 * i_))); \
    _Pragma("unroll") for (int i_ = 0; i_ < 2; ++i_) glds16(gv_ + vsrc[i_], (unsigned)__builtin_amdgcn_readfirstlane(lds0 + MLA_V0 + (slot) * MLA_VSLOT + 1024 * (2 * wid + i_))); } while (0)
  DMA_T(0, 0); DMA_T(1, 1);
  bf16x8 qr[12];
  { const bf16_t* Qw = Qb + (long)(wid * 32 + r32) * 192 + hi * 8;
#pragma unroll
    for (int d0 = 0; d0 < 12; ++d0) qr[d0] = *(const bf16x8*)(Qw + d0 * 16); }
  float m_reg = -1e30f, l_reg = 0.f; f32x16 o[4] = {};
  const int vb0 = (int)(lds0 + MLA_V0) + v_rd_base(lane);
  WAIT_BAR(0);
  if (H1) WAIT_BAR2(6, 5);
  int s_0 = 0, s_2 = 2;
  for (int j = 0; j < NT; ++j) {
    if (H1) DMA_T(j + 2, s_2);
    f32x16 p0, p1; float mn, alpha;
    SBAR(); __builtin_amdgcn_s_setprio(1);
    qkt<192, MLA_PP_LA>(p0, p1, lds + MLA_K0 + s_0 * MLA_KSLOT, qr, r32, hi);
    __builtin_amdgcn_s_setprio(0);
    partialSM<1>(p0, p1, m_reg, mn, alpha, C, thr_raw); (void)mn;
    WAIT_BAR2(6, 5);
    if (!H1) DMA_T(j + 2, s_2);
    bf16x8 pa0, pa1, pa2, pa3; finishSM(p0, p1, alpha, l_reg, pa0, pa1, pa2, pa3);
    if (__any(alpha < 1.f)) { if (hi == 0) al_l[r32] = alpha; asm volatile("s_waitcnt lgkmcnt(0)" ::: "memory");
#pragma unroll
      for (int d = 0; d < 4; ++d)
#pragma unroll
        for (int r = 0; r < 16; ++r) o[d][r] *= al_l[crow(r, hi)]; }
    SBAR(); __builtin_amdgcn_s_setprio(1);
    pv_d0_la(o, vb0 + s_0 * MLA_VSLOT, pa0, pa1, pa2, pa3);
    __builtin_amdgcn_s_setprio(0);
    WAIT_BAR2(6, 5);
    s_2 = s_0; s_0 = (s_0 == 2) ? 0 : s_0 + 1;
  }
  if (!H1) WAIT_BAR2(6, 5);
#undef DMA_T
  if (hi == 0) li_l[r32] = l_reg;
  WAIT_BAR(0);
  float rli[16];
#pragma unroll
  for (int r = 0; r < 16; ++r) rli[r] = __builtin_amdgcn_rcpf(li_l[crow(r, hi)]);
  ATT_LAS bf16_t* stg = (ATT_LAS bf16_t*)(lds + MLA_K0) + wid * 4096;
#pragma unroll
  for (int r = 0; r < 16; ++r) { const int orow = crow(r, hi);
#pragma unroll
    for (int d0 = 0; d0 < 4; ++d0) stg[orow * 128 + d0 * 32 + r32] = f2bf(o[d0][r] * rli[r]); }
  asm volatile("s_waitcnt lgkmcnt(0)" ::: "memory");
  bf16_t* Ow = Ob + (long)(wid * 32) * ldo;
#pragma unroll
  for (int i = 0; i < 8; ++i) { const int row = i * 4 + (lane >> 4), ch = lane & 15; const u32x4 v = *(const ATT_LAS u32x4*)(stg + row * 128 + ch * 8); *(u32x4*)(Ow + (long)row * ldo + ch * 8) = v; }
  WAIT_BAR(0);
}

constexpr int DIL_KB = 64 * 272, DIL_SLOT = DIL_KB + 16384, DIL_WS = 3 * DIL_SLOT, DIL_STG = DIL_WS + 8 * 256, DIL_LDS = DIL_STG + 8 * 4096;
__device__ __forceinline__ void dil_unit(const bf16_t* Qs, const bf16_t* Ks, const bf16_t* Vs, bf16_t* Os, float* lses, long ld, long ldl, int qb_first, int nqb, int L64, float scale, ATT_LAS char* lds, int wave_s, bool dry = false) {
  int tid_l = wave_s * 64 + mk_lane(); asm volatile("" : "+v"(tid_l));
  const int tid = tid_l, wid = __builtin_amdgcn_readfirstlane(tid >> 6), lane = tid & 63, r32 = lane & 31, hi = lane >> 5, pair = wid >> 1, sub = wid & 1;
  const unsigned lds0 = (unsigned)(uintptr_t)lds;
  ATT_LAS float* wsf = (ATT_LAS float*)(lds + DIL_WS) + wid * 64; ATT_LAS float* li_l = wsf; ATT_LAS float* al_l = wsf + 32;
  ATT_LAS bf16_t* stg = (ATT_LAS bf16_t*)(lds + DIL_STG) + wid * 2048;
  const float C = scale * 1.4426950408889634f, thr_raw = 8.0f / scale;
  const int kt_lo = qb_first > 0 ? qb_first - 1 : 0, qb_end = qb_first + nqb, kt_hi = qb_end + 1 < L64 ? qb_end + 1 : L64;
  const long ld2 = ld * 2, ts = 64 * ld2;
  long koff[3], voff[2];
#pragma unroll
  for (int i = 0; i < 3; ++i) { const int gch = 64 * (wid + 8 * i) + lane, row = gch / 17, cc = gch % 17; koff[i] = row * ld2 + (cc < 16 ? cc * 16 : 0); }
#pragma unroll
  for (int i = 0; i < 2; ++i) { const int B = 1024 * (2 * wid + i) + 16 * lane, sb = B >> 9, e = (B & 511) >> 1, kk = (sb >> 2) * 8 + (e >> 5), c = (sb & 3) * 32 + (e & 31);
    const int k = (kk & ~0xC) | ((kk & 4) << 1) | ((kk & 8) >> 1); voff[i] = k * ld2 + c * 2; }
#define DMA_T(t, slot) do { const int t_ = (t) < kt_hi ? (t) : kt_hi - 1; const char* gk_ = (const char*)Ks + t_ * ts; const char* gv_ = (const char*)Vs + t_ * ts; \
    _Pragma("unroll") for (int i_ = 0; i_ < 3; ++i_) if (i_ < 2 || wid == 0) glds16(gk_ + koff[i_], (unsigned)__builtin_amdgcn_readfirstlane(lds0 + (slot) * DIL_SLOT + 1024 * (wid + 8 * i_))); \
    _Pragma("unroll") for (int i_ = 0; i_ < 2; ++i_) glds16(gv_ + voff[i_], (unsigned)__builtin_amdgcn_readfirstlane(lds0 + (slot) * DIL_SLOT + DIL_KB + 1024 * (2 * wid + i_))); } while (0)
  DMA_T(kt_lo, 0); DMA_T(kt_lo + 1, 1);
  int qb = qb_first + pair; bool have = qb < qb_end;
  bf16x8 qr[8];
#define QLOAD() do { const bf16_t* Qw_ = Qs + (long)(qb * 64 + sub * 32 + r32) * ld + hi * 8; \
    _Pragma("unroll") for (int d0 = 0; d0 < 8; ++d0) qr[d0] = *(const bf16x8*)(Qw_ + d0 * 16); } while (0)
#define QPIN() do { _Pragma("unroll") for (int d0 = 0; d0 < 8; ++d0) asm volatile("" : "+v"(qr[d0])); } while (0)
  if (have) QLOAD();
  float m_reg = -1e30f, l_reg = 0.f; f32x16 o[4] = {};
  const int qi = sub * 32 + r32;
  const int vb0 = (int)lds0 + DIL_KB + v_rd_base(lane);
#define BLOCK_EPI() do { if (hi == 0) li_l[r32] = l_reg; asm volatile("s_waitcnt lgkmcnt(0)" ::: "memory"); \
    float rli[16]; _Pragma("unroll") for (int r = 0; r < 16; ++r) rli[r] = __builtin_amdgcn_rcpf(li_l[crow(r, hi)]); \
    bf16_t* Ow_ = Os + (long)(qb * 64 + sub * 32) * ld; \
    _Pragma("unroll") for (int hf = 0; hf < 2; ++hf) { \
      _Pragma("unroll") for (int r = 0; r < 16; ++r) { const int orow = crow(r, hi); \
        _Pragma("unroll") for (int dd = 0; dd < 2; ++dd) stg[orow * 64 + dd * 32 + r32] = f2bf(o[hf * 2 + dd][r] * rli[r]); } \
      asm volatile("s_waitcnt lgkmcnt(0)" ::: "memory"); \
      _Pragma("unroll") for (int i = 0; i < 4; ++i) { const int row = i * 8 + (lane >> 3), ch = lane & 7; const u32x4 v = *(const ATT_LAS u32x4*)(stg + row * 64 + ch * 8); \
        if (!dry) *(u32x4*)(Ow_ + (long)row * ld + hf * 64 + ch * 8) = v; } \
      asm volatile("s_waitcnt lgkmcnt(0)" ::: "memory"); } \
    if (hi == 0 && !dry) lses[(long)(qb * 64 + sub * 32 + r32) * ldl] = m_reg * scale + __logf(l_reg); } while (0)
  WAIT_BAR(0);
  int s_0 = 0, s_1 = 1, s_2 = 2;
  for (int t = kt_lo; t < kt_hi; ++t) {
    if (have && t >= qb - 1 && t <= qb + 1) {
      f32x16 p0, p1; qkt<128>(p0, p1, lds + s_0 * DIL_SLOT, qr, r32, hi);
      if (t == qb - 1) {
#pragma unroll
        for (int r = 0; r < 16; ++r) { const int k0 = crow(r, hi); if (k0 < qi) p0[r] = -1e30f; if (k0 + 32 < qi) p1[r] = -1e30f; }
      } else if (t == qb + 1) {
#pragma unroll
        for (int r = 0; r < 16; ++r) { const int k0 = crow(r, hi); if (k0 > qi) p0[r] = -1e30f; if (k0 + 32 > qi) p1[r] = -1e30f; }
      }
      float mn, alpha; partialSM<1>(p0, p1, m_reg, mn, alpha, C, thr_raw); (void)mn;
      bf16x8 pa0, pa1, pa2, pa3; finishSM(p0, p1, alpha, l_reg, pa0, pa1, pa2, pa3);
      if (__any(alpha < 1.f)) { if (hi == 0) al_l[r32] = alpha; asm volatile("s_waitcnt lgkmcnt(0)" ::: "memory");
#pragma unroll
        for (int d = 0; d < 4; ++d)
#pragma unroll
          for (int r = 0; r < 16; ++r) o[d][r] *= al_l[crow(r, hi)]; }
      pv_d0(o, vb0 + s_0 * DIL_SLOT, pa0, pa1, pa2, pa3);
    } else if (have && t == qb + 2) {
      BLOCK_EPI();
      qb += 4; have = qb < qb_end; m_reg = -1e30f; l_reg = 0.f;
#pragma unroll
      for (int d = 0; d < 4; ++d) o[d] = f32x16{};
      if (have) { QLOAD(); QPIN(); }
    }
    DMA_T(t + 2, s_2);
    WAIT_BAR2(5, 4);
    { const int t_ = s_0; s_0 = s_1; s_1 = s_2; s_2 = t_; }
  }
  if (have) BLOCK_EPI();
  WAIT_BAR(0);
#undef DMA_T
#undef QLOAD
#undef QPIN
#undef BLOCK_EPI
}
#undef WAIT_BAR
#undef SBAR
}

#define LAS __attribute__((address_space(3)))
typedef unsigned short bf16;
typedef float f32x4 __attribute__((ext_vector_type(4)));
typedef unsigned v4u __attribute__((ext_vector_type(4)));
typedef unsigned v2u __attribute__((ext_vector_type(2)));
typedef short bf16x8 __attribute__((ext_vector_type(8)));

constexpr int NWAVES = 8, NTHR = 512;
constexpr int BATCH = 8, SEQ = 8192, DM = 1024, M = BATCH * SEQ, FF = 4096;
#ifndef MK_NCH
#define MK_NCH 4
#endif
constexpr int NCH = MK_NCH, MH = M / NCH, BPC = BATCH / NCH;
constexpr int NQKV = 9216;
constexpr size_t MiB = 1u << 20;
constexpr size_t WS_WQKV = 1 * MiB, WS_WOA = 19 * MiB, WS_W1 = 21 * MiB, WS_W2 = 37 * MiB, WS_WIN = 53 * MiB, WS_WQB = 54 * MiB, WS_WKVB = 55 * MiB, WS_WOB = 56 * MiB;
constexpr size_t WS_COS128 = 58 * MiB, WS_SIN128 = 60 * MiB, WS_COS64 = 62 * MiB, WS_SIN64 = 63 * MiB;
constexpr size_t WS_LSE = 64 * MiB, WS_SSR = 67 * MiB;
constexpr size_t WS_RS = 68 * MiB, WS_RS2 = 70 * MiB;
constexpr size_t WS_HN = 128 * MiB;
constexpr size_t WS_QKVH = 256 * MiB;
constexpr size_t WS_ACT = 256 * MiB;
constexpr size_t WS_CQN = 256 * MiB, WS_CKVN = 288 * MiB, WS_KR = 320 * MiB;
constexpr size_t WS_Q = 384 * MiB, WS_K = 576 * MiB, WS_V = 768 * MiB;
constexpr size_t WS_AO = 896 * MiB;
constexpr size_t WS_END = 1024 * MiB;
constexpr int RING_BYTES = 131072, XCH_OFF = RING_BYTES, LDS_BYTES = 147456;

#define RLX_AGENT __ATOMIC_RELAXED, __HIP_MEMORY_SCOPE_AGENT
#define XB_TMO      128
#define XB_XCNT(j)  (256  + 64 * (j))
#define XB_XSUB(j)  (1280 + 64 * (j))
#define XB_XGEN(j)  (2304 + 64 * (j))
#define XB_TOP      3328
#define XB_TOPGEN   3392
#define XCD_BAR_WORDS 3456
#define XB_SPIN_CAP (1u << 18)

__device__ __forceinline__ unsigned xb_ld(unsigned* p)              { return __hip_atomic_load(p, __ATOMIC_RELAXED, __HIP_MEMORY_SCOPE_AGENT); }
__device__ __forceinline__ unsigned xb_add(unsigned* p, unsigned v) { return __hip_atomic_fetch_add(p, v, __ATOMIC_RELAXED, __HIP_MEMORY_SCOPE_AGENT); }
__device__ __forceinline__ unsigned xb_xcc_id() { return (unsigned)__builtin_amdgcn_s_getreg((3 << 11) | 20) & 0xFu; }
#define XB_SPIN(cond, bar) do { unsigned _sp = 0; while (cond) { __builtin_amdgcn_s_sleep(1); \
    if ((++_sp & 255u) == 0u) { if (xb_ld(&(bar)[XB_TMO])) break; if (_sp > XB_SPIN_CAP) { atomicAdd(&(bar)[XB_TMO], 1u); break; } } } } while (0)

struct XcdBarrier {
    unsigned* bar; unsigned x; int wave;
    volatile LAS unsigned* st;
};

__device__ __forceinline__ XcdBarrier xcd_barrier_post(unsigned* bar, volatile LAS unsigned* st, int wave_s) {
    XcdBarrier b; b.bar = bar; b.x = xb_xcc_id(); b.st = st; b.wave = wave_s;
    if (wave_s == 0 && mk_lane() == 0) (void)xb_add(&bar[XB_XCNT(b.x)], 1u);
    return b;
}
__device__ __forceinline__ void xcd_barrier_complete(unsigned* bar, unsigned x, unsigned& nloc, unsigned& nx) {
    const unsigned G = gridDim.x * gridDim.y * gridDim.z;
    unsigned sum, cnt, mine, sp = 0u;
    for (;;) {
        sum = 0u; cnt = 0u; mine = 0u;
#pragma unroll
        for (unsigned j = 0; j < 16; ++j) { const unsigned c = xb_ld(&bar[XB_XCNT(j)]); sum += c; cnt += (c > 0u) ? 1u : 0u; mine = (j == x) ? c : mine; }
        if (sum == G) break;
        __builtin_amdgcn_s_sleep(1);
        if ((++sp & 255u) == 0u) { if (xb_ld(&bar[XB_TMO])) break; if (sp > XB_SPIN_CAP) { atomicAdd(&bar[XB_TMO], 1u); break; } }
    }
    nloc = mine > 0u ? mine : 1u; nx = cnt > 0u ? cnt : 1u;
}

__device__ __forceinline__ void xcd_barrier(const XcdBarrier& b) {
    asm volatile("s_waitcnt vmcnt(0)" ::: "memory");
    __syncthreads();
    if (b.wave == 0 && mk_lane() == 0) {
        unsigned* bar = b.bar;
        __builtin_amdgcn_s_waitcnt(0);
        unsigned nloc = b.st[0], nx = b.st[1];
        if (nloc == 0u) { xcd_barrier_complete(bar, b.x, nloc, nx); b.st[0] = nloc; b.st[1] = nx; }
        const unsigned old = xb_add(&bar[XB_XSUB(b.x)], 1u);
        const unsigned gen = old / nloc;
        if (old + 1u == (gen + 1u) * nloc) {
            __builtin_amdgcn_fence(__ATOMIC_RELEASE, "agent");
            asm volatile("s_waitcnt vmcnt(0)" ::: "memory");
            const unsigned og = xb_add(&bar[XB_TOP], 1u);
            const unsigned tg = og / nx;
            if (og + 1u == (tg + 1u) * nx) xb_add(&bar[XB_TOPGEN], 1u);
            else XB_SPIN(xb_ld(&bar[XB_TOPGEN]) == tg, bar);
            __builtin_amdgcn_fence(__ATOMIC_ACQUIRE, "agent");
            xb_add(&bar[XB_XGEN(b.x)], 1u);
            asm volatile("s_waitcnt vmcnt(0)" ::: "memory");
        } else {
            XB_SPIN(xb_ld(&bar[XB_XGEN(b.x)]) == gen, bar);
            __builtin_amdgcn_fence(__ATOMIC_ACQUIRE, "agent");
            asm volatile("s_waitcnt vmcnt(0)" ::: "memory");
        }
    }
    __syncthreads();
}

constexpr size_t WS_BAR = 0, BAR_ZERO_BYTES = 16384;

#ifndef STAG_SLEEPS
#define STAG_SLEEPS 1
#endif
__device__ __forceinline__ void stagger(int bx) { if (STAG_SLEEPS > 0) for (int i = 0; i < bx; ++i) __builtin_amdgcn_s_sleep(STAG_SLEEPS); }
__device__ __forceinline__ unsigned char* ws_fresh(unsigned char* w) { asm volatile("" : "+s"(w)); return w; }
struct Params {
  const float* x; const float* norm_mix; const float* norm_ffn; const float* a_w_qkv; const float* a_q_gain; const float* a_k_gain; const float* a_w_o;
  const float* b_w_in; const float* b_q_a_gain; const float* b_w_qb; const float* b_kv_a_gain; const float* b_w_kvb; const float* b_q_gain; const float* b_k_gain; const float* b_w_o;
  const float* ffn_w1; const float* ffn_w2; float* out; unsigned char* ws;
};

__device__ __forceinline__ unsigned f2bf_rne(float f) { unsigned u = __builtin_bit_cast(unsigned, f); return (u + 0x7fffu + ((u >> 16) & 1u)) >> 16; }
__device__ __forceinline__ unsigned pk2(float lo, float hi) { return f2bf_rne(lo) | (f2bf_rne(hi) << 16); }
__device__ __forceinline__ float wave_sum(float v) {
#pragma unroll
  for (int o = 1; o < 64; o <<= 1) v += __shfl_xor(v, o);
  return v;
}
__device__ __forceinline__ int rope_perm128(int p) { const int wc = p >> 5, fq = (p >> 3) & 3, n = (p >> 2) & 1, j = p & 3; return 16 * wc + 4 * fq + j + 64 * n; }
__device__ __forceinline__ int rope_perm64(int p) { const int wc = p >> 5, fq = (p >> 3) & 3, n = (p >> 2) & 1, j = p & 3; return wc >= 2 ? -1 : 16 * wc + 4 * fq + j + 32 * n; }
template <int MAP> __device__ __forceinline__ int src_col(int n) {
  if (MAP == 1) { if (n >= 6144) return n; const int p = n & 127; return (n - p) + rope_perm128(p); }
  if (MAP == 2) { if (n < 384) return n; const int q = rope_perm64(n - 384); return q < 0 ? -1 : 384 + q; }
  if (MAP == 3) { const int h = n >> 8, p = n & 255; if (p < 128) return h * 192 + p; const int q = rope_perm64(p - 128); return q < 0 ? -1 : h * 192 + 128 + q; }
  if (MAP == 4) { const int p = n & 255, bj = p >> 7, wc = (p >> 5) & 3, i = p & 31; return (n - p) + wc * 64 + bj * 32 + i; }
  return n;
}
template <int MAP> __device__ __forceinline__ void wt_convert(const float* W, int Klog, int Nlog, int Kphys, int Nphys, bf16* WT, int gw, int NGW, int lane, const float* gain = nullptr) {
  const int nkb = Kphys / 8, nnb = Nphys / 64;
#pragma unroll 4
  for (int it = gw; it < nkb * nnb; it += NGW) {
    const int nb = it % nnb, kb = it / nnb, n = nb * 64 + lane, src = src_col<MAP>(n), k0 = kb * 8;
    float v[8];
#pragma unroll
    for (int i = 0; i < 8; ++i) v[i] = (src >= 0 && k0 + i < Klog) ? W[(size_t)(k0 + i) * Nlog + src] : 0.f;
    if (gain != nullptr) {
#pragma unroll
      for (int i = 0; i < 8; ++i) v[i] *= gain[k0 + i]; }
    v4u o; o.x = pk2(v[0], v[1]); o.y = pk2(v[2], v[3]); o.z = pk2(v[4], v[5]); o.w = pk2(v[6], v[7]);
    *(v4u*)(WT + (size_t)n * Kphys + k0) = o;
  }
}
__device__ __forceinline__ void rope_table(float* cosT, float* sinT, int half_d, int gtid, int NGT) {
  for (int id = gtid; id < SEQ * half_d; id += NGT) {
    const int pos = id / half_d, i = id % half_d;
    const float freq = powf(10000.0f, -(float)i / (float)half_d);
    const float angf = (float)pos * freq;
    const double a = (double)angf, k = rint(a * 0.15915494309189535), red = a - k * 6.283185307179586;
    const float r = (float)red;
    cosT[id] = cosf(r); sinT[id] = sinf(r);
  }
}
__device__ __forceinline__ void xb_rows(const float* src, bf16* dst, float* rs, int gw, int NGW, int lane) {
#pragma unroll 4
  for (int row = gw; row < M; row += NGW) {
    const f32x4* xr = (const f32x4*)(src + (size_t)row * DM) + lane;
    f32x4 v[4]; float s = 0.f;
#pragma unroll
    for (int j = 0; j < 4; ++j) { v[j] = xr[64 * j]; s += (v[j][0] * v[j][0] + v[j][1] * v[j][1]) + (v[j][2] * v[j][2] + v[j][3] * v[j][3]); }
    s = wave_sum(s);
    v2u* o8 = (v2u*)(dst + (size_t)row * DM) + lane;
#pragma unroll
    for (int j = 0; j < 4; ++j) { v2u w; w.x = pk2(v[j][0], v[j][1]); w.y = pk2(v[j][2], v[j][3]); o8[64 * j] = w; }
    if (lane < 4) rs[(size_t)row * 4 + lane] = lane == 0 ? s : 0.f;
  }
}
__device__ __forceinline__ void merge_half(const bf16* qkvh, const float* lse, bf16* ao_half, int gtid, int NGT) {
  for (int id = gtid; id < MH * 128; id += NGT) {
    const int tok = id >> 7, c8 = id & 127, h = c8 >> 4;
    const float l0 = lse[((size_t)0 * MH + tok) * 8 + h], l1 = lse[((size_t)1 * MH + tok) * 8 + h], l2 = lse[((size_t)2 * MH + tok) * 8 + h];
    const float mx = fmaxf(l0, fmaxf(l1, l2));
    float w0 = __expf(l0 - mx), w1 = __expf(l1 - mx), w2 = __expf(l2 - mx);
    const float inv = 1.0f / (w0 + w1 + w2); w0 *= inv; w1 *= inv; w2 *= inv;
    const bf16* p = qkvh + (size_t)tok * NQKV + c8 * 8;
    const v4u a = *(const v4u*)p, b = *(const v4u*)(p + 1024), c = *(const v4u*)(p + 2048);
    v4u o;
#pragma unroll
    for (int e = 0; e < 4; ++e) {
      const float alo = __uint_as_float(a[e] << 16), ahi = __uint_as_float(a[e] & 0xffff0000u);
      const float blo = __uint_as_float(b[e] << 16), bhi = __uint_as_float(b[e] & 0xffff0000u);
      const float clo = __uint_as_float(c[e] << 16), chi = __uint_as_float(c[e] & 0xffff0000u);
      o[e] = pk2(w0 * alo + w1 * blo + w2 * clo, w0 * ahi + w1 * bhi + w2 * chi);
    }
    *(v4u*)(ao_half + (size_t)tok * DM + c8 * 8) = o;
  }
}

__global__ void __launch_bounds__(NTHR) fwd_megakernel(Params p) {
  extern __shared__ __attribute__((aligned(16))) unsigned char lds_raw[];
  cg::grid_group grid = cg::this_grid();
  LAS unsigned char* lds = (LAS unsigned char*)lds_raw;
  LAS float* XP = (LAS float*)(lds + XCH_OFF);
  const int G = gridDim.x, bx = blockIdx.x, NGW = G * NWAVES, NGT = G * NTHR;
  volatile LAS unsigned* bst = (volatile LAS unsigned*)(lds + XCH_OFF + 8192);
  const int wave_s = __builtin_amdgcn_readfirstlane((int)threadIdx.x >> 6);
  if (wave_s == 0 && mk_lane() < 4) bst[mk_lane()] = 0u;
  __syncthreads();
  XcdBarrier xbar = xcd_barrier_post((unsigned*)(p.ws + WS_BAR), bst, wave_s);
#define GRID_BAR() xcd_barrier(xbar)
#define FRESH_IDS() int tid_f = wave_s * 64 + mk_lane(); asm volatile("" : "+v"(tid_f)); const int lane = tid_f & 63, gw = bx * NWAVES + wave_s, gtid = bx * NTHR + tid_f; (void)lane; (void)gw; (void)gtid
  unsigned char* ws = p.ws;
  bf16* WQKV = (bf16*)(ws + WS_WQKV); bf16* WOA = (bf16*)(ws + WS_WOA); bf16* W1 = (bf16*)(ws + WS_W1); bf16* W2 = (bf16*)(ws + WS_W2);
  bf16* WIN = (bf16*)(ws + WS_WIN); bf16* WQB = (bf16*)(ws + WS_WQB); bf16* WKVB = (bf16*)(ws + WS_WKVB); bf16* WOB = (bf16*)(ws + WS_WOB);
  float* COS128 = (float*)(ws + WS_COS128); float* SIN128 = (float*)(ws + WS_SIN128); float* COS64 = (float*)(ws + WS_COS64); float* SIN64 = (float*)(ws + WS_SIN64);
  float* LSE = (float*)(ws + WS_LSE); float* SSR = (float*)(ws + WS_SSR);
  bf16* HN = (bf16*)(ws + WS_HN); float* RS = (float*)(ws + WS_RS); float* RS2 = (float*)(ws + WS_RS2); bf16* QKVH = (bf16*)(ws + WS_QKVH); bf16* ACT = (bf16*)(ws + WS_ACT);
  bf16* CQN = (bf16*)(ws + WS_CQN); bf16* CKVN = (bf16*)(ws + WS_CKVN); float* KR = (float*)(ws + WS_KR);
  bf16* QB = (bf16*)(ws + WS_Q); bf16* KB = (bf16*)(ws + WS_K); bf16* VB = (bf16*)(ws + WS_V); bf16* AO = (bf16*)(ws + WS_AO);

#ifndef SEL
#define SEL 0xffff
#endif
#ifndef PROBE_EW_REPS
#define PROBE_EW_REPS 1
#endif
#ifndef PROBE_GEMM_REPS
#define PROBE_GEMM_REPS 1
#endif
#if SEL & 1
  for (int rep_ = 0; rep_ < PROBE_EW_REPS; ++rep_)
  { FRESH_IDS();
  wt_convert<1>(p.a_w_qkv, DM, NQKV, DM, NQKV, WQKV, gw, NGW, lane, p.norm_mix);
  wt_convert<0>(p.a_w_o, DM, DM, DM, DM, WOA, gw, NGW, lane);
  wt_convert<0>(p.ffn_w1, DM, FF, DM, FF, W1, gw, NGW, lane, p.norm_ffn);
  wt_convert<0>(p.ffn_w1 + (size_t)DM * FF, DM, FF, DM, FF, W1 + (size_t)DM * FF, gw, NGW, lane, p.norm_ffn + DM);
  wt_convert<0>(p.ffn_w2, FF, DM, FF, DM, W2, gw, NGW, lane);
  wt_convert<0>(p.ffn_w2 + (size_t)DM * FF, FF, DM, FF, DM, W2 + (size_t)DM * FF, gw, NGW, lane);
  wt_convert<2>(p.b_w_in, DM, 448, DM, 512, WIN, gw, NGW, lane, p.norm_mix + DM);
  wt_convert<3>(p.b_w_qb, 256, 1536, 256, 2048, WQB, gw, NGW, lane);
  wt_convert<0>(p.b_w_kvb, 128, 2048, 256, 2048, WKVB, gw, NGW, lane);
  wt_convert<0>(p.b_w_o, DM, DM, DM, DM, WOB, gw, NGW, lane);
  rope_table(COS128, SIN128, 64, gtid, NGT);
  rope_table(COS64, SIN64, 32, gtid, NGT);
  xb_rows(p.x, HN, RS, gw, NGW, lane); }
#endif
  grid.sync();

#ifdef PROBE_EXTRA_SYNCS
  for (int i_ = 0; i_ < PROBE_EXTRA_SYNCS; ++i_) grid.sync();
#endif
  for (int layer = 0; layer < 2; ++layer) {
    if (layer == 0) {
      for (int half = 0; half < NCH; ++half) {
        for (int rep_ = 0; rep_ < PROBE_GEMM_REPS; ++rep_)
        { pg8::Gemm g{HN + (size_t)half * MH * DM, WQKV, MH, NQKV, DM}; pg8::StaticOrder S; S.init(MH, NQKV, G, bx);
          pg8::EpiQKVA E{QKVH, p.a_q_gain, p.a_k_gain, COS128, SIN128, XP, RS, half * MH};
          pg8::gemm_phase<pg8::EpiQKVA, pg8::StaticOrder, true, true>(lds, g, S, E, wave_s); }
        GRID_BAR();
        int uid0 = bx; asm volatile("" : "+s"(uid0));
        for (int uid = uid0; uid < BPC * 256; uid += G) {
          int g, r, nqb, L64, rem;
          if (uid < BPC * 64) { g = 0; r = 1; nqb = 16; L64 = 128; rem = uid; } else if (uid < BPC * 128) { g = 1; r = 4; nqb = 16; L64 = 32; rem = uid - BPC * 64; } else { g = 2; r = 16; nqb = 8; L64 = 8; rem = uid - BPC * 128; }
          const int per = (g == 2) ? 16 : 8, sub_i = rem % per, bhh = rem / per, h = bhh & 7, bl = bhh >> 3;
          const int nch = L64 / nqb, c = sub_i / nch, ch = sub_i % nch;
          const long ld = (long)r * NQKV;
          const bf16* qp = QKVH + ((size_t)bl * SEQ + c) * NQKV + g * 1024 + h * 128;
          att::dil_unit(qp, qp + 3072, qp + 6144, (bf16*)qp, LSE + ((size_t)g * MH + (size_t)bl * SEQ + c) * 8 + h, ld, (long)r * 8, ch * nqb, nqb, L64, 0.08838834764831845f, (LAS char*)lds, wave_s);
        }
        GRID_BAR();
        for (int rep_ = 0; rep_ < PROBE_EW_REPS; ++rep_) { FRESH_IDS(); merge_half(QKVH, LSE, AO + (size_t)half * MH * DM, gtid, NGT); }
        GRID_BAR();
      }
    } else {
#if SEL & 16
      for (int rep_ = 0; rep_ < PROBE_GEMM_REPS; ++rep_)
      { pg8::Gemm g{HN, WIN, M, 512, DM}; pg8::StaticOrder S; S.init(M, 512, G, bx);
        pg8::EpiLat E{CQN, CKVN, KR, SSR, p.b_q_a_gain, p.b_kv_a_gain, p.b_k_gain, COS64, SIN64, XP, RS};
        pg8::gemm_phase<pg8::EpiLat, pg8::StaticOrder, true, true>(lds, g, S, E, wave_s); }
#endif
      GRID_BAR();
#if SEL & 32
      for (int rep_ = 0; rep_ < PROBE_GEMM_REPS; ++rep_) {
      { pg8::Gemm g{CQN, WQB, M, 2048, 256}; pg8::StaticOrder S; S.init(M, 2048, G, bx);
        pg8::EpiQB E{QB, p.b_q_gain, COS64, SIN64, XP};
        pg8::gemm_phase<pg8::EpiQB, pg8::StaticOrder, true, true>(lds, g, S, E, wave_s); }
#if SEL & 64
      { pg8::Gemm g{CKVN, WKVB, M, 2048, 256}; pg8::StaticOrder S; S.init(M, 2048, G, bx);
        pg8::EpiKVB E{KB, VB, p.b_k_gain, KR, SSR, XP};
        pg8::gemm_phase<pg8::EpiKVB, pg8::StaticOrder, true, true>(lds, g, S, E, wave_s); }
      }
#endif
#endif
      GRID_BAR();
#if SEL & 128
#ifndef PROBE_MLA_REPS
#define PROBE_MLA_REPS 1
#endif
      for (int rep_ = 0; rep_ < PROBE_MLA_REPS; ++rep_)
      { const int xcd = bx & 7, loc = bx >> 3;
        for (int i = 0; ; ++i) {
          int bh, qb;
          if (G == 256) { if (i >= 8) break; bh = i * 8 + xcd; qb = loc; }
          else { const int uid = i * G + bx; if (uid >= 64 * 32) break; bh = uid >> 5; qb = uid & 31; }
          const int b = bh >> 3, h = bh & 7;
#ifndef PROBE_MLA_MODE
#define PROBE_MLA_MODE 0
#endif
          if (PROBE_MLA_REPS > 1 && rep_ == 0)
          att::mla_unit<PROBE_MLA_MODE>(QB + ((size_t)bh * SEQ + 256 * qb) * 192, KB + (size_t)bh * SEQ * 192, VB + (size_t)bh * SEQ * 128,
                        AO + ((size_t)b * SEQ + 256 * qb) * DM + h * 128, DM, SEQ / 64, 0.07216878364870322f, (LAS char*)lds, wave_s, p.ws == nullptr);
          else
          att::mla_unit_pp(QB + ((size_t)bh * SEQ + 256 * qb) * 192, KB + (size_t)bh * SEQ * 192, VB + (size_t)bh * SEQ * 128,
                        AO + ((size_t)b * SEQ + 256 * qb) * DM + h * 128, DM, SEQ / 64, 0.07216878364870322f, (LAS char*)lds, wave_s);
        } }
#endif
      GRID_BAR();
    }
    { pg8::Gemm g{AO, layer == 0 ? WOA : WOB, M, DM, DM}; pg8::StaticOrder S; S.init(M, DM, G, bx);
      pg8::EpiResB E{HN, HN, RS2, XP, nullptr};
      pg8::gemm_phase<pg8::EpiResB, pg8::StaticOrder, true, true>(lds, g, S, E, wave_s); }
    GRID_BAR();
#ifndef PROBE_FFN1_REPS
#define PROBE_FFN1_REPS 1
#endif
#ifdef STAG_FFN1
    for (int i_ = 0; i_ < bx; ++i_) __builtin_amdgcn_s_sleep(STAG_FFN1);
#endif
    for (int rep_ = 0; rep_ < PROBE_FFN1_REPS; ++rep_)
    { pg8::Gemm g{HN, W1 + (size_t)layer * DM * FF, M, FF, DM}; pg8::StaticOrder S; S.init(M, FF, G, bx);
      pg8::EpiRelu2 E{ACT, FF, (PROBE_FFN1_REPS > 1 && rep_ == 0) ? 1 : 0};
      pg8::gemm_phase<pg8::EpiRelu2, pg8::StaticOrder, true, true>(lds, g, S, E, wave_s); }
    GRID_BAR();
    if (layer == 0) {
      { pg8::Gemm g{ACT, W2, M, DM, FF}; pg8::StaticOrder S; S.init(M, DM, G, bx);
        pg8::EpiResB E{HN, HN, RS, XP, RS2};
        pg8::gemm_phase<pg8::EpiResB, pg8::StaticOrder, true, true>(lds, g, S, E, wave_s); }
      GRID_BAR();
    } else {
      pg8::Gemm g{ACT, W2 + (size_t)DM * FF, M, DM, FF}; pg8::StaticOrder S; S.init(M, DM, G, bx);
      pg8::EpiResF E{HN, p.out, RS2};
      pg8::gemm_phase<pg8::EpiResF, pg8::StaticOrder, true, true>(lds, g, S, E, wave_s);
    }
  }
}

extern "C" void kernel_launch(void* const* d_in, const int* in_sizes, int n_in, void* d_out, int out_size, void* d_ws, size_t ws_size, hipStream_t stream) {
  static int grid_blocks = 0;
  if (grid_blocks == 0) {
    if (n_in != 17 || in_sizes[0] != M * DM || out_size != M * DM || ws_size < WS_END) {
      fprintf(stderr, "kernel_launch: unexpected shapes: n_in %d in0 %d out %d ws %zu (need >= %zu)\n", n_in, n_in > 0 ? in_sizes[0] : -1, out_size, ws_size, (size_t)WS_END); grid_blocks = -1; return; }
    int dev = 0, cus = 0, per_cu = 0;
    hipGetDevice(&dev); hipDeviceGetAttribute(&cus, hipDeviceAttributeMultiprocessorCount, dev);
    if (hipFuncSetAttribute((const void*)fwd_megakernel, hipFuncAttributeMaxDynamicSharedMemorySize, LDS_BYTES) != hipSuccess) { fprintf(stderr, "kernel_launch: hipFuncSetAttribute failed\n"); grid_blocks = -1; return; }
    if (hipOccupancyMaxActiveBlocksPerMultiprocessor(&per_cu, (const void*)fwd_megakernel, NTHR, LDS_BYTES) != hipSuccess || per_cu < 1) { fprintf(stderr, "kernel_launch: occupancy query gives %d\n", per_cu); per_cu = 1; }
    (void)hipGetLastError();
    grid_blocks = cus * per_cu;
  }
  if (grid_blocks < 0) return;
  Params p{};
  p.x = (const float*)d_in[0]; p.norm_mix = (const float*)d_in[1]; p.norm_ffn = (const float*)d_in[2]; p.a_w_qkv = (const float*)d_in[3]; p.a_q_gain = (const float*)d_in[4];
  p.a_k_gain = (const float*)d_in[5]; p.a_w_o = (const float*)d_in[6]; p.b_w_in = (const float*)d_in[7]; p.b_q_a_gain = (const float*)d_in[8]; p.b_w_qb = (const float*)d_in[9];
  p.b_kv_a_gain = (const float*)d_in[10]; p.b_w_kvb = (const float*)d_in[11]; p.b_q_gain = (const float*)d_in[12]; p.b_k_gain = (const float*)d_in[13]; p.b_w_o = (const float*)d_in[14];
  p.ffn_w1 = (const float*)d_in[15]; p.ffn_w2 = (const float*)d_in[16]; p.out = (float*)d_out; p.ws = (unsigned char*)d_ws;
  if (hipMemsetAsync((char*)d_ws + WS_BAR, 0, BAR_ZERO_BYTES, stream) != hipSuccess) { fprintf(stderr, "kernel_launch: memset failed\n"); return; }
  void* args[] = {&p};
  hipError_t e = hipLaunchCooperativeKernel((const void*)fwd_megakernel, dim3(grid_blocks), dim3(NTHR), args, LDS_BYTES, stream);
  if (e != hipSuccess) fprintf(stderr, "kernel_launch: cooperative launch failed: %s (grid %d)\n", hipGetErrorString(e), grid_blocks);
}
```

```cpp
#include <hip/hip_runtime.h>
#include <hip/hip_cooperative_groups.h>
#include <cstdio>
#include <cstdint>
namespace cg = cooperative_groups;
__device__ __forceinline__ int mk_lane() { int l; asm volatile("v_mbcnt_lo_u32_b32 %0, -1, 0\n\tv_mbcnt_hi_u32_b32 %0, -1, %0" : "=v"(l)); return l; }
namespace pg8 {
#define PG8_LAS __attribute__((address_space(3)))
typedef unsigned short bf16_t;
typedef short bf16x8 __attribute__((ext_vector_type(8)));
typedef float f32x4 __attribute__((ext_vector_type(4)));
typedef unsigned u32x4 __attribute__((ext_vector_type(4)));
constexpr int BM = 256, BK = 64, HALF = 128, HTB = HALF * BK * 2  , STAGE_BYTES = 8 * HTB, NXCD = 8, WGM = 8;

__host__ __device__ __forceinline__ int lds_byte(int r, int c) { const int st = (r >> 4) * 2 + (c >> 5), rr = r & 15, cc = c & 31, ob = rr * 64 + cc * 2; return st * 1024 + (ob ^ (((ob >> 9) & 1) << 5)); }
__host__ __device__ __forceinline__ void stage_rc(int b, int& R, int& C) { const int st = b / 1024, sb = b % 1024, swz = sb ^ (((sb >> 9) & 1) << 5); R = (st >> 1) * 16 + swz / 64; C = (st & 1) * 32 + (swz % 64) / 2; }
__host__ __device__ __forceinline__ int perm32(int rho) { const int n = rho >> 4, i = rho & 15; return 8 * (i >> 2) + 4 * n + (i & 3); }

struct Unit { int pm, pn; };
struct Gemm { const bf16_t* A; const bf16_t* Bt; int M, N, K; };

struct StaticOrder {
    int nM, nN, nwg, G, c;
    __host__ __device__ void init(int M, int N, int G_, int c_) { nM = M / BM; nN = N / BM; nwg = nM * nN; G = G_; c = c_; }
    __host__ __device__ bool next(int i, Unit& u) const {
        const long L = (long)i * G + c; if (L >= nwg) return false;
        int wgid = (int)L; { const int q = nwg / NXCD, r = nwg % NXCD, xcd = wgid % NXCD, off = wgid / NXCD; wgid = (xcd < r ? xcd * (q + 1) : r * (q + 1) + (xcd - r) * q) + off; }
        const int nig = WGM * nN, gid = wgid / nig, fm = gid * WGM, gsz = (nM - fm) < WGM ? (nM - fm) : WGM;
        u.pm = fm + ((wgid % nig) % gsz); u.pn = (wgid % nig) / gsz; return true;
    }
    __device__ __forceinline__ void a_ready(const Unit&) const {}
    __device__ __forceinline__ void done(const Unit&) const {}
};

__device__ __forceinline__ unsigned cvt_pk_bf16(float lo, float hi) { unsigned r; asm volatile("v_cvt_pk_bf16_f32 %0, %1, %2" : "=v"(r) : "v"(lo), "v"(hi)); return r; }
typedef float f32x2 __attribute__((ext_vector_type(2)));
typedef unsigned u32x2 __attribute__((ext_vector_type(2)));
constexpr float RMS_EPS = 1e-6f;
__device__ __forceinline__ u32x4 pack8(const f32x4& a, const f32x4& b) { u32x4 w; w.x = cvt_pk_bf16(a[0], a[1]); w.y = cvt_pk_bf16(a[2], a[3]); w.z = cvt_pk_bf16(b[0], b[1]); w.w = cvt_pk_bf16(b[2], b[3]); return w; }
__device__ __forceinline__ u32x2 pack4(const f32x4& a) { u32x2 w; w.x = cvt_pk_bf16(a[0], a[1]); w.y = cvt_pk_bf16(a[2], a[3]); return w; }
__device__ __forceinline__ float hsum4(const f32x4& t) { return (t[0] + t[1]) + (t[2] + t[3]); }


__device__ __forceinline__ float row_rstd(const float* rs, int row) { const f32x4 t = *(const f32x4*)(rs + (size_t)row * 4); return rsqrtf(hsum4(t) * (1.0f / 1024.0f) + RMS_EPS); }
__device__ __forceinline__ f32x4 bf2f_lo(const u32x2 u) { f32x4 r; r[0] = __uint_as_float(u.x << 16); r[1] = __uint_as_float(u.x & 0xffff0000u); r[2] = __uint_as_float(u.y << 16); r[3] = __uint_as_float(u.y & 0xffff0000u); return r; }
__device__ __forceinline__ void ss_exchange(const f32x4 (&acc)[2][2][4][2], int wr, int wc, int fr, int fq, PG8_LAS float* P) {
#pragma unroll
    for (int ai = 0; ai < 2; ++ai)
#pragma unroll
        for (int m = 0; m < 4; ++m)
#pragma unroll
            for (int bj = 0; bj < 2; ++bj) {
                const f32x4 a = acc[ai][bj][m][0], b = acc[ai][bj][m][1];
                float s = ((a[0] * a[0] + a[1] * a[1]) + (a[2] * a[2] + a[3] * a[3])) + ((b[0] * b[0] + b[1] * b[1]) + (b[2] * b[2] + b[3] * b[3]));
                s += __shfl_xor(s, 16); s += __shfl_xor(s, 32);
                if (fq == 0) P[((ai * HALF + wr * 64 + m * 16 + fr) * 2 + bj) * 4 + wc] = s;
            }
    asm volatile("s_waitcnt lgkmcnt(0)" ::: "memory"); __builtin_amdgcn_s_barrier(); asm volatile("" ::: "memory");
}

struct EpiResB {
    static constexpr bool PERM = true, AFTER_DRAIN = false;
    const bf16_t* base; bf16_t* out; float* rs; PG8_LAS float* P; const float* rs_in;
    __device__ __forceinline__ void operator()(const f32x4 (&acc)[2][2][4][2], const Unit& u, int wr, int wc, int fr, int fq) const {
        asm volatile("" : "+v"(fr), "+v"(fq));
        const int row0 = u.pm * BM + wr * 64 + fr, col0 = u.pn * BM + wc * 32 + 8 * fq;
        float r2[2][4];
#pragma unroll
        for (int ai = 0; ai < 2; ++ai)
#pragma unroll
            for (int m = 0; m < 4; ++m) { r2[ai][m] = 1.f; if (rs_in != nullptr) { const float r_ = row_rstd(rs_in, row0 + ai * HALF + m * 16); r2[ai][m] = r_ * r_; } }
#pragma unroll
        for (int ai = 0; ai < 2; ++ai) {
            u32x4 pre[4][2];
#pragma unroll
            for (int m = 0; m < 4; ++m)
#pragma unroll
                for (int bj = 0; bj < 2; ++bj) pre[m][bj] = *(const u32x4*)(base + (size_t)(row0 + ai * HALF + m * 16) * 1024 + col0 + bj * HALF);
#pragma unroll
            for (int m = 0; m < 4; ++m) { float ss = 0.f;
#pragma unroll
                for (int bj = 0; bj < 2; ++bj) { const u32x4 b = pre[m][bj];
                    const f32x4 x0 = bf2f_lo((u32x2){b.x, b.y}) + acc[ai][bj][m][0] * r2[ai][m], x1 = bf2f_lo((u32x2){b.z, b.w}) + acc[ai][bj][m][1] * r2[ai][m];
                    ss += ((x0[0] * x0[0] + x0[1] * x0[1]) + (x0[2] * x0[2] + x0[3] * x0[3])) + ((x1[0] * x1[0] + x1[1] * x1[1]) + (x1[2] * x1[2] + x1[3] * x1[3]));
                    *(u32x4*)(out + (size_t)(row0 + ai * HALF + m * 16) * 1024 + col0 + bj * HALF) = pack8(x0, x1); }
                ss += __shfl_xor(ss, 16); ss += __shfl_xor(ss, 32);
                if (fq == 0) P[(ai * HALF + wr * 64 + m * 16 + fr) * 4 + wc] = ss; }
            asm volatile("" ::: "memory"); }
        asm volatile("s_waitcnt lgkmcnt(0)" ::: "memory"); __builtin_amdgcn_s_barrier(); asm volatile("" ::: "memory");
        if (wr == 0) { const int rl = wc * 64 + fq * 16 + fr; const f32x4 t = *(const PG8_LAS f32x4*)(P + rl * 4); rs[(size_t)(u.pm * BM + rl) * 4 + u.pn] = hsum4(t); }
    }
};
struct EpiResF {
    static constexpr bool PERM = false, AFTER_DRAIN = false;
    const bf16_t* base; float* out; const float* rs_in;
    __device__ __forceinline__ void operator()(const f32x4 (&acc)[2][2][4][2], const Unit& u, int wr, int wc, int fr, int fq) const {
        asm volatile("" : "+v"(fr), "+v"(fq));
        const int col0 = u.pn * BM + wc * 32 + 4 * fq;
#pragma unroll
        for (int ai = 0; ai < 2; ++ai) {
            u32x2 pre[4][2][2]; float r2[4];
#pragma unroll
            for (int m = 0; m < 4; ++m) { const float r_ = row_rstd(rs_in, u.pm * BM + ai * HALF + wr * 64 + m * 16 + fr); r2[m] = r_ * r_; }
#pragma unroll
            for (int m = 0; m < 4; ++m) { const size_t off = (size_t)(u.pm * BM + ai * HALF + wr * 64 + m * 16 + fr) * 1024 + col0;
#pragma unroll
                for (int bj = 0; bj < 2; ++bj)
#pragma unroll
                    for (int n = 0; n < 2; ++n) pre[m][bj][n] = *(const u32x2*)(base + off + bj * HALF + n * 16); }
#pragma unroll
            for (int m = 0; m < 4; ++m) { const size_t off = (size_t)(u.pm * BM + ai * HALF + wr * 64 + m * 16 + fr) * 1024 + col0;
#pragma unroll
                for (int bj = 0; bj < 2; ++bj)
#pragma unroll
                    for (int n = 0; n < 2; ++n) *(f32x4*)(out + off + bj * HALF + n * 16) = bf2f_lo(pre[m][bj][n]) + acc[ai][bj][m][n] * r2[m]; }
            asm volatile("" ::: "memory"); }
    }
};
struct EpiRelu2 {
    static constexpr bool PERM = true, AFTER_DRAIN = false;
    bf16_t* O; int ldc; int dry;
    __device__ __forceinline__ void operator()(const f32x4 (&acc)[2][2][4][2], const Unit& u, int wr, int wc, int fr, int fq) const {
        asm volatile("" : "+v"(fr), "+v"(fq));
        if (dry == 2) { if (O == nullptr) *(f32x4*)O = acc[0][0][0][0] + acc[1][1][3][1]; return; }
        const int row0 = u.pm * BM + wr * 64 + fr, col0 = u.pn * BM + wc * 32 + 8 * fq;
#pragma unroll
        for (int ai = 0; ai < 2; ++ai)
#pragma unroll
            for (int m = 0; m < 4; ++m) { bf16_t* rowp = O + (size_t)(row0 + ai * HALF + m * 16) * ldc + col0;
#pragma unroll
                for (int bj = 0; bj < 2; ++bj) { f32x4 v0 = acc[ai][bj][m][0], v1 = acc[ai][bj][m][1];
                    v0 = __builtin_elementwise_max(v0, (f32x4){0.f, 0.f, 0.f, 0.f}); v1 = __builtin_elementwise_max(v1, (f32x4){0.f, 0.f, 0.f, 0.f});
                    v0 = v0 * v0; v1 = v1 * v1; const u32x4 w8_ = pack8(v0, v1); if (!dry) __builtin_nontemporal_store(w8_, (u32x4*)(rowp + bj * HALF)); } }
    }
};
struct EpiQKVA {
    static constexpr bool PERM = true, AFTER_DRAIN = false;
    bf16_t* O; const float* qg; const float* kg; const float* cosT; const float* sinT; PG8_LAS float* P; const float* rs; int rs_row0;
    __device__ __forceinline__ void operator()(const f32x4 (&acc)[2][2][4][2], const Unit& u, int wr, int wc, int fr, int fq) const {
        asm volatile("" : "+v"(fr), "+v"(fq));
        const int c0 = u.pn * BM, which = c0 / 3072;
        float rr[2][4];
#pragma unroll
        for (int ai = 0; ai < 2; ++ai)
#pragma unroll
            for (int m = 0; m < 4; ++m) rr[ai][m] = row_rstd(rs, rs_row0 + u.pm * BM + ai * HALF + wr * 64 + m * 16 + fr);
        if (which == 2) {
            const int row0 = u.pm * BM + wr * 64 + fr, col0 = c0 + wc * 32 + 8 * fq;
#pragma unroll
            for (int ai = 0; ai < 2; ++ai)
#pragma unroll
                for (int m = 0; m < 4; ++m) { bf16_t* rowp = O + (size_t)(row0 + ai * HALF + m * 16) * 9216 + col0;
#pragma unroll
                    for (int bj = 0; bj < 2; ++bj) *(u32x4*)(rowp + bj * HALF) = pack8(acc[ai][bj][m][0] * rr[ai][m], acc[ai][bj][m][1] * rr[ai][m]); }
            return;
        }
        const int g = (c0 % 3072) / 1024; const float* gain = (which == 0 ? qg : kg) + g * 128;
        const int hh = wc >> 1, dm = 32 * (wc & 1) + 8 * fq;
        const f32x4 g0a = *(const f32x4*)(gain + dm), g0b = *(const f32x4*)(gain + dm + 4), g1a = *(const f32x4*)(gain + 64 + dm), g1b = *(const f32x4*)(gain + 64 + dm + 4);
        typedef _Float16 h8 __attribute__((ext_vector_type(8)));
        h8 cs[4], sn[4];
#define QK_TAB(ai) do { _Pragma("unroll") for (int m = 0; m < 4; ++m) { const int pos = (u.pm * BM + (ai) * HALF + wr * 64 + m * 16 + fr) & 8191; \
            cs[m] = *(const h8*)((const _Float16*)cosT + pos * 64 + dm); sn[m] = *(const h8*)((const _Float16*)sinT + pos * 64 + dm); } } while (0)
        QK_TAB(0);
        ss_exchange(acc, wr, wc, fr, fq, P);
#pragma unroll
        for (int ai = 0; ai < 2; ++ai) {
            if (ai == 1) { asm volatile("" ::: "memory"); QK_TAB(1); }
#pragma unroll
            for (int m = 0; m < 4; ++m) { const int rl = ai * HALF + wr * 64 + m * 16 + fr, row = u.pm * BM + rl;
                const f32x4 t0 = *(const PG8_LAS f32x4*)(P + (rl * 2 + 0) * 4), t1 = *(const PG8_LAS f32x4*)(P + (rl * 2 + 1) * 4);
                const float ssh = hh ? ((t0[2] + t0[3]) + (t1[2] + t1[3])) : ((t0[0] + t0[1]) + (t1[0] + t1[1]));
                const float rw = rr[ai][m], rstd = rw * rsqrtf(rw * rw * ssh * (1.0f / 128.0f) + RMS_EPS);
                const h8 ch = cs[m], sh = sn[m];
                const f32x4 ca = {(float)ch[0], (float)ch[1], (float)ch[2], (float)ch[3]}, cb = {(float)ch[4], (float)ch[5], (float)ch[6], (float)ch[7]};
                const f32x4 sa = {(float)sh[0], (float)sh[1], (float)sh[2], (float)sh[3]}, sb = {(float)sh[4], (float)sh[5], (float)sh[6], (float)sh[7]};
                const f32x4 x1a = acc[ai][0][m][0] * rstd * g0a, x1b = acc[ai][0][m][1] * rstd * g0b, x2a = acc[ai][1][m][0] * rstd * g1a, x2b = acc[ai][1][m][1] * rstd * g1b;
                bf16_t* op = O + (size_t)row * 9216 + c0 + hh * 128 + dm;
                *(u32x4*)op = pack8(x1a * ca - x2a * sa, x1b * cb - x2b * sb);
                *(u32x4*)(op + 64) = pack8(x2a * ca + x1a * sa, x2b * cb + x1b * sb); }
        }
#undef QK_TAB
    }
};
struct EpiLat {
    static constexpr bool PERM = true, AFTER_DRAIN = false;
    bf16_t* cqn; bf16_t* ckvn; float* kr; float* ssr; const float* qag; const float* kvag; const float* kg; const float* cos64; const float* sin64; PG8_LAS float* P; const float* rs;
    __device__ __forceinline__ void operator()(const f32x4 (&acc)[2][2][4][2], const Unit& u, int wr, int wc, int fr, int fq) const {
        asm volatile("" : "+v"(fr), "+v"(fq));
        float rr[2][4];
#pragma unroll
        for (int ai = 0; ai < 2; ++ai)
#pragma unroll
            for (int m = 0; m < 4; ++m) rr[ai][m] = row_rstd(rs, u.pm * BM + ai * HALF + wr * 64 + m * 16 + fr);
        ss_exchange(acc, wr, wc, fr, fq, P);
        const int col0 = wc * 32 + 8 * fq;
        if (u.pn == 0) {
            f32x4 ga[2][2];
#pragma unroll
            for (int bj = 0; bj < 2; ++bj) { ga[bj][0] = *(const f32x4*)(qag + bj * HALF + col0); ga[bj][1] = *(const f32x4*)(qag + bj * HALF + col0 + 4); }
#pragma unroll
            for (int ai = 0; ai < 2; ++ai)
#pragma unroll
                for (int m = 0; m < 4; ++m) { const int rl = ai * HALF + wr * 64 + m * 16 + fr, row = u.pm * BM + rl;
                    const f32x4 t0 = *(const PG8_LAS f32x4*)(P + (rl * 2 + 0) * 4), t1 = *(const PG8_LAS f32x4*)(P + (rl * 2 + 1) * 4);
                    const float rw = rr[ai][m], rstd = rw * rsqrtf(rw * rw * (hsum4(t0) + hsum4(t1)) * (1.0f / 256.0f) + RMS_EPS);
#pragma unroll
                    for (int bj = 0; bj < 2; ++bj) *(u32x4*)(cqn + (size_t)row * 256 + bj * HALF + col0) = pack8(acc[ai][bj][m][0] * rstd * ga[bj][0], acc[ai][bj][m][1] * rstd * ga[bj][1]);
                    asm volatile("" ::: "memory"); }
        } else {
            const f32x4 gv0 = *(const f32x4*)(kvag + col0), gv1 = *(const f32x4*)(kvag + col0 + 4);
            const int i0 = (16 * wc + 4 * fq) & 31;
            const f32x4 gk0 = *(const f32x4*)(kg + 128 + i0), gk1 = *(const f32x4*)(kg + 160 + i0);
#pragma unroll
            for (int ai = 0; ai < 2; ++ai)
#pragma unroll
                for (int m = 0; m < 4; ++m) { const int rl = ai * HALF + wr * 64 + m * 16 + fr, row = u.pm * BM + rl, pos = row & 8191;
                    const f32x4 t0 = *(const PG8_LAS f32x4*)(P + (rl * 2 + 0) * 4), t1 = *(const PG8_LAS f32x4*)(P + (rl * 2 + 1) * 4);
                    const float rw = rr[ai][m], rstd = rw * rsqrtf(rw * rw * hsum4(t0) * (1.0f / 128.0f) + RMS_EPS);
                    { const u32x4 w8 = pack8(acc[ai][0][m][0] * rstd * gv0, acc[ai][0][m][1] * rstd * gv1);
                      *(u32x4*)(ckvn + (size_t)row * 256 + col0) = w8; *(u32x4*)(ckvn + (size_t)row * 256 + HALF + col0) = w8; }
                    if (wc < 2) { const f32x4 cs = *(const f32x4*)(cos64 + pos * 32 + i0), sn = *(const f32x4*)(sin64 + pos * 32 + i0);
                        const f32x4 x1 = acc[ai][1][m][0] * rw * gk0, x2 = acc[ai][1][m][1] * rw * gk1;
                        *(f32x4*)(kr + (size_t)row * 64 + i0) = x1 * cs - x2 * sn; *(f32x4*)(kr + (size_t)row * 64 + 32 + i0) = x2 * cs + x1 * sn; }
                    if (wc == 0 && fq == 0) ssr[row] = rw * rw * hsum4(t1);
                    asm volatile("" ::: "memory"); }
        }
    }
};
struct EpiQB {
    static constexpr bool PERM = true, AFTER_DRAIN = false;
    bf16_t* Q; const float* qg; const float* cos64; const float* sin64; PG8_LAS float* P;
    __device__ __forceinline__ void operator()(const f32x4 (&acc)[2][2][4][2], const Unit& u, int wr, int wc, int fr, int fq) const {
        asm volatile("" : "+v"(fr), "+v"(fq));
        const int h = u.pn, col0 = wc * 32 + 8 * fq, i0 = (16 * wc + 4 * fq) & 31;
        const f32x4 ga = *(const f32x4*)(qg + col0), gb = *(const f32x4*)(qg + col0 + 4), gr0 = *(const f32x4*)(qg + 128 + i0), gr1 = *(const f32x4*)(qg + 160 + i0);
        f32x4 csv[2][4], snv[2][4];
        if (wc < 2) {
#pragma unroll
            for (int ai = 0; ai < 2; ++ai)
#pragma unroll
                for (int m = 0; m < 4; ++m) { const int s_ = (u.pm * BM + ai * HALF + wr * 64 + m * 16 + fr) & 8191; csv[ai][m] = *(const f32x4*)(cos64 + s_ * 32 + i0); snv[ai][m] = *(const f32x4*)(sin64 + s_ * 32 + i0); }
        }
        ss_exchange(acc, wr, wc, fr, fq, P);
#pragma unroll
        for (int ai = 0; ai < 2; ++ai)
#pragma unroll
            for (int m = 0; m < 4; ++m) { const int rl = ai * HALF + wr * 64 + m * 16 + fr, row = u.pm * BM + rl, b = row >> 13, s = row & 8191;
                const f32x4 t0 = *(const PG8_LAS f32x4*)(P + (rl * 2 + 0) * 4), t1 = *(const PG8_LAS f32x4*)(P + (rl * 2 + 1) * 4);
                const float rstd = rsqrtf((hsum4(t0) + hsum4(t1)) * (1.0f / 192.0f) + RMS_EPS) * (0.07216878364870322f * 1.4426950408889634f);
                bf16_t* qp = Q + ((size_t)(b * 8 + h) * 8192 + s) * 192;
                *(u32x4*)(qp + col0) = pack8(acc[ai][0][m][0] * rstd * ga, acc[ai][0][m][1] * rstd * gb);
                if (wc < 2) { const f32x4 cs = csv[ai][m], sn = snv[ai][m];
                    const f32x4 x1 = acc[ai][1][m][0] * rstd * gr0, x2 = acc[ai][1][m][1] * rstd * gr1;
                    *(u32x2*)(qp + 128 + i0) = pack4(x1 * cs - x2 * sn); *(u32x2*)(qp + 160 + i0) = pack4(x2 * cs + x1 * sn); } }
    }
};
struct EpiKVB {
    static constexpr bool PERM = true, AFTER_DRAIN = false;
    bf16_t* K; bf16_t* V; const float* kg; const float* kr; const float* ssr; PG8_LAS float* P;
    __device__ __forceinline__ void operator()(const f32x4 (&acc)[2][2][4][2], const Unit& u, int wr, int wc, int fr, int fq) const {
        asm volatile("" : "+v"(fr), "+v"(fq));
        const int h = u.pn, col0 = wc * 32 + 8 * fq, c4 = 4 * (4 * wc + fq);
        const f32x4 ga = *(const f32x4*)(kg + col0), gb = *(const f32x4*)(kg + col0 + 4);
        f32x4 krv[2][4]; float ssv[2][4];
#pragma unroll
        for (int ai = 0; ai < 2; ++ai)
#pragma unroll
            for (int m = 0; m < 4; ++m) { const int row = u.pm * BM + ai * HALF + wr * 64 + m * 16 + fr; ssv[ai][m] = ssr[row]; krv[ai][m] = *(const f32x4*)(kr + (size_t)row * 64 + c4); }
        ss_exchange(acc, wr, wc, fr, fq, P);
#pragma unroll
        for (int ai = 0; ai < 2; ++ai)
#pragma unroll
            for (int m = 0; m < 4; ++m) { const int rl = ai * HALF + wr * 64 + m * 16 + fr, row = u.pm * BM + rl, b = row >> 13, s = row & 8191;
                const f32x4 t0 = *(const PG8_LAS f32x4*)(P + (rl * 2 + 0) * 4);
                const float rstd = rsqrtf((hsum4(t0) + ssv[ai][m]) * (1.0f / 192.0f) + RMS_EPS);
                const size_t tok = (size_t)(b * 8 + h) * 8192 + s;
                bf16_t* kp = K + tok * 192;
                *(u32x4*)(kp + col0) = pack8(acc[ai][0][m][0] * rstd * ga, acc[ai][0][m][1] * rstd * gb);
                const f32x4 r4 = krv[ai][m] * rstd;
                *(u32x2*)(kp + 128 + c4) = pack4(r4);
                *(u32x4*)(V + tok * 128 + col0) = pack8(acc[ai][1][m][0], acc[ai][1][m][1]); }
    }
};

template <class Epi, class Sched, bool ALIGN_EPI = false, bool SP2 = false>
__device__ __forceinline__ void gemm_phase(PG8_LAS unsigned char* lds, const Gemm g, const Sched& S, const Epi& E, int wave_s) {
    int tid_l = wave_s * 64 + mk_lane(); asm volatile("" : "+v"(tid_l));
    const int tid = tid_l, wid = __builtin_amdgcn_readfirstlane(tid >> 6), lane = tid & 63, wr = wid >> 2, wc = wid & 3, fr = lane & 15, fq = lane >> 4;
    int K_l = g.K; asm volatile("" : "+s"(K_l));
    const int K = K_l, nt = K / BK;
    unsigned voffA[2], voffB[2];
#pragma unroll
    for (int i = 0; i < 2; ++i) { int R, C; stage_rc(tid * 16 + i * 8192, R, C); const int Rb = Epi::PERM ? ((R & ~31) + perm32(R & 31)) : R;
        voffA[i] = (unsigned)(R * K + C) * 2u; voffB[i] = (unsigned)(Rb * K + C) * 2u; }
    const size_t kstep = (size_t)(BK * 2);
    const size_t hstep = (size_t)HALF * K * 2;
    const size_t tstep = 2 * hstep;
    const unsigned ldsw = (unsigned)wid * 1024u;
    const int aoff = lds_byte(wr * 64 + fr, fq * 8), boff = lds_byte(wc * 32 + fr, fq * 8);
#define PG8_SA(b, h) (((b) * 2 + (h)) * HTB)
#define PG8_SB(b, h) ((4 + (b) * 2 + (h)) * HTB)
#define PG8_STAGE(bufoff, gbase, voff) do { _Pragma("unroll") for (int _i = 0; _i < 2; ++_i) \
        __builtin_amdgcn_global_load_lds((const unsigned*)((const char*)(gbase) + (voff)[_i]), (PG8_LAS unsigned*)(lds + (bufoff) + ldsw + _i * 8192), 16, 0, 0); } while (0)
#define PG8_LDA(dst, b, h) do { _Pragma("unroll") for (int m = 0; m < 4; ++m) _Pragma("unroll") for (int k = 0; k < 2; ++k) dst[m][k] = *(const PG8_LAS bf16x8*)(lds + PG8_SA(b, h) + aoff + m * 2048 + k * 1024); } while (0)
#define PG8_LDB(dst, b, h) do { _Pragma("unroll") for (int n = 0; n < 2; ++n) _Pragma("unroll") for (int k = 0; k < 2; ++k) dst[n][k] = *(const PG8_LAS bf16x8*)(lds + PG8_SB(b, h) + boff + n * 2048 + k * 1024); } while (0)
#define PG8_MMA(ai, bj, At, Bt) do { __builtin_amdgcn_s_setprio(1); _Pragma("unroll") for (int m = 0; m < 4; ++m) _Pragma("unroll") for (int n = 0; n < 2; ++n) _Pragma("unroll") for (int k = 0; k < 2; ++k) \
        acc[ai][bj][m][n] = __builtin_amdgcn_mfma_f32_16x16x32_bf16(Bt[n][k], At[m][k], acc[ai][bj][m][n], 0, 0, 0); __builtin_amdgcn_s_setprio(0); } while (0)
#define PG8_WAIT_V(n) asm volatile("s_waitcnt vmcnt(" #n ")" ::: "memory")
#define PG8_WAIT_L(n) asm volatile("s_waitcnt lgkmcnt(" #n ")" ::: "memory")
#define PG8_BAR __builtin_amdgcn_s_barrier()
#define PG8_SCHED __builtin_amdgcn_sched_barrier(0)
    Unit cur, nxt; int ui = 0;
    if (!S.next(0, cur)) return;
    f32x4 acc[2][2][4][2];
#pragma unroll
    for (int a = 0; a < 2; ++a)
#pragma unroll
        for (int b = 0; b < 2; ++b)
#pragma unroll
            for (int m = 0; m < 4; ++m)
#pragma unroll
                for (int n = 0; n < 2; ++n) acc[a][b][m][n] = (f32x4){0.f, 0.f, 0.f, 0.f};
    bf16x8 At[4][2], B0[2][2], B1[2][2];
    const char* cA = (const char*)g.A + (size_t)cur.pm * tstep; const char* cB = (const char*)g.Bt + (size_t)cur.pn * tstep;
    S.a_ready(cur);
    if constexpr (SP2) {
        PG8_STAGE(PG8_SB(0, 0), cB, voffB); PG8_STAGE(PG8_SB(0, 1), cB + hstep, voffB); PG8_STAGE(PG8_SA(0, 0), cA, voffA); PG8_STAGE(PG8_SA(0, 1), cA + hstep, voffA);
        if (wr == 1) PG8_BAR;
        PG8_WAIT_V(2); PG8_BAR;
        PG8_STAGE(PG8_SB(1, 0), cB + kstep, voffB); PG8_STAGE(PG8_SA(1, 0), cA + kstep, voffA); PG8_STAGE(PG8_SB(1, 1), cB + hstep + kstep, voffB);
        PG8_WAIT_V(6); PG8_BAR;
    } else {
        PG8_STAGE(PG8_SB(0, 0), cB, voffB); PG8_STAGE(PG8_SA(0, 0), cA, voffA); PG8_STAGE(PG8_SB(0, 1), cB + hstep, voffB); PG8_STAGE(PG8_SA(0, 1), cA + hstep, voffA);
        if (wr == 1) PG8_BAR;
        PG8_WAIT_V(4); PG8_BAR;
        PG8_STAGE(PG8_SB(1, 0), cB + kstep, voffB); PG8_STAGE(PG8_SA(1, 0), cA + kstep, voffA); PG8_STAGE(PG8_SB(1, 1), cB + hstep + kstep, voffB);
        PG8_WAIT_V(6); PG8_BAR;
    }
    for (;;) {
        const bool has_next = S.next(ui + 1, nxt);
        const char* nA = has_next ? (const char*)g.A + (size_t)nxt.pm * tstep : cA; const char* nB = has_next ? (const char*)g.Bt + (size_t)nxt.pn * tstep : cB;
        for (int t = 0; t < nt; t += 2) {
            const bool last = (t == nt - 2);
            const char* a1 = cA + (size_t)(t + 1) * kstep;
            const char* a2 = last ? nA : cA + (size_t)(t + 2) * kstep; const char* b2 = last ? nB : cB + (size_t)(t + 2) * kstep;
            const char* a3 = a2 + kstep; const char* b3 = b2 + kstep;
            if (last && has_next) S.a_ready(nxt);
            if constexpr (SP2) {
            PG8_LDB(B0, 0, 0); PG8_LDB(B1, 0, 1); PG8_SCHED; PG8_LDA(At, 0, 0); PG8_STAGE(PG8_SA(1, 1), a1 + hstep, voffA);
            PG8_WAIT_V(8); PG8_WAIT_L(0); PG8_BAR; PG8_MMA(0, 0, At, B0); PG8_MMA(0, 1, At, B1); PG8_BAR; PG8_SCHED;
            PG8_LDA(At, 0, 1); PG8_STAGE(PG8_SB(0, 0), b2, voffB); PG8_STAGE(PG8_SB(0, 1), b2 + hstep, voffB); PG8_STAGE(PG8_SA(0, 0), a2, voffA);
            PG8_WAIT_V(8); PG8_WAIT_L(0); PG8_BAR; PG8_MMA(1, 0, At, B0); PG8_MMA(1, 1, At, B1); PG8_BAR; PG8_SCHED;
            PG8_LDB(B0, 1, 0); PG8_LDB(B1, 1, 1); PG8_SCHED; PG8_LDA(At, 1, 0); PG8_STAGE(PG8_SA(0, 1), a2 + hstep, voffA);
            PG8_WAIT_V(8); PG8_WAIT_L(0); PG8_BAR; PG8_MMA(0, 0, At, B0); PG8_MMA(0, 1, At, B1); PG8_BAR; PG8_SCHED;
            PG8_LDA(At, 1, 1); PG8_STAGE(PG8_SB(1, 0), b3, voffB); PG8_STAGE(PG8_SB(1, 1), b3 + hstep, voffB); PG8_STAGE(PG8_SA(1, 0), a3, voffA);
            PG8_WAIT_V(8); PG8_WAIT_L(0); PG8_BAR; PG8_MMA(1, 0, At, B0); PG8_MMA(1, 1, At, B1); PG8_BAR; PG8_SCHED;
            } else {
            PG8_LDB(B0, 0, 0); PG8_SCHED; PG8_LDA(At, 0, 0); PG8_STAGE(PG8_SA(1, 1), a1 + hstep, voffA);
            PG8_WAIT_L(8); PG8_BAR; PG8_WAIT_L(0); PG8_MMA(0, 0, At, B0); PG8_BAR; PG8_SCHED;
            PG8_LDB(B1, 0, 1); PG8_STAGE(PG8_SB(0, 0), b2, voffB);
            PG8_BAR; PG8_WAIT_L(0); PG8_MMA(0, 1, At, B1); PG8_BAR;
            PG8_LDA(At, 0, 1); PG8_STAGE(PG8_SA(0, 0), a2, voffA);
            PG8_BAR; PG8_WAIT_L(0); PG8_MMA(1, 0, At, B0); PG8_BAR; PG8_SCHED;
            PG8_STAGE(PG8_SB(0, 1), b2 + hstep, voffB);
            PG8_WAIT_V(6); PG8_BAR; PG8_MMA(1, 1, At, B1); PG8_BAR;
            PG8_LDB(B0, 1, 0); PG8_SCHED; PG8_LDA(At, 1, 0); PG8_STAGE(PG8_SA(0, 1), a2 + hstep, voffA);
            PG8_WAIT_L(8); PG8_BAR; PG8_WAIT_L(0); PG8_MMA(0, 0, At, B0); PG8_BAR; PG8_SCHED;
            PG8_LDB(B1, 1, 1); PG8_STAGE(PG8_SB(1, 0), b3, voffB);
            PG8_BAR; PG8_WAIT_L(0); PG8_MMA(0, 1, At, B1); PG8_BAR;
            PG8_LDA(At, 1, 1); PG8_STAGE(PG8_SA(1, 0), a3, voffA);
            PG8_BAR; PG8_WAIT_L(0); PG8_MMA(1, 0, At, B0); PG8_BAR; PG8_SCHED;
            PG8_STAGE(PG8_SB(1, 1), b3 + hstep, voffB);
            PG8_WAIT_V(6); PG8_BAR; PG8_MMA(1, 1, At, B1); PG8_BAR;
            }
        }
        if constexpr (ALIGN_EPI) { if (wr == 0) PG8_BAR; }
        if constexpr (!Epi::AFTER_DRAIN) { E(acc, cur, wr, wc, fr, fq); S.done(cur); }
        if (!has_next) break;
#pragma unroll
        for (int a = 0; a < 2; ++a)
#pragma unroll
            for (int b = 0; b < 2; ++b)
#pragma unroll
                for (int m = 0; m < 4; ++m)
#pragma unroll
                    for (int n = 0; n < 2; ++n) acc[a][b][m][n] = (f32x4){0.f, 0.f, 0.f, 0.f};
        cur = nxt; cA = nA; cB = nB; ++ui;
        if constexpr (ALIGN_EPI) { if (wr == 1) PG8_BAR; }
    }
    PG8_WAIT_V(0);
    if constexpr (!ALIGN_EPI) { if (wr == 0) PG8_BAR; }
    PG8_BAR;
    if constexpr (Epi::AFTER_DRAIN) { E.fused(acc, cur, wr, wc, fr, fq, lds, wid, lane); S.done(cur); }
#undef PG8_SA
#undef PG8_SB
#undef PG8_STAGE
#undef PG8_LDA
#undef PG8_LDB
#undef PG8_MMA
#undef PG8_WAIT_V
#undef PG8_WAIT_L
#undef PG8_BAR
#undef PG8_SCHED
}
}
namespace att {
#define ATT_LAS __attribute__((address_space(3)))
typedef unsigned short bf16_t;
typedef short bf16x8 __attribute__((ext_vector_type(8)));
typedef short s16x4 __attribute__((ext_vector_type(4)));
typedef float f32x16 __attribute__((ext_vector_type(16)));
typedef unsigned u32x4 __attribute__((ext_vector_type(4)));
#define SBAR() __builtin_amdgcn_sched_barrier(0)
__device__ __forceinline__ int crow(int r, int hi) { return (r & 3) + 8 * (r >> 2) + 4 * hi; }
__device__ __forceinline__ unsigned cvtpk(float lo, float hi) { unsigned r; asm volatile("v_cvt_pk_bf16_f32 %0, %1, %2" : "=v"(r) : "v"(lo), "v"(hi)); return r; }
__device__ __forceinline__ unsigned short f2bf(float f) { return (unsigned short)(cvtpk(f, f) & 0xffffu); }

template <int THRON>
__device__ __forceinline__ void partialSM(f32x16& p0, f32x16& p1, float& m_reg, float& mn, float& alpha, float C, float thr_raw) {
  float pmax = p0[0];
#pragma unroll
  for (int r = 1; r < 16; ++r) pmax = fmaxf(pmax, p0[r]);
#pragma unroll
  for (int r = 0; r < 16; ++r) pmax = fmaxf(pmax, p1[r]);
  { auto rr = __builtin_amdgcn_permlane32_swap(__float_as_uint(pmax), __float_as_uint(pmax), false, false);
    pmax = fmaxf(__uint_as_float(rr[0]), __uint_as_float(rr[1])); }
  if (THRON && __builtin_expect(__all(pmax - m_reg <= thr_raw), 1)) { mn = m_reg; alpha = 1.f; }
  else { mn = fmaxf(m_reg, pmax); alpha = __builtin_amdgcn_exp2f((m_reg - mn) * C); m_reg = mn; }
  const float mnC = -mn * C;
#pragma unroll
  for (int r = 0; r < 16; ++r) p0[r] = fmaf(p0[r], C, mnC);
#pragma unroll
  for (int r = 0; r < 16; ++r) p1[r] = fmaf(p1[r], C, mnC);
#pragma unroll
  for (int r = 0; r < 16; ++r) p0[r] = __builtin_amdgcn_exp2f(p0[r]);
}
__device__ __forceinline__ void partialSM_ref(f32x16& p0, f32x16& p1, float& mref, f32x16& negm, float& alpha, float thr2, bool first, bool check) {
  if (!check) { alpha = 1.f;
#pragma unroll
    for (int r = 0; r < 16; ++r) p0[r] = __builtin_amdgcn_exp2f(p0[r]);
    return; }
  float pmax = p0[0];
#pragma unroll
  for (int r = 1; r < 16; ++r) pmax = fmaxf(pmax, p0[r]);
#pragma unroll
  for (int r = 0; r < 16; ++r) pmax = fmaxf(pmax, p1[r]);
  { auto rr = __builtin_amdgcn_permlane32_swap(__float_as_uint(pmax), __float_as_uint(pmax), false, false);
    pmax = fmaxf(__uint_as_float(rr[0]), __uint_as_float(rr[1])); }
  if (!first && __builtin_expect(__all(pmax <= thr2), 1)) { alpha = 1.f; }
  else { const float dl = first ? pmax : fmaxf(pmax, 0.f); mref += dl; alpha = first ? 1.f : __builtin_amdgcn_exp2f(-dl);
#pragma unroll
    for (int r = 0; r < 16; ++r) { p0[r] -= dl; p1[r] -= dl; }
#pragma unroll
    for (int r = 0; r < 16; ++r) negm[r] = -mref; }
#pragma unroll
  for (int r = 0; r < 16; ++r) p0[r] = __builtin_amdgcn_exp2f(p0[r]);
}
__device__ __forceinline__ void finishSM(f32x16& p0, f32x16& p1, float alpha, float& l_reg, bf16x8& pa0, bf16x8& pa1, bf16x8& pa2, bf16x8& pa3) {
#pragma unroll
  for (int r = 0; r < 16; ++r) p1[r] = __builtin_amdgcn_exp2f(p1[r]);
  float ps = 0;
#pragma unroll
  for (int r = 0; r < 16; ++r) ps += p0[r];
#pragma unroll
  for (int r = 0; r < 16; ++r) ps += p1[r];
  { auto rr = __builtin_amdgcn_permlane32_swap(__float_as_uint(ps), __float_as_uint(ps), false, false);
    ps = __uint_as_float(rr[0]) + __uint_as_float(rr[1]); }
  l_reg = l_reg * alpha + ps;
#define PK4(P, BASE, OUT) do { unsigned a0 = cvtpk(P[BASE + 0], P[BASE + 1]), a1 = cvtpk(P[BASE + 2], P[BASE + 3]);   \
    unsigned b0 = cvtpk(P[BASE + 4], P[BASE + 5]), b1 = cvtpk(P[BASE + 6], P[BASE + 7]);                              \
    auto r0 = __builtin_amdgcn_permlane32_swap(a0, b0, false, false); auto r1 = __builtin_amdgcn_permlane32_swap(a1, b1, false, false); \
    u32x4 w = {r0[0], r1[0], r0[1], r1[1]}; OUT = __builtin_bit_cast(bf16x8, w); } while (0)
  PK4(p0, 0, pa0); PK4(p0, 8, pa1); PK4(p1, 0, pa2); PK4(p1, 8, pa3);
#undef PK4
}
__device__ __forceinline__ void finishSM_np(f32x16& p0, f32x16& p1, float alpha, float& l_reg, bf16x8& pa0, bf16x8& pa1, bf16x8& pa2, bf16x8& pa3) {
#pragma unroll
  for (int r = 0; r < 16; ++r) p1[r] = __builtin_amdgcn_exp2f(p1[r]);
  float ps = 0;
#pragma unroll
  for (int r = 0; r < 16; ++r) ps += p0[r];
#pragma unroll
  for (int r = 0; r < 16; ++r) ps += p1[r];
  { auto rr = __builtin_amdgcn_permlane32_swap(__float_as_uint(ps), __float_as_uint(ps), false, false);
    ps = __uint_as_float(rr[0]) + __uint_as_float(rr[1]); }
  l_reg = l_reg * alpha + ps;
#define PK8(P, BASE, OUT) do { u32x4 w = {cvtpk(P[BASE + 0], P[BASE + 1]), cvtpk(P[BASE + 2], P[BASE + 3]), cvtpk(P[BASE + 4], P[BASE + 5]), cvtpk(P[BASE + 6], P[BASE + 7])}; OUT = __builtin_bit_cast(bf16x8, w); } while (0)
  PK8(p0, 0, pa0); PK8(p0, 8, pa1); PK8(p1, 0, pa2); PK8(p1, 8, pa3);
#undef PK8
}
template <int DQK> __device__ __forceinline__ constexpr int kstride() { return DQK * 2 + 16; }
template <int DQK> __device__ __forceinline__ int kswz(int row, int colB) { return row * kstride<DQK>() + colB; }
template <int DQK, int LA = 2> __device__ __forceinline__ void qkt(f32x16& p0, f32x16& p1, const ATT_LAS char* Ks, const bf16x8* qr, int r32, int hi) {
  constexpr int N = DQK / 16;
  const ATT_LAS char* k0 = Ks + r32 * kstride<DQK>(); const ATT_LAS char* k1 = Ks + (32 + r32) * kstride<DQK>(); const int sw = 0;
  bf16x8 kf[N][2];
  p0 = f32x16{}; p1 = f32x16{};
#pragma unroll
  for (int d0 = 0; d0 < LA; ++d0) { const int cb = ((d0 * 16 + hi * 8) * 2) ^ sw; kf[d0][0] = *(const ATT_LAS bf16x8*)(k0 + cb); kf[d0][1] = *(const ATT_LAS bf16x8*)(k1 + cb); }
  SBAR();
#pragma unroll
  for (int d0 = 0; d0 < N; ++d0) {
    if (d0 + LA < N) { const int cb = (((d0 + LA) * 16 + hi * 8) * 2) ^ sw; kf[d0 + LA][0] = *(const ATT_LAS bf16x8*)(k0 + cb); kf[d0 + LA][1] = *(const ATT_LAS bf16x8*)(k1 + cb); }
    SBAR();
    p0 = __builtin_amdgcn_mfma_f32_32x32x16_bf16(kf[d0][0], qr[d0], p0, 0, 0, 0);
    p1 = __builtin_amdgcn_mfma_f32_32x32x16_bf16(kf[d0][1], qr[d0], p1, 0, 0, 0);
    SBAR();
  }
}
template <int DQK, int LA = 2> __device__ __forceinline__ void qkt_c(f32x16& p0, f32x16& p1, const ATT_LAS char* Ks, const bf16x8* qr, int r32, int hi, const f32x16& cinit) {
  constexpr int N = DQK / 16;
  const int rp = (r32 & ~0xC) | ((r32 & 4) << 1) | ((r32 & 8) >> 1);
  const ATT_LAS char* k0 = Ks + rp * kstride<DQK>(); const ATT_LAS char* k1 = Ks + (32 + rp) * kstride<DQK>(); const int sw = 0;
  bf16x8 kf[N][2];
  p0 = cinit; p1 = cinit;
#pragma unroll
  for (int d0 = 0; d0 < LA; ++d0) { const int cb = ((d0 * 16 + hi * 8) * 2) ^ sw; kf[d0][0] = *(const ATT_LAS bf16x8*)(k0 + cb); kf[d0][1] = *(const ATT_LAS bf16x8*)(k1 + cb); }
  SBAR();
#pragma unroll
  for (int d0 = 0; d0 < N; ++d0) {
    if (d0 + LA < N) { const int cb = (((d0 + LA) * 16 + hi * 8) * 2) ^ sw; kf[d0 + LA][0] = *(const ATT_LAS bf16x8*)(k0 + cb); kf[d0 + LA][1] = *(const ATT_LAS bf16x8*)(k1 + cb); }
    SBAR();
    p0 = __builtin_amdgcn_mfma_f32_32x32x16_bf16(kf[d0][0], qr[d0], p0, 0, 0, 0);
    p1 = __builtin_amdgcn_mfma_f32_32x32x16_bf16(kf[d0][1], qr[d0], p1, 0, 0, 0);
    SBAR();
  }
}
__device__ __forceinline__ int v_st(int k, int c) { const int kk = (k & ~0xC) | ((k & 4) << 1) | ((k & 8) >> 1); return ((kk >> 3) * 4 + (c >> 5)) * 512 + ((kk & 7) * 32 + (c & 31)) * 2; }
__device__ __forceinline__ int v_rd_base(int lane) { return ((lane & 3) << 3) | (((lane >> 2) & 3) << 6) | (((lane >> 4) & 1) << 5) | (((lane >> 5) & 1) << 8); }
constexpr int v_rd_off(int d0, int ks, int half) { return d0 * 512 + ks * 4096 + half * 2048; }
template <int OFF> __device__ __forceinline__ s16x4 tr_read(int vb) { s16x4 r; asm volatile("ds_read_b64_tr_b16 %0, %1 offset:%2" : "=&v"(r) : "v"(vb), "i"(OFF) : "memory"); return r; }
template <int D0> __device__ __forceinline__ void pv_one(f32x16& od, int vb, bf16x8 pa0, bf16x8 pa1, bf16x8 pa2, bf16x8 pa3) {
  const s16x4 l0 = tr_read<v_rd_off(D0, 0, 0)>(vb), h0 = tr_read<v_rd_off(D0, 0, 1)>(vb), l1 = tr_read<v_rd_off(D0, 1, 0)>(vb), h1 = tr_read<v_rd_off(D0, 1, 1)>(vb);
  const s16x4 l2 = tr_read<v_rd_off(D0, 2, 0)>(vb), h2 = tr_read<v_rd_off(D0, 2, 1)>(vb), l3 = tr_read<v_rd_off(D0, 3, 0)>(vb), h3 = tr_read<v_rd_off(D0, 3, 1)>(vb);
  asm volatile("s_waitcnt lgkmcnt(0)" ::: "memory"); SBAR();
#define PK(L, H) (bf16x8){L[0], L[1], L[2], L[3], H[0], H[1], H[2], H[3]}
  od = __builtin_amdgcn_mfma_f32_32x32x16_bf16(pa0, PK(l0, h0), od, 0, 0, 0);
  od = __builtin_amdgcn_mfma_f32_32x32x16_bf16(pa1, PK(l1, h1), od, 0, 0, 0);
  od = __builtin_amdgcn_mfma_f32_32x32x16_bf16(pa2, PK(l2, h2), od, 0, 0, 0);
  od = __builtin_amdgcn_mfma_f32_32x32x16_bf16(pa3, PK(l3, h3), od, 0, 0, 0);
#undef PK
}
__device__ __forceinline__ void pv_d0(f32x16* o, int vb, bf16x8 pa0, bf16x8 pa1, bf16x8 pa2, bf16x8 pa3) {
  pv_one<0>(o[0], vb, pa0, pa1, pa2, pa3); pv_one<1>(o[1], vb, pa0, pa1, pa2, pa3); pv_one<2>(o[2], vb, pa0, pa1, pa2, pa3); pv_one<3>(o[3], vb, pa0, pa1, pa2, pa3);
}

template <int D0> __device__ __forceinline__ void pv_reads(s16x4 (&l)[4], s16x4 (&h)[4], int vb) {
  l[0] = tr_read<v_rd_off(D0, 0, 0)>(vb); h[0] = tr_read<v_rd_off(D0, 0, 1)>(vb); l[1] = tr_read<v_rd_off(D0, 1, 0)>(vb); h[1] = tr_read<v_rd_off(D0, 1, 1)>(vb);
  l[2] = tr_read<v_rd_off(D0, 2, 0)>(vb); h[2] = tr_read<v_rd_off(D0, 2, 1)>(vb); l[3] = tr_read<v_rd_off(D0, 3, 0)>(vb); h[3] = tr_read<v_rd_off(D0, 3, 1)>(vb);
}
__device__ __forceinline__ void pv_mma(f32x16& od, const s16x4 (&l)[4], const s16x4 (&h)[4], bf16x8 pa0, bf16x8 pa1, bf16x8 pa2, bf16x8 pa3) {
#define PK(L, H) (bf16x8){L[0], L[1], L[2], L[3], H[0], H[1], H[2], H[3]}
  od = __builtin_amdgcn_mfma_f32_32x32x16_bf16(pa0, PK(l[0], h[0]), od, 0, 0, 0);
  od = __builtin_amdgcn_mfma_f32_32x32x16_bf16(pa1, PK(l[1], h[1]), od, 0, 0, 0);
  od = __builtin_amdgcn_mfma_f32_32x32x16_bf16(pa2, PK(l[2], h[2]), od, 0, 0, 0);
  od = __builtin_amdgcn_mfma_f32_32x32x16_bf16(pa3, PK(l[3], h[3]), od, 0, 0, 0);
#undef PK
}
__device__ __forceinline__ void pv_d0_la(f32x16* o, int vb, bf16x8 pa0, bf16x8 pa1, bf16x8 pa2, bf16x8 pa3) {
  s16x4 la[4], ha[4], lb[4], hb[4];
  pv_reads<0>(la, ha, vb); pv_reads<1>(lb, hb, vb);
  asm volatile("s_waitcnt lgkmcnt(8)" ::: "memory"); SBAR(); pv_mma(o[0], la, ha, pa0, pa1, pa2, pa3); SBAR();
  pv_reads<2>(la, ha, vb);
  asm volatile("s_waitcnt lgkmcnt(8)" ::: "memory"); SBAR(); pv_mma(o[1], lb, hb, pa0, pa1, pa2, pa3); SBAR();
  pv_reads<3>(lb, hb, vb);
  asm volatile("s_waitcnt lgkmcnt(8)" ::: "memory"); SBAR(); pv_mma(o[2], la, ha, pa0, pa1, pa2, pa3); SBAR();
  asm volatile("s_waitcnt lgkmcnt(0)" ::: "memory"); SBAR(); pv_mma(o[3], lb, hb, pa0, pa1, pa2, pa3);
}

template <int DQK, bool BAND>
__device__ __forceinline__ void attn_unit(const bf16_t* Qb, long ldq, const bf16_t* Kb, long ldk, const bf16_t* Vb, long ldv, bf16_t* Ob, long ldo, float* lse, long ldl,
                                          int kt0, int kt1, int qtile0, float scale, ATT_LAS char* lds, int wave_s) {
  constexpr int KB_BYTES = 64 * DQK * 2, VB_BYTES = 64 * 128 * 2, KCH = DQK / 8, NKC = DQK / 64;
  int tid_l = wave_s * 64 + mk_lane(); asm volatile("" : "+v"(tid_l));
  const int tid = tid_l, wid = __builtin_amdgcn_readfirstlane(tid >> 6), lane = tid & 63, r32 = lane & 31, hi = lane >> 5;
  ATT_LAS char* V_lds = lds; ATT_LAS char* K_lds = lds + 2 * VB_BYTES;
  ATT_LAS float* wsf = (ATT_LAS float*)(lds + 2 * VB_BYTES + 2 * KB_BYTES) + wid * 64; ATT_LAS float* li_l = wsf; ATT_LAS float* al_l = wsf + 32;
  const float C = scale * 1.4426950408889634f, thr_raw = 8.0f / scale;
  bf16x8 qr[DQK / 16];
  { const bf16_t* Qw = Qb + (long)(wid * 32 + r32) * ldq + hi * 8;
#pragma unroll
    for (int d0 = 0; d0 < DQK / 16; ++d0) qr[d0] = *(const bf16x8*)(Qw + d0 * 16); }
  float m_reg = -1e30f, l_reg = 0.f; f32x16 o[4] = {};
  const int qb = qtile0 + (wid >> 1), qi = (wid & 1) * 32 + r32;
  const int vb0 = (int)(unsigned)(uintptr_t)V_lds + v_rd_base(lane);
  bf16x8 ks[NKC], vs[2];
  const int vrow = tid >> 4, vcol = (tid & 15) * 8;
#define SLOAD(t) do { _Pragma("unroll") for (int i_ = 0; i_ < NKC; ++i_) { const int id_ = tid + 512 * i_, row_ = id_ / KCH, c8_ = id_ % KCH; ks[i_] = *(const bf16x8*)(Kb + (long)((t) * 64 + row_) * ldk + c8_ * 8); } \
    _Pragma("unroll") for (int i_ = 0; i_ < 2; ++i_) vs[i_] = *(const bf16x8*)(Vb + (long)((t) * 64 + vrow + 32 * i_) * ldv + vcol); } while (0)
#define SWRITE(b) do { _Pragma("unroll") for (int i_ = 0; i_ < NKC; ++i_) { const int id_ = tid + 512 * i_, row_ = id_ / KCH, c8_ = id_ % KCH; *(ATT_LAS bf16x8*)(K_lds + (b) * KB_BYTES + kswz<DQK>(row_, c8_ * 16)) = ks[i_]; } \
    _Pragma("unroll") for (int i_ = 0; i_ < 2; ++i_) *(ATT_LAS bf16x8*)(V_lds + (b) * VB_BYTES + v_st(vrow + 32 * i_, vcol)) = vs[i_]; } while (0)
  SLOAD(kt0); SWRITE(0); __syncthreads();
  for (int t = kt0; t < kt1; ++t) {
    const int b = (t - kt0) & 1; const bool more = (t + 1 < kt1);
    if (more) SLOAD(t + 1);
    const bool act = !BAND || (t >= qb - 1 && t <= qb + 1);
    if (act) {
      f32x16 p0, p1; qkt<DQK>(p0, p1, K_lds + b * KB_BYTES, qr, r32, hi);
      if (BAND) {
        if (t == qb - 1) {
#pragma unroll
          for (int r = 0; r < 16; ++r) { const int k0 = crow(r, hi); if (k0 < qi) p0[r] = -1e30f; if (k0 + 32 < qi) p1[r] = -1e30f; }
        } else if (t == qb + 1) {
#pragma unroll
          for (int r = 0; r < 16; ++r) { const int k0 = crow(r, hi); if (k0 > qi) p0[r] = -1e30f; if (k0 + 32 > qi) p1[r] = -1e30f; }
        }
      }
      float mn, alpha; partialSM<1>(p0, p1, m_reg, mn, alpha, C, thr_raw);
      bf16x8 pa0, pa1, pa2, pa3; finishSM(p0, p1, alpha, l_reg, pa0, pa1, pa2, pa3);
      if (__any(alpha < 1.f)) { if (hi == 0) al_l[r32] = alpha; asm volatile("s_waitcnt lgkmcnt(0)" ::: "memory");
#pragma unroll
        for (int d = 0; d < 4; ++d)
#pragma unroll
          for (int r = 0; r < 16; ++r) o[d][r] *= al_l[crow(r, hi)]; }
      pv_d0(o, vb0 + b * VB_BYTES, pa0, pa1, pa2, pa3);
    }
    if (more) SWRITE(b ^ 1);
    __syncthreads();
  }
#undef SLOAD
#undef SWRITE
  if (hi == 0) li_l[r32] = l_reg;
  asm volatile("s_waitcnt lgkmcnt(0)" ::: "memory");
  float rli[16];
#pragma unroll
  for (int r = 0; r < 16; ++r) rli[r] = __builtin_amdgcn_rcpf(li_l[crow(r, hi)]);
  bf16_t* Ow = Ob + (long)(wid * 32) * ldo;
#pragma unroll
  for (int r = 0; r < 16; ++r) { const int orow = crow(r, hi);
#pragma unroll
    for (int d0 = 0; d0 < 4; ++d0) Ow[(long)orow * ldo + d0 * 32 + r32] = f2bf(o[d0][r] * rli[r]); }
  if (lse != nullptr && hi == 0) lse[(long)(wid * 32 + r32) * ldl] = m_reg * scale + __logf(l_reg);
}

__device__ __forceinline__ void glds16(const void* gsrc, unsigned lds_dst) { unsigned keep;
  asm volatile("s_mov_b32 %0, m0\n\ts_mov_b32 m0, %2\n\ts_nop 0\n\tglobal_load_lds_dwordx4 %1, off\n\ts_mov_b32 m0, %0" : "=&s"(keep) : "v"(gsrc), "s"(lds_dst) : "memory"); }
#define WAIT_BAR(N) asm volatile("s_waitcnt vmcnt(" #N ") lgkmcnt(0)\n\ts_barrier" ::: "memory")
#define WAIT_BAR2(N0, N) do { if (wid == 0) WAIT_BAR(N0); else WAIT_BAR(N); } while (0)
#ifndef MLA_LA
#define MLA_LA 1
#endif
#ifndef MLA_PP_LA
#define MLA_PP_LA 6
#endif
constexpr int MLA_KSLOT = 64 * 400, MLA_KTILE = 64 * 192 * 2, MLA_VSLOT = 64 * 128 * 2, MLA_K0 = 0, MLA_V0 = 3 * MLA_KSLOT, MLA_WS = MLA_V0 + 3 * MLA_VSLOT, MLA_LDS = MLA_WS + 8 * 256;
template <int MODE = 0> __device__ __forceinline__ void mla_unit(const bf16_t* Qb, const bf16_t* Kh, const bf16_t* Vh, bf16_t* Ob, long ldo, int NT, float scale, ATT_LAS char* lds, int wave_s, bool do_store = true) {
  int tid_l = wave_s * 64 + mk_lane(); asm volatile("" : "+v"(tid_l));
  const int tid = tid_l, wid = __builtin_amdgcn_readfirstlane(tid >> 6), lane = tid & 63, r32 = lane & 31, hi = lane >> 5;
  const unsigned lds0 = (unsigned)(uintptr_t)lds;
  ATT_LAS float* wsf = (ATT_LAS float*)(lds + MLA_WS) + wid * 64; ATT_LAS float* li_l = wsf; ATT_LAS float* al_l = wsf + 32;
  const float C = scale * 1.4426950408889634f, thr_raw = 8.0f / scale;
  int ksrc[4], vsrc[2];
#pragma unroll
  for (int i = 0; i < 4; ++i) { const int gch = 64 * (wid + 8 * i) + lane, row = gch / 25, cc = gch % 25; ksrc[i] = row * 384 + (cc < 24 ? cc * 16 : 0); }
#pragma unroll
  for (int i = 0; i < 2; ++i) { const int B = 1024 * (2 * wid + i) + 16 * lane, sub = B >> 9, e = (B & 511) >> 1, kk = (sub >> 2) * 8 + (e >> 5), c = (sub & 3) * 32 + (e & 31);
    const int k = (kk & ~0xC) | ((kk & 4) << 1) | ((kk & 8) >> 1); vsrc[i] = (k * 128 + c) * 2; }
#define DMA_K(t, slot) do { const int t_ = (t) < NT ? (t) : NT - 1; const char* g_ = (const char*)Kh + (long)t_ * MLA_KTILE; \
    _Pragma("unroll") for (int i_ = 0; i_ < 4; ++i_) if ((i_ < 3 || wid == 0) && !(MODE & 2)) glds16(g_ + ksrc[i_], (unsigned)__builtin_amdgcn_readfirstlane(lds0 + MLA_K0 + (slot) * MLA_KSLOT + 1024 * (wid + 8 * i_))); } while (0)
#define DMA_V(t, slot) do { const int t_ = (t) < NT ? (t) : NT - 1; const char* g_ = (const char*)Vh + (long)t_ * MLA_VSLOT; \
    _Pragma("unroll") for (int i_ = 0; i_ < 2; ++i_) if (!(MODE & 2)) glds16(g_ + vsrc[i_], (unsigned)__builtin_amdgcn_readfirstlane(lds0 + MLA_V0 + (slot) * MLA_VSLOT + 1024 * (2 * wid + i_))); } while (0)
  DMA_K(0, 0); DMA_V(0, 0); DMA_K(1, 1); DMA_V(1, 1); DMA_K(2, 2);
  bf16x8 qr[12];
  { const bf16_t* Qw = Qb + (long)(wid * 32 + r32) * 192 + hi * 8;
#pragma unroll
    for (int d0 = 0; d0 < 12; ++d0) qr[d0] = *(const bf16x8*)(Qw + d0 * 16); }
  float m_reg = -1e30f, l_reg = 0.f; f32x16 o[4] = {};
  const int vb0 = (int)(lds0 + MLA_V0) + v_rd_base(lane);
  f32x16 pA0, pA1, pB0, pB1; float mnA, mnB, alA, alB; bf16x8 pa0, pa1, pa2, pa3;
#define RESC(a) do { if (__any((a) < 1.f)) { if (hi == 0) al_l[r32] = (a); asm volatile("s_waitcnt lgkmcnt(0)" ::: "memory"); \
    _Pragma("unroll") for (int d = 0; d < 4; ++d) _Pragma("unroll") for (int r = 0; r < 16; ++r) o[d][r] *= al_l[crow(r, hi)]; } } while (0)
  WAIT_BAR(0);
  if (wid >= 4) __builtin_amdgcn_s_setprio(1);
  qkt<192, MLA_LA>(pA0, pA1, lds + MLA_K0, qr, r32, hi); partialSM<1>(pA0, pA1, m_reg, mnA, alA, C, thr_raw);
  WAIT_BAR(0);
  int s_m1 = 0, s_0 = 1, s_p1 = 2;
#define ROT() do { const int t_ = s_m1; s_m1 = s_0; s_0 = s_p1; s_p1 = t_; } while (0)
#define STEP(X0, X1, mnX, alX, Y0, Y1, alY, j) do { \
    SBAR(); qkt<192, MLA_LA>(X0, X1, lds + MLA_K0 + s_0 * MLA_KSLOT, qr, r32, hi); \
    if (MODE & 1) { pa0 = __builtin_bit_cast(bf16x8, (u32x4){__float_as_uint(Y0[0]), __float_as_uint(Y0[1]), __float_as_uint(Y0[2]), __float_as_uint(Y0[3])}); pa1 = __builtin_bit_cast(bf16x8, (u32x4){__float_as_uint(Y0[4]), __float_as_uint(Y0[5]), __float_as_uint(Y0[6]), __float_as_uint(Y0[7])}); \
      pa2 = __builtin_bit_cast(bf16x8, (u32x4){__float_as_uint(Y1[0]), __float_as_uint(Y1[1]), __float_as_uint(Y1[2]), __float_as_uint(Y1[3])}); pa3 = __builtin_bit_cast(bf16x8, (u32x4){__float_as_uint(Y1[4]), __float_as_uint(Y1[5]), __float_as_uint(Y1[6]), __float_as_uint(Y1[7])}); } \
    else finishSM(Y0, Y1, alY, l_reg, pa0, pa1, pa2, pa3); SBAR(); \
    DMA_K((j) + 2, s_m1); SBAR(); \
    pv_d0(o, vb0 + s_m1 * MLA_VSLOT, pa0, pa1, pa2, pa3); if (MODE & 1) { alX = 1.f; } else partialSM<1>(X0, X1, m_reg, mnX, alX, C, thr_raw); SBAR(); \
    DMA_V((j) + 1, s_p1); \
    WAIT_BAR2(6, 5); RESC(alX); ROT(); } while (0)
  for (int j = 1; j + 1 < NT; j += 2) {
    STEP(pB0, pB1, mnB, alB, pA0, pA1, alA, j);
    STEP(pA0, pA1, mnA, alA, pB0, pB1, alB, j + 1);
  }
  STEP(pB0, pB1, mnB, alB, pA0, pA1, alA, NT - 1);
  finishSM(pB0, pB1, alB, l_reg, pa0, pa1, pa2, pa3); SBAR();
  pv_d0(o, vb0 + s_m1 * MLA_VSLOT, pa0, pa1, pa2, pa3);
  __builtin_amdgcn_s_setprio(0);
  (void)mnA; (void)mnB;
#undef STEP
#undef ROT
#undef RESC
#undef DMA_K
#undef DMA_V
  if (hi == 0) li_l[r32] = l_reg;
  WAIT_BAR(0);
  float rli[16];
#pragma unroll
  for (int r = 0; r < 16; ++r) rli[r] = __builtin_amdgcn_rcpf(li_l[crow(r, hi)]);
  ATT_LAS bf16_t* stg = (ATT_LAS bf16_t*)(lds + MLA_K0) + wid * 4096;
#pragma unroll
  for (int r = 0; r < 16; ++r) { const int orow = crow(r, hi);
#pragma unroll
    for (int d0 = 0; d0 < 4; ++d0) stg[orow * 128 + d0 * 32 + r32] = f2bf(o[d0][r] * rli[r]); }
  asm volatile("s_waitcnt lgkmcnt(0)" ::: "memory");
  bf16_t* Ow = Ob + (long)(wid * 32) * ldo;
#pragma unroll
  for (int i = 0; i < 8; ++i) { const int row = i * 4 + (lane >> 4), ch = lane & 15; const u32x4 v = *(const ATT_LAS u32x4*)(stg + row * 128 + ch * 8); if (do_store) *(u32x4*)(Ow + (long)row * ldo + ch * 8) = v; }
  WAIT_BAR(0);
}

__device__ __forceinline__ void mla_unit_stag(const bf16_t* Qb, const bf16_t* Kh, const bf16_t* Vh, bf16_t* Ob, long ldo, int NT, float scale, ATT_LAS char* lds, int wave_s) {
  int tid_l = wave_s * 64 + mk_lane(); asm volatile("" : "+v"(tid_l));
  const int tid = tid_l, wid = __builtin_amdgcn_readfirstlane(tid >> 6), lane = tid & 63, r32 = lane & 31, hi = lane >> 5;
  const unsigned lds0 = (unsigned)(uintptr_t)lds;
  ATT_LAS float* wsf = (ATT_LAS float*)(lds + MLA_WS) + wid * 64; ATT_LAS float* li_l = wsf; ATT_LAS float* al_l = wsf + 32;
  const float C = scale * 1.4426950408889634f, thr_raw = 8.0f / scale;
  int ksrc[4], vsrc[2];
#pragma unroll
  for (int i = 0; i < 4; ++i) { const int gch = 64 * (wid + 8 * i) + lane, row = gch / 25, cc = gch % 25; ksrc[i] = row * 384 + (cc < 24 ? cc * 16 : 0); }
#pragma unroll
  for (int i = 0; i < 2; ++i) { const int B = 1024 * (2 * wid + i) + 16 * lane, sub = B >> 9, e = (B & 511) >> 1, kk = (sub >> 2) * 8 + (e >> 5), c = (sub & 3) * 32 + (e & 31);
    const int k = (kk & ~0xC) | ((kk & 4) << 1) | ((kk & 8) >> 1); vsrc[i] = (k * 128 + c) * 2; }
#define DMA_K(t, slot) do { const int t_ = (t) < NT ? (t) : NT - 1; const char* g_ = (const char*)Kh + (long)t_ * MLA_KTILE; \
    _Pragma("unroll") for (int i_ = 0; i_ < 4; ++i_) if (i_ < 3 || wid == 0) glds16(g_ + ksrc[i_], (unsigned)__builtin_amdgcn_readfirstlane(lds0 + MLA_K0 + (slot) * MLA_KSLOT + 1024 * (wid + 8 * i_))); } while (0)
#define DMA_V(t, slot) do { const int t_ = (t) < NT ? (t) : NT - 1; const char* g_ = (const char*)Vh + (long)t_ * MLA_VSLOT; \
    _Pragma("unroll") for (int i_ = 0; i_ < 2; ++i_) glds16(g_ + vsrc[i_], (unsigned)__builtin_amdgcn_readfirstlane(lds0 + MLA_V0 + (slot) * MLA_VSLOT + 1024 * (2 * wid + i_))); } while (0)
  DMA_K(0, 0); DMA_V(0, 0); DMA_K(1, 1); DMA_V(1, 1); DMA_K(2, 2);
  bf16x8 qr[12];
  { const bf16_t* Qw = Qb + (long)(wid * 32 + r32) * 192 + hi * 8;
#pragma unroll
    for (int d0 = 0; d0 < 12; ++d0) qr[d0] = *(const bf16x8*)(Qw + d0 * 16); }
  float m_reg = -1e30f, l_reg = 0.f; f32x16 o[4] = {};
  const int vb0 = (int)(lds0 + MLA_V0) + v_rd_base(lane);
  f32x16 pA0, pA1, pB0, pB1; float mnA, mnB, alA, alB; bf16x8 pa0, pa1, pa2, pa3;
#define RESC(a) do { if (__any((a) < 1.f)) { if (hi == 0) al_l[r32] = (a); asm volatile("s_waitcnt lgkmcnt(0)" ::: "memory"); \
    _Pragma("unroll") for (int d = 0; d < 4; ++d) _Pragma("unroll") for (int r = 0; r < 16; ++r) o[d][r] *= al_l[crow(r, hi)]; } } while (0)
  WAIT_BAR(0);
  int s_m1 = 0, s_0 = 1, s_p1 = 2;
#define ROT() do { const int t_ = s_m1; s_m1 = s_0; s_0 = s_p1; s_p1 = t_; } while (0)
#define STEPA(X0, X1, mnX, alX, Y0, Y1, alY, j) do { \
    SBAR(); qkt<192, MLA_LA>(X0, X1, lds + MLA_K0 + s_0 * MLA_KSLOT, qr, r32, hi); \
    finishSM(Y0, Y1, alY, l_reg, pa0, pa1, pa2, pa3); SBAR(); \
    DMA_K((j) + 2, s_m1); SBAR(); \
    pv_d0(o, vb0 + s_m1 * MLA_VSLOT, pa0, pa1, pa2, pa3); partialSM<1>(X0, X1, m_reg, mnX, alX, C, thr_raw); SBAR(); \
    DMA_V((j) + 1, s_p1); \
    WAIT_BAR2(6, 5); RESC(alX); ROT(); } while (0)
#define STEPB(X0, X1, Y0, Y1, j) do { float mnY_, alY_; \
    SBAR(); partialSM<1>(Y0, Y1, m_reg, mnY_, alY_, C, thr_raw); (void)mnY_; RESC(alY_); \
    finishSM(Y0, Y1, alY_, l_reg, pa0, pa1, pa2, pa3); SBAR(); \
    DMA_K((j) + 2, s_m1); SBAR(); \
    pv_d0(o, vb0 + s_m1 * MLA_VSLOT, pa0, pa1, pa2, pa3); SBAR(); \
    qkt<192, MLA_LA>(X0, X1, lds + MLA_K0 + s_0 * MLA_KSLOT, qr, r32, hi); SBAR(); \
    DMA_V((j) + 1, s_p1); \
    WAIT_BAR2(6, 5); ROT(); } while (0)
  if (wid < 4) {
    qkt<192, MLA_LA>(pA0, pA1, lds + MLA_K0, qr, r32, hi); partialSM<1>(pA0, pA1, m_reg, mnA, alA, C, thr_raw);
    WAIT_BAR(0);
    for (int j = 1; j + 1 < NT; j += 2) {
      STEPA(pB0, pB1, mnB, alB, pA0, pA1, alA, j);
      STEPA(pA0, pA1, mnA, alA, pB0, pB1, alB, j + 1);
    }
    STEPA(pB0, pB1, mnB, alB, pA0, pA1, alA, NT - 1);
    finishSM(pB0, pB1, alB, l_reg, pa0, pa1, pa2, pa3); SBAR();
    pv_d0(o, vb0 + s_m1 * MLA_VSLOT, pa0, pa1, pa2, pa3);
  } else {
    __builtin_amdgcn_s_setprio(1);
    qkt<192, MLA_LA>(pA0, pA1, lds + MLA_K0, qr, r32, hi);
    WAIT_BAR(0);
    for (int j = 1; j + 1 < NT; j += 2) {
      STEPB(pB0, pB1, pA0, pA1, j);
      STEPB(pA0, pA1, pB0, pB1, j + 1);
    }
    STEPB(pB0, pB1, pA0, pA1, NT - 1);
    partialSM<1>(pB0, pB1, m_reg, mnB, alB, C, thr_raw); RESC(alB);
    finishSM(pB0, pB1, alB, l_reg, pa0, pa1, pa2, pa3); SBAR();
    pv_d0(o, vb0 + s_m1 * MLA_VSLOT, pa0, pa1, pa2, pa3);
  }
#undef STEPA
#undef STEPB
  __builtin_amdgcn_s_setprio(0);
  (void)mnA; (void)mnB;
#undef ROT
#undef RESC
#undef DMA_K
#undef DMA_V
  if (hi == 0) li_l[r32] = l_reg;
  WAIT_BAR(0);
  float rli[16];
#pragma unroll
  for (int r = 0; r < 16; ++r) rli[r] = __builtin_amdgcn_rcpf(li_l[crow(r, hi)]);
  ATT_LAS bf16_t* stg = (ATT_LAS bf16_t*)(lds + MLA_K0) + wid * 4096;
#pragma unroll
  for (int r = 0; r < 16; ++r) { const int orow = crow(r, hi);
#pragma unroll
    for (int d0 = 0; d0 < 4; ++d0) stg[orow * 128 + d0 * 32 + r32] = f2bf(o[d0][r] * rli[r]); }
  asm volatile("s_waitcnt lgkmcnt(0)" ::: "memory");
  bf16_t* Ow = Ob + (long)(wid * 32) * ldo;
#pragma unroll
  for (int i = 0; i < 8; ++i) { const int row = i * 4 + (lane >> 4), ch = lane & 15; const u32x4 v = *(const ATT_LAS u32x4*)(stg + row * 128 + ch * 8); *(u32x4*)(Ow + (long)row * ldo + ch * 8) = v; }
  WAIT_BAR(0);
}

__device__ __forceinline__ void mla_unit_pp(const bf16_t* Qb, const bf16_t* Kh, const bf16_t* Vh, bf16_t* Ob, long ldo, int NT, float scale, ATT_LAS char* lds, int wave_s) {
  int tid_l = wave_s * 64 + mk_lane(); asm volatile("" : "+v"(tid_l));
  const int tid = tid_l, wid = __builtin_amdgcn_readfirstlane(tid >> 6), lane = tid & 63, r32 = lane & 31, hi = lane >> 5;
  const bool H1 = wid >= 4;
  const unsigned lds0 = (unsigned)(uintptr_t)lds;
  ATT_LAS float* wsf = (ATT_LAS float*)(lds + MLA_WS) + wid * 64; ATT_LAS float* li_l = wsf; ATT_LAS float* al_l = wsf + 32;
  (void)scale;
  int ksrc[4], vsrc[2];
#pragma unroll
  for (int i = 0; i < 4; ++i) { const int gch = 64 * (wid + 8 * i) + lane, row = gch / 25, cc = gch % 25; ksrc[i] = row * 384 + (cc < 24 ? cc * 16 : 0); }
#pragma unroll
  for (int i = 0; i < 2; ++i) { const int B = 1024 * (2 * wid + i) + 16 * lane, sub = B >> 9, e = (B & 511) >> 1, kk = (sub >> 2) * 8 + (e >> 5), c = (sub & 3) * 32 + (e & 31);
    const int k = (kk & ~0xC) | ((kk & 4) << 1) | ((kk & 8) >> 1); vsrc[i] = (k * 128 + c) * 2; }
#define DMA_T(t, slot) do { const int t_ = (t) < NT ? (t) : NT - 1; const char* gk_ = (const char*)Kh + (long)t_ * MLA_KTILE; const char* gv_ = (const char*)Vh + (long)t_ * MLA_VSLOT; \
    _Pragma("unroll") for (int i_ = 0; i_ < 4; ++i_) if (i_ < 3 || wid == 0) glds16(gk_ + ksrc[i_], (unsigned)__builtin_amdgcn_readfirstlane(lds0 + MLA_K0 + (slot) * MLA_KSLOT + 1024 * (wid + 8 * i_))); \
    _Pragma("unroll") for (int i_ = 0; i_ < 2; ++i_) glds16(gv_ + vsrc[i_], (unsigned)__builtin_amdgcn_readfirstlane(lds0 + MLA_V0 + (slot) * MLA_VSLOT + 1024 * (2 * wid + i_))); } while (0)
  DMA_T(0, 0); DMA_T(1, 1);
  bf16x8 qr[12];
  { const bf16_t* Qw = Qb + (long)(wid * 32 + r32) * 192 + hi * 8;
#pragma unroll
    for (int d0 = 0; d0 < 12; ++d0) qr[d0] = *(const bf16x8*)(Qw + d0 * 16); }
  float mref = 0.f, l_reg = 0.f; f32x16 o[4] = {}; f32x16 negm = {};
  const float thr2 = 8.0f * 1.4426950408889634f;
  const int vb0 = (int)(lds0 + MLA_V0) + v_rd_base(lane);
  WAIT_BAR(0);
  if (H1) WAIT_BAR2(6, 5);
  int s_0 = 0, s_2 = 2;
  for (int j = 0; j < NT; ++j) {
    if (H1) DMA_T(j + 2, s_2);
    f32x16 p0, p1; float alpha;
    SBAR(); __builtin_amdgcn_s_setprio(1);
    qkt_c<192, MLA_PP_LA>(p0, p1, lds + MLA_K0 + s_0 * MLA_KSLOT, qr, r32, hi, negm);
    __builtin_amdgcn_s_setprio(0);
    partialSM_ref(p0, p1, mref, negm, alpha, thr2, j == 0, (j & 7) == 0);
    WAIT_BAR2(6, 5);
    if (!H1) DMA_T(j + 2, s_2);
    bf16x8 pa0, pa1, pa2, pa3; finishSM_np(p0, p1, alpha, l_reg, pa0, pa1, pa2, pa3);
    if (__any(alpha < 1.f)) { if (hi == 0) al_l[r32] = alpha; asm volatile("s_waitcnt lgkmcnt(0)" ::: "memory");
#pragma unroll
      for (int d = 0; d < 4; ++d)
#pragma unroll
        for (int r = 0; r < 16; ++r) o[d][r] *= al_l[crow(r, hi)]; }
    SBAR(); __builtin_amdgcn_s_setprio(1);
    pv_d0_la(o, vb0 + s_0 * MLA_VSLOT, pa0, pa1, pa2, pa3);
    __builtin_amdgcn_s_setprio(0);
    WAIT_BAR2(6, 5);
    s_2 = s_0; s_0 = (s_0 == 2) ? 0 : s_0 + 1;
  }
  if (!H1) WAIT_BAR2(6, 5);
#undef DMA_T
  if (hi == 0) li_l[r32] = l_reg;
  WAIT_BAR(0);
  float rli[16];
#pragma unroll
  for (int r = 0; r < 16; ++r) rli[r] = __builtin_amdgcn_rcpf(li_l[crow(r, hi)]);
  ATT_LAS bf16_t* stg = (ATT_LAS bf16_t*)(lds + MLA_K0) + wid * 4096;
#pragma unroll
  for (int r = 0; r < 16; ++r) { const int orow = crow(r, hi);
#pragma unroll
    for (int d0 = 0; d0 < 4; ++d0) stg[orow * 128 + d0 * 32 + r32] = f2bf(o[d0][r] * rli[r]); }
  asm volatile("s_waitcnt lgkmcnt(0)" ::: "memory");
  bf16_t* Ow = Ob + (long)(wid * 32) * ldo;
#pragma unroll
  for (int i = 0; i < 8; ++i) { const int row = i * 4 + (lane >> 4), ch = lane & 15; const u32x4 v = *(const ATT_LAS u32x4*)(stg + row * 128 + ch * 8); *(u32x4*)(Ow + (long)row * ldo + ch * 8) = v; }
  WAIT_BAR(0);
}

constexpr int DIL_KB = 64 * 272, DIL_SLOT = DIL_KB + 16384, DIL_WS = 3 * DIL_SLOT, DIL_STG = DIL_WS + 8 * 256, DIL_LDS = DIL_STG + 8 * 4096;
__device__ __forceinline__ void dil_unit(const bf16_t* Qs, const bf16_t* Ks, const bf16_t* Vs, bf16_t* Os, float* lses, long ld, long ldl, int qb_first, int nqb, int L64, float scale, ATT_LAS char* lds, int wave_s, bool dry = false) {
  int tid_l = wave_s * 64 + mk_lane(); asm volatile("" : "+v"(tid_l));
  const int tid = tid_l, wid = __builtin_amdgcn_readfirstlane(tid >> 6), lane = tid & 63, r32 = lane & 31, hi = lane >> 5, pair = wid >> 1, sub = wid & 1;
  const unsigned lds0 = (unsigned)(uintptr_t)lds;
  ATT_LAS float* wsf = (ATT_LAS float*)(lds + DIL_WS) + wid * 64; ATT_LAS float* li_l = wsf; ATT_LAS float* al_l = wsf + 32;
  ATT_LAS bf16_t* stg = (ATT_LAS bf16_t*)(lds + DIL_STG) + wid * 2048;
  const float C = scale * 1.4426950408889634f, thr_raw = 8.0f / scale;
  const int kt_lo = qb_first > 0 ? qb_first - 1 : 0, qb_end = qb_first + nqb, kt_hi = qb_end + 1 < L64 ? qb_end + 1 : L64;
  const long ld2 = ld * 2, ts = 64 * ld2;
  long koff[3], voff[2];
#pragma unroll
  for (int i = 0; i < 3; ++i) { const int gch = 64 * (wid + 8 * i) + lane, row = gch / 17, cc = gch % 17; koff[i] = row * ld2 + (cc < 16 ? cc * 16 : 0); }
#pragma unroll
  for (int i = 0; i < 2; ++i) { const int B = 1024 * (2 * wid + i) + 16 * lane, sb = B >> 9, e = (B & 511) >> 1, kk = (sb >> 2) * 8 + (e >> 5), c = (sb & 3) * 32 + (e & 31);
    const int k = (kk & ~0xC) | ((kk & 4) << 1) | ((kk & 8) >> 1); voff[i] = k * ld2 + c * 2; }
#define DMA_T(t, slot) do { const int t_ = (t) < kt_hi ? (t) : kt_hi - 1; const char* gk_ = (const char*)Ks + t_ * ts; const char* gv_ = (const char*)Vs + t_ * ts; \
    _Pragma("unroll") for (int i_ = 0; i_ < 3; ++i_) if (i_ < 2 || wid == 0) glds16(gk_ + koff[i_], (unsigned)__builtin_amdgcn_readfirstlane(lds0 + (slot) * DIL_SLOT + 1024 * (wid + 8 * i_))); \
    _Pragma("unroll") for (int i_ = 0; i_ < 2; ++i_) glds16(gv_ + voff[i_], (unsigned)__builtin_amdgcn_readfirstlane(lds0 + (slot) * DIL_SLOT + DIL_KB + 1024 * (2 * wid + i_))); } while (0)
  DMA_T(kt_lo, 0); DMA_T(kt_lo + 1, 1);
  int qb = qb_first + pair; bool have = qb < qb_end;
  bf16x8 qr[8];
#define QLOAD() do { const bf16_t* Qw_ = Qs + (long)(qb * 64 + sub * 32 + r32) * ld + hi * 8; \
    _Pragma("unroll") for (int d0 = 0; d0 < 8; ++d0) qr[d0] = *(const bf16x8*)(Qw_ + d0 * 16); } while (0)
#define QPIN() do { _Pragma("unroll") for (int d0 = 0; d0 < 8; ++d0) asm volatile("" : "+v"(qr[d0])); } while (0)
  if (have) QLOAD();
  float m_reg = -1e30f, l_reg = 0.f; f32x16 o[4] = {};
  const int qi = sub * 32 + r32;
  const int vb0 = (int)lds0 + DIL_KB + v_rd_base(lane);
#define BLOCK_EPI() do { if (hi == 0) li_l[r32] = l_reg; asm volatile("s_waitcnt lgkmcnt(0)" ::: "memory"); \
    float rli[16]; _Pragma("unroll") for (int r = 0; r < 16; ++r) rli[r] = __builtin_amdgcn_rcpf(li_l[crow(r, hi)]); \
    bf16_t* Ow_ = Os + (long)(qb * 64 + sub * 32) * ld; \
    _Pragma("unroll") for (int hf = 0; hf < 2; ++hf) { \
      _Pragma("unroll") for (int r = 0; r < 16; ++r) { const int orow = crow(r, hi); \
        _Pragma("unroll") for (int dd = 0; dd < 2; ++dd) stg[orow * 64 + dd * 32 + r32] = f2bf(o[hf * 2 + dd][r] * rli[r]); } \
      asm volatile("s_waitcnt lgkmcnt(0)" ::: "memory"); \
      _Pragma("unroll") for (int i = 0; i < 4; ++i) { const int row = i * 8 + (lane >> 3), ch = lane & 7; const u32x4 v = *(const ATT_LAS u32x4*)(stg + row * 64 + ch * 8); \
        if (!dry) *(u32x4*)(Ow_ + (long)row * ld + hf * 64 + ch * 8) = v; } \
      asm volatile("s_waitcnt lgkmcnt(0)" ::: "memory"); } \
    if (hi == 0 && !dry) lses[(long)(qb * 64 + sub * 32 + r32) * ldl] = m_reg * scale + __logf(l_reg); } while (0)
  WAIT_BAR(0);
  int s_0 = 0, s_1 = 1, s_2 = 2;
  for (int t = kt_lo; t < kt_hi; ++t) {
    if (have && t >= qb - 1 && t <= qb + 1) {
      f32x16 p0, p1; qkt<128>(p0, p1, lds + s_0 * DIL_SLOT, qr, r32, hi);
      if (t == qb - 1) {
#pragma unroll
        for (int r = 0; r < 16; ++r) { const int k0 = crow(r, hi); if (k0 < qi) p0[r] = -1e30f; if (k0 + 32 < qi) p1[r] = -1e30f; }
      } else if (t == qb + 1) {
#pragma unroll
        for (int r = 0; r < 16; ++r) { const int k0 = crow(r, hi); if (k0 > qi) p0[r] = -1e30f; if (k0 + 32 > qi) p1[r] = -1e30f; }
      }
      float mn, alpha; partialSM<1>(p0, p1, m_reg, mn, alpha, C, thr_raw); (void)mn;
      bf16x8 pa0, pa1, pa2, pa3; finishSM(p0, p1, alpha, l_reg, pa0, pa1, pa2, pa3);
      if (__any(alpha < 1.f)) { if (hi == 0) al_l[r32] = alpha; asm volatile("s_waitcnt lgkmcnt(0)" ::: "memory");
#pragma unroll
        for (int d = 0; d < 4; ++d)
#pragma unroll
          for (int r = 0; r < 16; ++r) o[d][r] *= al_l[crow(r, hi)]; }
      pv_d0(o, vb0 + s_0 * DIL_SLOT, pa0, pa1, pa2, pa3);
    } else if (have && t == qb + 2) {
      BLOCK_EPI();
      qb += 4; have = qb < qb_end; m_reg = -1e30f; l_reg = 0.f;
#pragma unroll
      for (int d = 0; d < 4; ++d) o[d] = f32x16{};
      if (have) { QLOAD(); QPIN(); }
    }
    DMA_T(t + 2, s_2);
    WAIT_BAR2(5, 4);
    { const int t_ = s_0; s_0 = s_1; s_1 = s_2; s_2 = t_; }
  }
  if (have) BLOCK_EPI();
  WAIT_BAR(0);
#undef DMA_T
#undef QLOAD
#undef QPIN
#undef BLOCK_EPI
}
#undef WAIT_BAR
#undef SBAR
}

#define LAS __attribute__((address_space(3)))
typedef unsigned short bf16;
typedef float f32x4 __attribute__((ext_vector_type(4)));
typedef unsigned v4u __attribute__((ext_vector_type(4)));
typedef unsigned v2u __attribute__((ext_vector_type(2)));
typedef short bf16x8 __attribute__((ext_vector_type(8)));

constexpr int NWAVES = 8, NTHR = 512;
constexpr int BATCH = 8, SEQ = 8192, DM = 1024, M = BATCH * SEQ, FF = 4096;
#ifndef MK_NCH
#define MK_NCH 4
#endif
constexpr int NCH = MK_NCH, MH = M / NCH, BPC = BATCH / NCH;
constexpr int NQKV = 9216;
constexpr size_t MiB = 1u << 20;
constexpr size_t WS_WQKV = 1 * MiB, WS_WOA = 19 * MiB, WS_W1 = 21 * MiB, WS_W2 = 37 * MiB, WS_WIN = 53 * MiB, WS_WQB = 54 * MiB, WS_WKVB = 55 * MiB, WS_WOB = 56 * MiB;
constexpr size_t WS_COS128 = 58 * MiB, WS_SIN128 = 60 * MiB, WS_COS64 = 62 * MiB, WS_SIN64 = 63 * MiB;
constexpr size_t WS_LSE = 64 * MiB, WS_SSR = 67 * MiB;
constexpr size_t WS_RS = 68 * MiB, WS_RS2 = 70 * MiB;
constexpr size_t WS_HN = 128 * MiB;
constexpr size_t WS_QKVH = 256 * MiB;
constexpr size_t WS_ACT = 256 * MiB;
constexpr size_t WS_CQN = 256 * MiB, WS_CKVN = 288 * MiB, WS_KR = 320 * MiB;
constexpr size_t WS_Q = 384 * MiB, WS_K = 576 * MiB, WS_V = 768 * MiB;
constexpr size_t WS_AO = 896 * MiB;
constexpr size_t WS_END = 1024 * MiB;
constexpr int RING_BYTES = 131072, XCH_OFF = RING_BYTES, LDS_BYTES = 147456;

#define RLX_AGENT __ATOMIC_RELAXED, __HIP_MEMORY_SCOPE_AGENT
#define XB_TMO      128
#define XB_XCNT(j)  (256  + 64 * (j))
#define XB_XSUB(j)  (1280 + 64 * (j))
#define XB_XGEN(j)  (2304 + 64 * (j))
#define XB_TOP      3328
#define XB_TOPGEN   3392
#define XCD_BAR_WORDS 3456
#define XB_SPIN_CAP (1u << 18)

__device__ __forceinline__ unsigned xb_ld(unsigned* p)              { return __hip_atomic_load(p, __ATOMIC_RELAXED, __HIP_MEMORY_SCOPE_AGENT); }
__device__ __forceinline__ unsigned xb_add(unsigned* p, unsigned v) { return __hip_atomic_fetch_add(p, v, __ATOMIC_RELAXED, __HIP_MEMORY_SCOPE_AGENT); }
__device__ __forceinline__ unsigned xb_xcc_id() { return (unsigned)__builtin_amdgcn_s_getreg((3 << 11) | 20) & 0xFu; }
#define XB_SPIN(cond, bar) do { unsigned _sp = 0; while (cond) { __builtin_amdgcn_s_sleep(1); \
    if ((++_sp & 255u) == 0u) { if (xb_ld(&(bar)[XB_TMO])) break; if (_sp > XB_SPIN_CAP) { atomicAdd(&(bar)[XB_TMO], 1u); break; } } } } while (0)

struct XcdBarrier {
    unsigned* bar; unsigned x; int wave;
    volatile LAS unsigned* st;
};

__device__ __forceinline__ XcdBarrier xcd_barrier_post(unsigned* bar, volatile LAS unsigned* st, int wave_s) {
    XcdBarrier b; b.bar = bar; b.x = xb_xcc_id(); b.st = st; b.wave = wave_s;
    if (wave_s == 0 && mk_lane() == 0) (void)xb_add(&bar[XB_XCNT(b.x)], 1u);
    return b;
}
__device__ __forceinline__ void xcd_barrier_complete(unsigned* bar, unsigned x, unsigned& nloc, unsigned& nx) {
    const unsigned G = gridDim.x * gridDim.y * gridDim.z;
    unsigned sum, cnt, mine, sp = 0u;
    for (;;) {
        sum = 0u; cnt = 0u; mine = 0u;
#pragma unroll
        for (unsigned j = 0; j < 16; ++j) { const unsigned c = xb_ld(&bar[XB_XCNT(j)]); sum += c; cnt += (c > 0u) ? 1u : 0u; mine = (j == x) ? c : mine; }
        if (sum == G) break;
        __builtin_amdgcn_s_sleep(1);
        if ((++sp & 255u) == 0u) { if (xb_ld(&bar[XB_TMO])) break; if (sp > XB_SPIN_CAP) { atomicAdd(&bar[XB_TMO], 1u); break; } }
    }
    nloc = mine > 0u ? mine : 1u; nx = cnt > 0u ? cnt : 1u;
}

__device__ __forceinline__ void xcd_barrier(const XcdBarrier& b) {
    asm volatile("s_waitcnt vmcnt(0)" ::: "memory");
    __syncthreads();
    if (b.wave == 0 && mk_lane() == 0) {
        unsigned* bar = b.bar;
        __builtin_amdgcn_s_waitcnt(0);
        unsigned nloc = b.st[0], nx = b.st[1];
        if (nloc == 0u) { xcd_barrier_complete(bar, b.x, nloc, nx); b.st[0] = nloc; b.st[1] = nx; }
        const unsigned old = xb_add(&bar[XB_XSUB(b.x)], 1u);
        const unsigned gen = old / nloc;
        if (old + 1u == (gen + 1u) * nloc) {
            __builtin_amdgcn_fence(__ATOMIC_RELEASE, "agent");
            asm volatile("s_waitcnt vmcnt(0)" ::: "memory");
            const unsigned og = xb_add(&bar[XB_TOP], 1u);
            const unsigned tg = og / nx;
            if (og + 1u == (tg + 1u) * nx) xb_add(&bar[XB_TOPGEN], 1u);
            else XB_SPIN(xb_ld(&bar[XB_TOPGEN]) == tg, bar);
            __builtin_amdgcn_fence(__ATOMIC_ACQUIRE, "agent");
            xb_add(&bar[XB_XGEN(b.x)], 1u);
            asm volatile("s_waitcnt vmcnt(0)" ::: "memory");
        } else {
            XB_SPIN(xb_ld(&bar[XB_XGEN(b.x)]) == gen, bar);
            __builtin_amdgcn_fence(__ATOMIC_ACQUIRE, "agent");
            asm volatile("s_waitcnt vmcnt(0)" ::: "memory");
        }
    }
    __syncthreads();
}

constexpr size_t WS_BAR = 0, BAR_ZERO_BYTES = 16384;

#ifndef STAG_SLEEPS
#define STAG_SLEEPS 1
#endif
__device__ __forceinline__ void stagger(int bx) { if (STAG_SLEEPS > 0) for (int i = 0; i < bx; ++i) __builtin_amdgcn_s_sleep(STAG_SLEEPS); }
__device__ __forceinline__ unsigned char* ws_fresh(unsigned char* w) { asm volatile("" : "+s"(w)); return w; }
struct Params {
  const float* x; const float* norm_mix; const float* norm_ffn; const float* a_w_qkv; const float* a_q_gain; const float* a_k_gain; const float* a_w_o;
  const float* b_w_in; const float* b_q_a_gain; const float* b_w_qb; const float* b_kv_a_gain; const float* b_w_kvb; const float* b_q_gain; const float* b_k_gain; const float* b_w_o;
  const float* ffn_w1; const float* ffn_w2; float* out; unsigned char* ws;
};

__device__ __forceinline__ unsigned f2bf_rne(float f) { unsigned u = __builtin_bit_cast(unsigned, f); return (u + 0x7fffu + ((u >> 16) & 1u)) >> 16; }
__device__ __forceinline__ unsigned pk2(float lo, float hi) { return f2bf_rne(lo) | (f2bf_rne(hi) << 16); }
__device__ __forceinline__ float wave_sum(float v) {
#pragma unroll
  for (int o = 1; o < 64; o <<= 1) v += __shfl_xor(v, o);
  return v;
}
__device__ __forceinline__ int rope_perm128(int p) { const int wc = p >> 5, fq = (p >> 3) & 3, n = (p >> 2) & 1, j = p & 3; return 16 * wc + 4 * fq + j + 64 * n; }
__device__ __forceinline__ int rope_perm64(int p) { const int wc = p >> 5, fq = (p >> 3) & 3, n = (p >> 2) & 1, j = p & 3; return wc >= 2 ? -1 : 16 * wc + 4 * fq + j + 32 * n; }
template <int MAP> __device__ __forceinline__ int src_col(int n) {
  if (MAP == 1) { if (n >= 6144) return n; const int p = n & 255, bj = p >> 7, pp = p & 127; return (n - p) + (pp >> 6) * 128 + (pp & 63) + 64 * bj; }
  if (MAP == 2) { if (n < 384) return n; const int q = rope_perm64(n - 384); return q < 0 ? -1 : 384 + q; }
  if (MAP == 3) { const int h = n >> 8, p = n & 255; if (p < 128) return h * 192 + p; const int q = rope_perm64(p - 128); return q < 0 ? -1 : h * 192 + 128 + q; }
  if (MAP == 4) { const int p = n & 255, bj = p >> 7, wc = (p >> 5) & 3, i = p & 31; return (n - p) + wc * 64 + bj * 32 + i; }
  return n;
}
template <int MAP> __device__ __forceinline__ void wt_convert(const float* W, int Klog, int Nlog, int Kphys, int Nphys, bf16* WT, int gw, int NGW, int lane, const float* gain = nullptr) {
  const int nkb = Kphys / 8, nnb = Nphys / 64;
#pragma unroll 4
  for (int it = gw; it < nkb * nnb; it += NGW) {
    const int nb = it % nnb, kb = it / nnb, n = nb * 64 + lane, src = src_col<MAP>(n), k0 = kb * 8;
    float v[8];
#pragma unroll
    for (int i = 0; i < 8; ++i) v[i] = (src >= 0 && k0 + i < Klog) ? W[(size_t)(k0 + i) * Nlog + src] : 0.f;
    if (gain != nullptr) {
#pragma unroll
      for (int i = 0; i < 8; ++i) v[i] *= gain[k0 + i]; }
    v4u o; o.x = pk2(v[0], v[1]); o.y = pk2(v[2], v[3]); o.z = pk2(v[4], v[5]); o.w = pk2(v[6], v[7]);
    *(v4u*)(WT + (size_t)n * Kphys + k0) = o;
  }
}
__device__ __forceinline__ void rope_table(float* cosT, float* sinT, int half_d, int gtid, int NGT, bool as_half = false) {
  for (int id = gtid; id < SEQ * half_d; id += NGT) {
    const int pos = id / half_d, i = id % half_d;
    const float freq = powf(10000.0f, -(float)i / (float)half_d);
    const float angf = (float)pos * freq;
    const double a = (double)angf, k = rint(a * 0.15915494309189535), red = a - k * 6.283185307179586;
    const float r = (float)red;
    if (as_half) { ((_Float16*)cosT)[id] = (_Float16)cosf(r); ((_Float16*)sinT)[id] = (_Float16)sinf(r); } else { cosT[id] = cosf(r); sinT[id] = sinf(r); }
  }
}
__device__ __forceinline__ void xb_rows(const float* src, bf16* dst, float* rs, int gw, int NGW, int lane) {
#pragma unroll 4
  for (int row = gw; row < M; row += NGW) {
    const f32x4* xr = (const f32x4*)(src + (size_t)row * DM) + lane;
    f32x4 v[4]; float s = 0.f;
#pragma unroll
    for (int j = 0; j < 4; ++j) { v[j] = xr[64 * j]; s += (v[j][0] * v[j][0] + v[j][1] * v[j][1]) + (v[j][2] * v[j][2] + v[j][3] * v[j][3]); }
    s = wave_sum(s);
    v2u* o8 = (v2u*)(dst + (size_t)row * DM) + lane;
#pragma unroll
    for (int j = 0; j < 4; ++j) { v2u w; w.x = pk2(v[j][0], v[j][1]); w.y = pk2(v[j][2], v[j][3]); o8[64 * j] = w; }
    if (lane < 4) rs[(size_t)row * 4 + lane] = lane == 0 ? s : 0.f;
  }
}
__device__ __forceinline__ void merge_half(const bf16* qkvh, const float* lse, bf16* ao_half, int gtid, int NGT) {
  for (int id = gtid; id < MH * 128; id += NGT) {
    const int tok = id >> 7, c8 = id & 127, h = c8 >> 4;
    const float l0 = lse[((size_t)0 * MH + tok) * 8 + h], l1 = lse[((size_t)1 * MH + tok) * 8 + h], l2 = lse[((size_t)2 * MH + tok) * 8 + h];
    const float mx = fmaxf(l0, fmaxf(l1, l2));
    float w0 = __expf(l0 - mx), w1 = __expf(l1 - mx), w2 = __expf(l2 - mx);
    const float inv = 1.0f / (w0 + w1 + w2); w0 *= inv; w1 *= inv; w2 *= inv;
    const bf16* p = qkvh + (size_t)tok * NQKV + c8 * 8;
    const v4u a = *(const v4u*)p, b = *(const v4u*)(p + 1024), c = *(const v4u*)(p + 2048);
    v4u o;
#pragma unroll
    for (int e = 0; e < 4; ++e) {
      const float alo = __uint_as_float(a[e] << 16), ahi = __uint_as_float(a[e] & 0xffff0000u);
      const float blo = __uint_as_float(b[e] << 16), bhi = __uint_as_float(b[e] & 0xffff0000u);
      const float clo = __uint_as_float(c[e] << 16), chi = __uint_as_float(c[e] & 0xffff0000u);
      o[e] = pk2(w0 * alo + w1 * blo + w2 * clo, w0 * ahi + w1 * bhi + w2 * chi);
    }
    *(v4u*)(ao_half + (size_t)tok * DM + c8 * 8) = o;
  }
}

__global__ void __launch_bounds__(NTHR) fwd_megakernel(Params p) {
  extern __shared__ __attribute__((aligned(16))) unsigned char lds_raw[];
  cg::grid_group grid = cg::this_grid();
  LAS unsigned char* lds = (LAS unsigned char*)lds_raw;
  LAS float* XP = (LAS float*)(lds + XCH_OFF);
  const int G = gridDim.x, bx = blockIdx.x, NGW = G * NWAVES, NGT = G * NTHR;
  volatile LAS unsigned* bst = (volatile LAS unsigned*)(lds + XCH_OFF + 8192);
  const int wave_s = __builtin_amdgcn_readfirstlane((int)threadIdx.x >> 6);
  if (wave_s == 0 && mk_lane() < 4) bst[mk_lane()] = 0u;
  __syncthreads();
  XcdBarrier xbar = xcd_barrier_post((unsigned*)(p.ws + WS_BAR), bst, wave_s);
#define GRID_BAR() xcd_barrier(xbar)
#define FRESH_IDS() int tid_f = wave_s * 64 + mk_lane(); asm volatile("" : "+v"(tid_f)); const int lane = tid_f & 63, gw = bx * NWAVES + wave_s, gtid = bx * NTHR + tid_f; (void)lane; (void)gw; (void)gtid
  unsigned char* ws = p.ws;
  bf16* WQKV = (bf16*)(ws + WS_WQKV); bf16* WOA = (bf16*)(ws + WS_WOA); bf16* W1 = (bf16*)(ws + WS_W1); bf16* W2 = (bf16*)(ws + WS_W2);
  bf16* WIN = (bf16*)(ws + WS_WIN); bf16* WQB = (bf16*)(ws + WS_WQB); bf16* WKVB = (bf16*)(ws + WS_WKVB); bf16* WOB = (bf16*)(ws + WS_WOB);
  float* COS128 = (float*)(ws + WS_COS128); float* SIN128 = (float*)(ws + WS_SIN128); float* COS64 = (float*)(ws + WS_COS64); float* SIN64 = (float*)(ws + WS_SIN64);
  float* LSE = (float*)(ws + WS_LSE); float* SSR = (float*)(ws + WS_SSR);
  bf16* HN = (bf16*)(ws + WS_HN); float* RS = (float*)(ws + WS_RS); float* RS2 = (float*)(ws + WS_RS2); bf16* QKVH = (bf16*)(ws + WS_QKVH); bf16* ACT = (bf16*)(ws + WS_ACT);
  bf16* CQN = (bf16*)(ws + WS_CQN); bf16* CKVN = (bf16*)(ws + WS_CKVN); float* KR = (float*)(ws + WS_KR);
  bf16* QB = (bf16*)(ws + WS_Q); bf16* KB = (bf16*)(ws + WS_K); bf16* VB = (bf16*)(ws + WS_V); bf16* AO = (bf16*)(ws + WS_AO);

#ifndef SEL
#define SEL 0xffff
#endif
#ifndef PROBE_EW_REPS
#define PROBE_EW_REPS 1
#endif
#ifndef PROBE_GEMM_REPS
#define PROBE_GEMM_REPS 1
#endif
#if SEL & 1
  for (int rep_ = 0; rep_ < PROBE_EW_REPS; ++rep_)
  { FRESH_IDS();
  wt_convert<1>(p.a_w_qkv, DM, NQKV, DM, NQKV, WQKV, gw, NGW, lane, p.norm_mix);
  wt_convert<0>(p.a_w_o, DM, DM, DM, DM, WOA, gw, NGW, lane);
  wt_convert<0>(p.ffn_w1, DM, FF, DM, FF, W1, gw, NGW, lane, p.norm_ffn);
  wt_convert<0>(p.ffn_w1 + (size_t)DM * FF, DM, FF, DM, FF, W1 + (size_t)DM * FF, gw, NGW, lane, p.norm_ffn + DM);
  wt_convert<0>(p.ffn_w2, FF, DM, FF, DM, W2, gw, NGW, lane);
  wt_convert<0>(p.ffn_w2 + (size_t)DM * FF, FF, DM, FF, DM, W2 + (size_t)DM * FF, gw, NGW, lane);
  wt_convert<2>(p.b_w_in, DM, 448, DM, 512, WIN, gw, NGW, lane, p.norm_mix + DM);
  wt_convert<3>(p.b_w_qb, 256, 1536, 256, 2048, WQB, gw, NGW, lane);
  wt_convert<0>(p.b_w_kvb, 128, 2048, 256, 2048, WKVB, gw, NGW, lane);
  wt_convert<0>(p.b_w_o, DM, DM, DM, DM, WOB, gw, NGW, lane);
  rope_table(COS128, SIN128, 64, gtid, NGT, true);
  rope_table(COS64, SIN64, 32, gtid, NGT);
  xb_rows(p.x, HN, RS, gw, NGW, lane); }
#endif
  grid.sync();

#ifdef PROBE_EXTRA_SYNCS
  for (int i_ = 0; i_ < PROBE_EXTRA_SYNCS; ++i_) grid.sync();
#endif
  for (int layer = 0; layer < 2; ++layer) {
    if (layer == 0) {
      for (int half = 0; half < NCH; ++half) {
        for (int rep_ = 0; rep_ < PROBE_GEMM_REPS; ++rep_)
        { pg8::Gemm g{HN + (size_t)half * MH * DM, WQKV, MH, NQKV, DM}; pg8::StaticOrder S; S.init(MH, NQKV, G, bx);
          pg8::EpiQKVA E{QKVH, p.a_q_gain, p.a_k_gain, COS128, SIN128, XP, RS, half * MH};
          pg8::gemm_phase<pg8::EpiQKVA, pg8::StaticOrder, true, true>(lds, g, S, E, wave_s); }
        GRID_BAR();
        int uid0 = bx; asm volatile("" : "+s"(uid0));
        for (int uid = uid0; uid < BPC * 256; uid += G) {
          int g, r, nqb, L64, rem;
          if (uid < BPC * 64) { g = 0; r = 1; nqb = 16; L64 = 128; rem = uid; } else if (uid < BPC * 128) { g = 1; r = 4; nqb = 16; L64 = 32; rem = uid - BPC * 64; } else { g = 2; r = 16; nqb = 8; L64 = 8; rem = uid - BPC * 128; }
          const int per = (g == 2) ? 16 : 8, sub_i = rem % per, bhh = rem / per, h = bhh & 7, bl = bhh >> 3;
          const int nch = L64 / nqb, c = sub_i / nch, ch = sub_i % nch;
          const long ld = (long)r * NQKV;
          const bf16* qp = QKVH + ((size_t)bl * SEQ + c) * NQKV + g * 1024 + h * 128;
          att::dil_unit(qp, qp + 3072, qp + 6144, (bf16*)qp, LSE + ((size_t)g * MH + (size_t)bl * SEQ + c) * 8 + h, ld, (long)r * 8, ch * nqb, nqb, L64, 0.08838834764831845f, (LAS char*)lds, wave_s);
        }
        GRID_BAR();
        for (int rep_ = 0; rep_ < PROBE_EW_REPS; ++rep_) { FRESH_IDS(); merge_half(QKVH, LSE, AO + (size_t)half * MH * DM, gtid, NGT); }
        GRID_BAR();
      }
    } else {
#if SEL & 16
      for (int rep_ = 0; rep_ < PROBE_GEMM_REPS; ++rep_)
      { pg8::Gemm g{HN, WIN, M, 512, DM}; pg8::StaticOrder S; S.init(M, 512, G, bx);
        pg8::EpiLat E{CQN, CKVN, KR, SSR, p.b_q_a_gain, p.b_kv_a_gain, p.b_k_gain, COS64, SIN64, XP, RS};
        pg8::gemm_phase<pg8::EpiLat, pg8::StaticOrder, true, true>(lds, g, S, E, wave_s); }
#endif
      GRID_BAR();
#if SEL & 32
      for (int rep_ = 0; rep_ < PROBE_GEMM_REPS; ++rep_) {
      { pg8::Gemm g{CQN, WQB, M, 2048, 256}; pg8::StaticOrder S; S.init(M, 2048, G, bx);
        pg8::EpiQB E{QB, p.b_q_gain, COS64, SIN64, XP};
        pg8::gemm_phase<pg8::EpiQB, pg8::StaticOrder, true, true>(lds, g, S, E, wave_s); }
#if SEL & 64
      { pg8::Gemm g{CKVN, WKVB, M, 2048, 256}; pg8::StaticOrder S; S.init(M, 2048, G, bx);
        pg8::EpiKVB E{KB, VB, p.b_k_gain, KR, SSR, XP};
        pg8::gemm_phase<pg8::EpiKVB, pg8::StaticOrder, true, true>(lds, g, S, E, wave_s); }
      }
#endif
#endif
      GRID_BAR();
#if SEL & 128
#ifndef PROBE_MLA_REPS
#define PROBE_MLA_REPS 1
#endif
#ifdef PROBE_CLOCK
      const unsigned long long pc0_ = __builtin_amdgcn_s_memtime(), pr0_ = __builtin_amdgcn_s_memrealtime();
#endif
      for (int rep_ = 0; rep_ < PROBE_MLA_REPS; ++rep_)
      { const int xcd = bx & 7, loc = bx >> 3;
        for (int i = 0; ; ++i) {
          int bh, qb;
          if (G == 256) { if (i >= 8) break; bh = i * 8 + xcd; qb = loc; }
          else { const int uid = i * G + bx; if (uid >= 64 * 32) break; bh = uid >> 5; qb = uid & 31; }
          const int b = bh >> 3, h = bh & 7;
#ifndef PROBE_MLA_MODE
#define PROBE_MLA_MODE 0
#endif
          if (PROBE_MLA_REPS > 1 && rep_ == 0)
          att::mla_unit<PROBE_MLA_MODE>(QB + ((size_t)bh * SEQ + 256 * qb) * 192, KB + (size_t)bh * SEQ * 192, VB + (size_t)bh * SEQ * 128,
                        AO + ((size_t)b * SEQ + 256 * qb) * DM + h * 128, DM, SEQ / 64, 0.07216878364870322f, (LAS char*)lds, wave_s, p.ws == nullptr);
          else
          att::mla_unit_pp(QB + ((size_t)bh * SEQ + 256 * qb) * 192, KB + (size_t)bh * SEQ * 192, VB + (size_t)bh * SEQ * 128,
                        AO + ((size_t)b * SEQ + 256 * qb) * DM + h * 128, DM, SEQ / 64, 0.07216878364870322f, (LAS char*)lds, wave_s);
        } }
#endif
#ifdef PROBE_CLOCK
      { const unsigned long long pc1_ = __builtin_amdgcn_s_memtime(), pr1_ = __builtin_amdgcn_s_memrealtime();
        if (bx == PROBE_CLOCK && wave_s == 0 && mk_lane() == 0) { const float mhz_ = (float)(pc1_ - pc0_) * 100.0f / (float)(pr1_ - pr0_); ((float*)(p.ws + WS_BAR + 14336))[0] = (mhz_ > 1450.f ? 1000.f : 0.f) + (mhz_ > 1750.f ? 1000.f : 0.f) + (mhz_ > 2050.f ? 1000.f : 0.f) + (mhz_ > 2300.f ? 1000.f : 0.f); } }
#endif
      GRID_BAR();
    }
    { pg8::Gemm g{AO, layer == 0 ? WOA : WOB, M, DM, DM}; pg8::StaticOrder S; S.init(M, DM, G, bx);
      pg8::EpiResB E{HN, HN, RS2, XP, nullptr};
      pg8::gemm_phase<pg8::EpiResB, pg8::StaticOrder, true, true>(lds, g, S, E, wave_s); }
    GRID_BAR();
#ifndef PROBE_FFN1_REPS
#define PROBE_FFN1_REPS 1
#endif
#ifndef PROBE_FFN1_DRY
#define PROBE_FFN1_DRY 1
#endif
#ifdef STAG_FFN1
    for (int i_ = 0; i_ < bx; ++i_) __builtin_amdgcn_s_sleep(STAG_FFN1);
#endif
    for (int rep_ = 0; rep_ < PROBE_FFN1_REPS; ++rep_)
    { pg8::Gemm g{HN, W1 + (size_t)layer * DM * FF, M, FF, DM}; pg8::StaticOrder S; S.init(M, FF, G, bx);
      pg8::EpiRelu2 E{ACT, FF, (PROBE_FFN1_REPS > 1 && rep_ == 0) ? PROBE_FFN1_DRY : 0};
      pg8::gemm_phase<pg8::EpiRelu2, pg8::StaticOrder, true, true>(lds, g, S, E, wave_s); }
    GRID_BAR();
    if (layer == 0) {
      { pg8::Gemm g{ACT, W2, M, DM, FF}; pg8::StaticOrder S; S.init(M, DM, G, bx);
        pg8::EpiResB E{HN, HN, RS, XP, RS2};
        pg8::gemm_phase<pg8::EpiResB, pg8::StaticOrder, true, true>(lds, g, S, E, wave_s); }
      GRID_BAR();
    } else {
      pg8::Gemm g{ACT, W2 + (size_t)DM * FF, M, DM, FF}; pg8::StaticOrder S; S.init(M, DM, G, bx);
      pg8::EpiResF E{HN, p.out, RS2};
      pg8::gemm_phase<pg8::EpiResF, pg8::StaticOrder, true, true>(lds, g, S, E, wave_s);
    }
  }
#ifdef PROBE_CLOCK
  GRID_BAR();
  if (bx == 0 && wave_s == 0 && mk_lane() == 0) p.out[0] += ((float*)(p.ws + WS_BAR + 14336))[0];
#endif
}

extern "C" void kernel_launch(void* const* d_in, const int* in_sizes, int n_in, void* d_out, int out_size, void* d_ws, size_t ws_size, hipStream_t stream) {
  static int grid_blocks = 0;
  if (grid_blocks == 0) {
    if (n_in != 17 || in_sizes[0] != M * DM || out_size != M * DM || ws_size < WS_END) {
      fprintf(stderr, "kernel_launch: unexpected shapes: n_in %d in0 %d out %d ws %zu (need >= %zu)\n", n_in, n_in > 0 ? in_sizes[0] : -1, out_size, ws_size, (size_t)WS_END); grid_blocks = -1; return; }
    int dev = 0, cus = 0, per_cu = 0;
    hipGetDevice(&dev); hipDeviceGetAttribute(&cus, hipDeviceAttributeMultiprocessorCount, dev);
    if (hipFuncSetAttribute((const void*)fwd_megakernel, hipFuncAttributeMaxDynamicSharedMemorySize, LDS_BYTES) != hipSuccess) { fprintf(stderr, "kernel_launch: hipFuncSetAttribute failed\n"); grid_blocks = -1; return; }
    if (hipOccupancyMaxActiveBlocksPerMultiprocessor(&per_cu, (const void*)fwd_megakernel, NTHR, LDS_BYTES) != hipSuccess || per_cu < 1) { fprintf(stderr, "kernel_launch: occupancy query gives %d\n", per_cu); per_cu = 1; }
    (void)hipGetLastError();
    grid_blocks = cus * per_cu;
  }
  if (grid_blocks < 0) return;
  Params p{};
  p.x = (const float*)d_in[0]; p.norm_mix = (const float*)d_in[1]; p.norm_ffn = (const float*)d_in[2]; p.a_w_qkv = (const float*)d_in[3]; p.a_q_gain = (const float*)d_in[4];
  p.a_k_gain = (const float*)d_in[5]; p.a_w_o = (const float*)d_in[6]; p.b_w_in = (const float*)d_in[7]; p.b_q_a_gain = (const float*)d_in[8]; p.b_w_qb = (const float*)d_in[9];
  p.b_kv_a_gain = (const float*)d_in[10]; p.b_w_kvb = (const float*)d_in[11]; p.b_q_gain = (const float*)d_in[12]; p.b_k_gain = (const float*)d_in[13]; p.b_w_o = (const float*)d_in[14];
  p.ffn_w1 = (const float*)d_in[15]; p.ffn_w2 = (const float*)d_in[16]; p.out = (float*)d_out; p.ws = (unsigned char*)d_ws;
  if (hipMemsetAsync((char*)d_ws + WS_BAR, 0, BAR_ZERO_BYTES, stream) != hipSuccess) { fprintf(stderr, "kernel_launch: memset failed\n"); return; }
  void* args[] = {&p};
  hipError_t e = hipLaunchCooperativeKernel((const void*)fwd_megakernel, dim3(grid_blocks), dim3(NTHR), args, LDS_BYTES, stream);
  if (e != hipSuccess) fprintf(stderr, "kernel_launch: cooperative launch failed: %s (grid %d)\n", hipGetErrorString(e), grid_blocks);
}
```

```cpp
#include <hip/hip_runtime.h>
#include <hip/hip_cooperative_groups.h>
#include <cstdio>
#include <cstdint>
namespace cg = cooperative_groups;
__device__ __forceinline__ int mk_lane() { int l; asm volatile("v_mbcnt_lo_u32_b32 %0, -1, 0\n\tv_mbcnt_hi_u32_b32 %0, -1, %0" : "=v"(l)); return l; }
namespace pg8 {
#define PG8_LAS __attribute__((address_space(3)))
typedef unsigned short bf16_t;
typedef short bf16x8 __attribute__((ext_vector_type(8)));
typedef float f32x4 __attribute__((ext_vector_type(4)));
typedef unsigned u32x4 __attribute__((ext_vector_type(4)));
constexpr int BM = 256, BK = 64, HALF = 128, HTB = HALF * BK * 2  , STAGE_BYTES = 8 * HTB, NXCD = 8, WGM = 8;

__host__ __device__ __forceinline__ int lds_byte(int r, int c) { const int st = (r >> 4) * 2 + (c >> 5), rr = r & 15, cc = c & 31, ob = rr * 64 + cc * 2; return st * 1024 + (ob ^ (((ob >> 9) & 1) << 5)); }
__host__ __device__ __forceinline__ void stage_rc(int b, int& R, int& C) { const int st = b / 1024, sb = b % 1024, swz = sb ^ (((sb >> 9) & 1) << 5); R = (st >> 1) * 16 + swz / 64; C = (st & 1) * 32 + (swz % 64) / 2; }
__host__ __device__ __forceinline__ int perm32(int rho) { const int n = rho >> 4, i = rho & 15; return 8 * (i >> 2) + 4 * n + (i & 3); }

struct Unit { int pm, pn; };
struct Gemm { const bf16_t* A; const bf16_t* Bt; int M, N, K; };

struct StaticOrder {
    int nM, nN, nwg, G, c;
    __host__ __device__ void init(int M, int N, int G_, int c_) { nM = M / BM; nN = N / BM; nwg = nM * nN; G = G_; c = c_; }
    __host__ __device__ bool next(int i, Unit& u) const {
        const long L = (long)i * G + c; if (L >= nwg) return false;
        int wgid = (int)L; { const int q = nwg / NXCD, r = nwg % NXCD, xcd = wgid % NXCD, off = wgid / NXCD; wgid = (xcd < r ? xcd * (q + 1) : r * (q + 1) + (xcd - r) * q) + off; }
        const int nig = WGM * nN, gid = wgid / nig, fm = gid * WGM, gsz = (nM - fm) < WGM ? (nM - fm) : WGM;
        u.pm = fm + ((wgid % nig) % gsz); u.pn = (wgid % nig) / gsz; return true;
    }
    __device__ __forceinline__ void a_ready(const Unit&) const {}
    __device__ __forceinline__ void done(const Unit&) const {}
};

__device__ __forceinline__ unsigned cvt_pk_bf16(float lo, float hi) { unsigned r; asm volatile("v_cvt_pk_bf16_f32 %0, %1, %2" : "=v"(r) : "v"(lo), "v"(hi)); return r; }
typedef float f32x2 __attribute__((ext_vector_type(2)));
typedef unsigned u32x2 __attribute__((ext_vector_type(2)));
constexpr float RMS_EPS = 1e-6f;
__device__ __forceinline__ u32x4 pack8(const f32x4& a, const f32x4& b) { u32x4 w; w.x = cvt_pk_bf16(a[0], a[1]); w.y = cvt_pk_bf16(a[2], a[3]); w.z = cvt_pk_bf16(b[0], b[1]); w.w = cvt_pk_bf16(b[2], b[3]); return w; }
__device__ __forceinline__ u32x2 pack4(const f32x4& a) { u32x2 w; w.x = cvt_pk_bf16(a[0], a[1]); w.y = cvt_pk_bf16(a[2], a[3]); return w; }
__device__ __forceinline__ float hsum4(const f32x4& t) { return (t[0] + t[1]) + (t[2] + t[3]); }


__device__ __forceinline__ float row_rstd(const float* rs, int row) { const f32x4 t = *(const f32x4*)(rs + (size_t)row * 4); return rsqrtf(hsum4(t) * (1.0f / 1024.0f) + RMS_EPS); }
__device__ __forceinline__ f32x4 bf2f_lo(const u32x2 u) { f32x4 r; r[0] = __uint_as_float(u.x << 16); r[1] = __uint_as_float(u.x & 0xffff0000u); r[2] = __uint_as_float(u.y << 16); r[3] = __uint_as_float(u.y & 0xffff0000u); return r; }
__device__ __forceinline__ void ss_exchange(const f32x4 (&acc)[2][2][4][2], int wr, int wc, int fr, int fq, PG8_LAS float* P) {
#pragma unroll
    for (int ai = 0; ai < 2; ++ai)
#pragma unroll
        for (int m = 0; m < 4; ++m)
#pragma unroll
            for (int bj = 0; bj < 2; ++bj) {
                const f32x4 a = acc[ai][bj][m][0], b = acc[ai][bj][m][1];
                float s = ((a[0] * a[0] + a[1] * a[1]) + (a[2] * a[2] + a[3] * a[3])) + ((b[0] * b[0] + b[1] * b[1]) + (b[2] * b[2] + b[3] * b[3]));
                s += __shfl_xor(s, 16); s += __shfl_xor(s, 32);
                if (fq == 0) P[((ai * HALF + wr * 64 + m * 16 + fr) * 2 + bj) * 4 + wc] = s;
            }
    asm volatile("s_waitcnt lgkmcnt(0)" ::: "memory"); __builtin_amdgcn_s_barrier(); asm volatile("" ::: "memory");
}

struct EpiResB {
    static constexpr bool PERM = true, AFTER_DRAIN = false;
    const bf16_t* base; bf16_t* out; float* rs; PG8_LAS float* P; const float* rs_in;
    __device__ __forceinline__ void operator()(const f32x4 (&acc)[2][2][4][2], const Unit& u, int wr, int wc, int fr, int fq) const {
        asm volatile("" : "+v"(fr), "+v"(fq));
        const int row0 = u.pm * BM + wr * 64 + fr, col0 = u.pn * BM + wc * 32 + 8 * fq;
        float r2[2][4];
#pragma unroll
        for (int ai = 0; ai < 2; ++ai)
#pragma unroll
            for (int m = 0; m < 4; ++m) { r2[ai][m] = 1.f; if (rs_in != nullptr) { const float r_ = row_rstd(rs_in, row0 + ai * HALF + m * 16); r2[ai][m] = r_ * r_; } }
#pragma unroll
        for (int ai = 0; ai < 2; ++ai) {
            u32x4 pre[4][2];
#pragma unroll
            for (int m = 0; m < 4; ++m)
#pragma unroll
                for (int bj = 0; bj < 2; ++bj) pre[m][bj] = *(const u32x4*)(base + (size_t)(row0 + ai * HALF + m * 16) * 1024 + col0 + bj * HALF);
#pragma unroll
            for (int m = 0; m < 4; ++m) { float ss = 0.f;
#pragma unroll
                for (int bj = 0; bj < 2; ++bj) { const u32x4 b = pre[m][bj];
                    const f32x4 x0 = bf2f_lo((u32x2){b.x, b.y}) + acc[ai][bj][m][0] * r2[ai][m], x1 = bf2f_lo((u32x2){b.z, b.w}) + acc[ai][bj][m][1] * r2[ai][m];
                    ss += ((x0[0] * x0[0] + x0[1] * x0[1]) + (x0[2] * x0[2] + x0[3] * x0[3])) + ((x1[0] * x1[0] + x1[1] * x1[1]) + (x1[2] * x1[2] + x1[3] * x1[3]));
                    *(u32x4*)(out + (size_t)(row0 + ai * HALF + m * 16) * 1024 + col0 + bj * HALF) = pack8(x0, x1); }
                ss += __shfl_xor(ss, 16); ss += __shfl_xor(ss, 32);
                if (fq == 0) P[(ai * HALF + wr * 64 + m * 16 + fr) * 4 + wc] = ss; }
            asm volatile("" ::: "memory"); }
        asm volatile("s_waitcnt lgkmcnt(0)" ::: "memory"); __builtin_amdgcn_s_barrier(); asm volatile("" ::: "memory");
        if (wr == 0) { const int rl = wc * 64 + fq * 16 + fr; const f32x4 t = *(const PG8_LAS f32x4*)(P + rl * 4); rs[(size_t)(u.pm * BM + rl) * 4 + u.pn] = hsum4(t); }
    }
};
struct EpiResF {
    static constexpr bool PERM = false, AFTER_DRAIN = false;
    const bf16_t* base; float* out; const float* rs_in;
    __device__ __forceinline__ void operator()(const f32x4 (&acc)[2][2][4][2], const Unit& u, int wr, int wc, int fr, int fq) const {
        asm volatile("" : "+v"(fr), "+v"(fq));
        const int col0 = u.pn * BM + wc * 32 + 4 * fq;
#pragma unroll
        for (int ai = 0; ai < 2; ++ai) {
            u32x2 pre[4][2][2]; float r2[4];
#pragma unroll
            for (int m = 0; m < 4; ++m) { const float r_ = row_rstd(rs_in, u.pm * BM + ai * HALF + wr * 64 + m * 16 + fr); r2[m] = r_ * r_; }
#pragma unroll
            for (int m = 0; m < 4; ++m) { const size_t off = (size_t)(u.pm * BM + ai * HALF + wr * 64 + m * 16 + fr) * 1024 + col0;
#pragma unroll
                for (int bj = 0; bj < 2; ++bj)
#pragma unroll
                    for (int n = 0; n < 2; ++n) pre[m][bj][n] = *(const u32x2*)(base + off + bj * HALF + n * 16); }
#pragma unroll
            for (int m = 0; m < 4; ++m) { const size_t off = (size_t)(u.pm * BM + ai * HALF + wr * 64 + m * 16 + fr) * 1024 + col0;
#pragma unroll
                for (int bj = 0; bj < 2; ++bj)
#pragma unroll
                    for (int n = 0; n < 2; ++n) *(f32x4*)(out + off + bj * HALF + n * 16) = bf2f_lo(pre[m][bj][n]) + acc[ai][bj][m][n] * r2[m]; }
            asm volatile("" ::: "memory"); }
    }
};
struct EpiRelu2 {
    static constexpr bool PERM = true, AFTER_DRAIN = false;
    bf16_t* O; int ldc; int dry;
    __device__ __forceinline__ void operator()(const f32x4 (&acc)[2][2][4][2], const Unit& u, int wr, int wc, int fr, int fq) const {
        asm volatile("" : "+v"(fr), "+v"(fq));
        if (dry == 2) { if (O == nullptr) *(f32x4*)O = acc[0][0][0][0] + acc[1][1][3][1]; return; }
        const int row0 = u.pm * BM + wr * 64 + fr, col0 = u.pn * BM + wc * 32 + 8 * fq;
#pragma unroll
        for (int ai = 0; ai < 2; ++ai)
#pragma unroll
            for (int m = 0; m < 4; ++m) { bf16_t* rowp = O + (size_t)(row0 + ai * HALF + m * 16) * ldc + col0;
#pragma unroll
                for (int bj = 0; bj < 2; ++bj) { f32x4 v0 = acc[ai][bj][m][0], v1 = acc[ai][bj][m][1];
                    v0 = __builtin_elementwise_max(v0, (f32x4){0.f, 0.f, 0.f, 0.f}); v1 = __builtin_elementwise_max(v1, (f32x4){0.f, 0.f, 0.f, 0.f});
                    v0 = v0 * v0; v1 = v1 * v1; const u32x4 w8_ = pack8(v0, v1); if (!dry) __builtin_nontemporal_store(w8_, (u32x4*)(rowp + bj * HALF)); } }
    }
};
struct EpiQKVA {
    static constexpr bool PERM = true, AFTER_DRAIN = false;
    bf16_t* O; const float* qg; const float* kg; const float* cosT; const float* sinT; PG8_LAS float* P; const float* rs; int rs_row0;
    __device__ __forceinline__ void operator()(const f32x4 (&acc)[2][2][4][2], const Unit& u, int wr, int wc, int fr, int fq) const {
        asm volatile("" : "+v"(fr), "+v"(fq));
        const int c0 = u.pn * BM, which = c0 / 3072;
        float rr[2][4];
#pragma unroll
        for (int ai = 0; ai < 2; ++ai)
#pragma unroll
            for (int m = 0; m < 4; ++m) rr[ai][m] = row_rstd(rs, rs_row0 + u.pm * BM + ai * HALF + wr * 64 + m * 16 + fr);
        if (which == 2) {
            const int row0 = u.pm * BM + wr * 64 + fr, col0 = c0 + wc * 32 + 8 * fq;
#pragma unroll
            for (int ai = 0; ai < 2; ++ai)
#pragma unroll
                for (int m = 0; m < 4; ++m) { bf16_t* rowp = O + (size_t)(row0 + ai * HALF + m * 16) * 9216 + col0;
#pragma unroll
                    for (int bj = 0; bj < 2; ++bj) *(u32x4*)(rowp + bj * HALF) = pack8(acc[ai][bj][m][0] * rr[ai][m], acc[ai][bj][m][1] * rr[ai][m]); }
            return;
        }
        const int g = (c0 % 3072) / 1024; const float* gain = (which == 0 ? qg : kg) + g * 128;
        const int hh = wc >> 1, dm = 32 * (wc & 1) + 8 * fq;
        const f32x4 g0a = *(const f32x4*)(gain + dm), g0b = *(const f32x4*)(gain + dm + 4), g1a = *(const f32x4*)(gain + 64 + dm), g1b = *(const f32x4*)(gain + 64 + dm + 4);
        typedef _Float16 h8 __attribute__((ext_vector_type(8)));
        h8 cs[4], sn[4];
#define QK_TAB(ai) do { _Pragma("unroll") for (int m = 0; m < 4; ++m) { const int pos = (u.pm * BM + (ai) * HALF + wr * 64 + m * 16 + fr) & 8191; \
            cs[m] = *(const h8*)((const _Float16*)cosT + pos * 64 + dm); sn[m] = *(const h8*)((const _Float16*)sinT + pos * 64 + dm); } } while (0)
        QK_TAB(0);
        ss_exchange(acc, wr, wc, fr, fq, P);
#pragma unroll
        for (int ai = 0; ai < 2; ++ai) {
            if (ai == 1) { asm volatile("" ::: "memory"); QK_TAB(1); }
#pragma unroll
            for (int m = 0; m < 4; ++m) { const int rl = ai * HALF + wr * 64 + m * 16 + fr, row = u.pm * BM + rl;
                const f32x4 t0 = *(const PG8_LAS f32x4*)(P + (rl * 2 + 0) * 4), t1 = *(const PG8_LAS f32x4*)(P + (rl * 2 + 1) * 4);
                const float ssh = hh ? ((t0[2] + t0[3]) + (t1[2] + t1[3])) : ((t0[0] + t0[1]) + (t1[0] + t1[1]));
                const float rw = rr[ai][m], rstd = rw * rsqrtf(rw * rw * ssh * (1.0f / 128.0f) + RMS_EPS);
                const h8 ch = cs[m], sh = sn[m];
                const f32x4 ca = {(float)ch[0], (float)ch[1], (float)ch[2], (float)ch[3]}, cb = {(float)ch[4], (float)ch[5], (float)ch[6], (float)ch[7]};
                const f32x4 sa = {(float)sh[0], (float)sh[1], (float)sh[2], (float)sh[3]}, sb = {(float)sh[4], (float)sh[5], (float)sh[6], (float)sh[7]};
                const f32x4 x1a = acc[ai][0][m][0] * rstd * g0a, x1b = acc[ai][0][m][1] * rstd * g0b, x2a = acc[ai][1][m][0] * rstd * g1a, x2b = acc[ai][1][m][1] * rstd * g1b;
                bf16_t* op = O + (size_t)row * 9216 + c0 + hh * 128 + dm;
                *(u32x4*)op = pack8(x1a * ca - x2a * sa, x1b * cb - x2b * sb);
                *(u32x4*)(op + 64) = pack8(x2a * ca + x1a * sa, x2b * cb + x1b * sb); }
        }
#undef QK_TAB
    }
};
struct EpiLat {
    static constexpr bool PERM = true, AFTER_DRAIN = false;
    bf16_t* cqn; bf16_t* ckvn; float* kr; float* ssr; const float* qag; const float* kvag; const float* kg; const float* cos64; const float* sin64; PG8_LAS float* P; const float* rs;
    __device__ __forceinline__ void operator()(const f32x4 (&acc)[2][2][4][2], const Unit& u, int wr, int wc, int fr, int fq) const {
        asm volatile("" : "+v"(fr), "+v"(fq));
        float rr[2][4];
#pragma unroll
        for (int ai = 0; ai < 2; ++ai)
#pragma unroll
            for (int m = 0; m < 4; ++m) rr[ai][m] = row_rstd(rs, u.pm * BM + ai * HALF + wr * 64 + m * 16 + fr);
        ss_exchange(acc, wr, wc, fr, fq, P);
        const int col0 = wc * 32 + 8 * fq;
        if (u.pn == 0) {
            f32x4 ga[2][2];
#pragma unroll
            for (int bj = 0; bj < 2; ++bj) { ga[bj][0] = *(const f32x4*)(qag + bj * HALF + col0); ga[bj][1] = *(const f32x4*)(qag + bj * HALF + col0 + 4); }
#pragma unroll
            for (int ai = 0; ai < 2; ++ai)
#pragma unroll
                for (int m = 0; m < 4; ++m) { const int rl = ai * HALF + wr * 64 + m * 16 + fr, row = u.pm * BM + rl;
                    const f32x4 t0 = *(const PG8_LAS f32x4*)(P + (rl * 2 + 0) * 4), t1 = *(const PG8_LAS f32x4*)(P + (rl * 2 + 1) * 4);
                    const float rw = rr[ai][m], rstd = rw * rsqrtf(rw * rw * (hsum4(t0) + hsum4(t1)) * (1.0f / 256.0f) + RMS_EPS);
#pragma unroll
                    for (int bj = 0; bj < 2; ++bj) *(u32x4*)(cqn + (size_t)row * 256 + bj * HALF + col0) = pack8(acc[ai][bj][m][0] * rstd * ga[bj][0], acc[ai][bj][m][1] * rstd * ga[bj][1]);
                    asm volatile("" ::: "memory"); }
        } else {
            const f32x4 gv0 = *(const f32x4*)(kvag + col0), gv1 = *(const f32x4*)(kvag + col0 + 4);
            const int i0 = (16 * wc + 4 * fq) & 31;
            const f32x4 gk0 = *(const f32x4*)(kg + 128 + i0), gk1 = *(const f32x4*)(kg + 160 + i0);
#pragma unroll
            for (int ai = 0; ai < 2; ++ai)
#pragma unroll
                for (int m = 0; m < 4; ++m) { const int rl = ai * HALF + wr * 64 + m * 16 + fr, row = u.pm * BM + rl, pos = row & 8191;
                    const f32x4 t0 = *(const PG8_LAS f32x4*)(P + (rl * 2 + 0) * 4), t1 = *(const PG8_LAS f32x4*)(P + (rl * 2 + 1) * 4);
                    const float rw = rr[ai][m], rstd = rw * rsqrtf(rw * rw * hsum4(t0) * (1.0f / 128.0f) + RMS_EPS);
                    { const u32x4 w8 = pack8(acc[ai][0][m][0] * rstd * gv0, acc[ai][0][m][1] * rstd * gv1);
                      *(u32x4*)(ckvn + (size_t)row * 128 + col0) = w8; }
                    if (wc < 2) { const f32x4 cs = *(const f32x4*)(cos64 + pos * 32 + i0), sn = *(const f32x4*)(sin64 + pos * 32 + i0);
                        const f32x4 x1 = acc[ai][1][m][0] * rw * gk0, x2 = acc[ai][1][m][1] * rw * gk1;
                        *(f32x4*)(kr + (size_t)row * 64 + i0) = x1 * cs - x2 * sn; *(f32x4*)(kr + (size_t)row * 64 + 32 + i0) = x2 * cs + x1 * sn; }
                    if (wc == 0 && fq == 0) ssr[row] = rw * rw * hsum4(t1);
                    asm volatile("" ::: "memory"); }
        }
    }
};
struct EpiQB {
    static constexpr bool PERM = true, AFTER_DRAIN = false;
    bf16_t* Q; const float* qg; const float* cos64; const float* sin64; PG8_LAS float* P;
    __device__ __forceinline__ void operator()(const f32x4 (&acc)[2][2][4][2], const Unit& u, int wr, int wc, int fr, int fq) const {
        asm volatile("" : "+v"(fr), "+v"(fq));
        const int h = u.pn, col0 = wc * 32 + 8 * fq, i0 = (16 * wc + 4 * fq) & 31;
        const f32x4 ga = *(const f32x4*)(qg + col0), gb = *(const f32x4*)(qg + col0 + 4), gr0 = *(const f32x4*)(qg + 128 + i0), gr1 = *(const f32x4*)(qg + 160 + i0);
        f32x4 csv[2][4], snv[2][4];
        if (wc < 2) {
#pragma unroll
            for (int ai = 0; ai < 2; ++ai)
#pragma unroll
                for (int m = 0; m < 4; ++m) { const int s_ = (u.pm * BM + ai * HALF + wr * 64 + m * 16 + fr) & 8191; csv[ai][m] = *(const f32x4*)(cos64 + s_ * 32 + i0); snv[ai][m] = *(const f32x4*)(sin64 + s_ * 32 + i0); }
        }
        ss_exchange(acc, wr, wc, fr, fq, P);
#pragma unroll
        for (int ai = 0; ai < 2; ++ai)
#pragma unroll
            for (int m = 0; m < 4; ++m) { const int rl = ai * HALF + wr * 64 + m * 16 + fr, row = u.pm * BM + rl, b = row >> 13, s = row & 8191;
                const f32x4 t0 = *(const PG8_LAS f32x4*)(P + (rl * 2 + 0) * 4), t1 = *(const PG8_LAS f32x4*)(P + (rl * 2 + 1) * 4);
                const float rstd = rsqrtf((hsum4(t0) + hsum4(t1)) * (1.0f / 192.0f) + RMS_EPS) * (0.07216878364870322f * 1.4426950408889634f);
                bf16_t* qp = Q + ((size_t)(b * 8 + h) * 8192 + s) * 192;
                *(u32x4*)(qp + col0) = pack8(acc[ai][0][m][0] * rstd * ga, acc[ai][0][m][1] * rstd * gb);
                if (wc < 2) { const f32x4 cs = csv[ai][m], sn = snv[ai][m];
                    const f32x4 x1 = acc[ai][1][m][0] * rstd * gr0, x2 = acc[ai][1][m][1] * rstd * gr1;
                    *(u32x2*)(qp + 128 + i0) = pack4(x1 * cs - x2 * sn); *(u32x2*)(qp + 160 + i0) = pack4(x2 * cs + x1 * sn); } }
    }
};
struct EpiKVB {
    static constexpr bool PERM = true, AFTER_DRAIN = false;
    bf16_t* K; bf16_t* V; const float* kg; const float* kr; const float* ssr; PG8_LAS float* P;
    __device__ __forceinline__ void operator()(const f32x4 (&acc)[2][2][4][2], const Unit& u, int wr, int wc, int fr, int fq) const {
        asm volatile("" : "+v"(fr), "+v"(fq));
        const int h = u.pn, col0 = wc * 32 + 8 * fq, c4 = 4 * (4 * wc + fq);
        const f32x4 ga = *(const f32x4*)(kg + col0), gb = *(const f32x4*)(kg + col0 + 4);
        f32x4 krv[2][4]; float ssv[2][4];
#pragma unroll
        for (int ai = 0; ai < 2; ++ai)
#pragma unroll
            for (int m = 0; m < 4; ++m) { const int row = u.pm * BM + ai * HALF + wr * 64 + m * 16 + fr; ssv[ai][m] = ssr[row]; krv[ai][m] = *(const f32x4*)(kr + (size_t)row * 64 + c4); }
        ss_exchange(acc, wr, wc, fr, fq, P);
#pragma unroll
        for (int ai = 0; ai < 2; ++ai)
#pragma unroll
            for (int m = 0; m < 4; ++m) { const int rl = ai * HALF + wr * 64 + m * 16 + fr, row = u.pm * BM + rl, b = row >> 13, s = row & 8191;
                const f32x4 t0 = *(const PG8_LAS f32x4*)(P + (rl * 2 + 0) * 4);
                const float rstd = rsqrtf((hsum4(t0) + ssv[ai][m]) * (1.0f / 192.0f) + RMS_EPS);
                const size_t tok = (size_t)(b * 8 + h) * 8192 + s;
                bf16_t* kp = K + tok * 192;
                *(u32x4*)(kp + col0) = pack8(acc[ai][0][m][0] * rstd * ga, acc[ai][0][m][1] * rstd * gb);
                const f32x4 r4 = krv[ai][m] * rstd;
                *(u32x2*)(kp + 128 + c4) = pack4(r4);
                *(u32x4*)(V + tok * 128 + col0) = pack8(acc[ai][1][m][0], acc[ai][1][m][1]); }
    }
};

template <class Epi, class Sched, bool ALIGN_EPI = false, bool SP2 = false>
__device__ __forceinline__ void gemm_phase(PG8_LAS unsigned char* lds, const Gemm g, const Sched& S, const Epi& E, int wave_s) {
    int tid_l = wave_s * 64 + mk_lane(); asm volatile("" : "+v"(tid_l));
    const int tid = tid_l, wid = __builtin_amdgcn_readfirstlane(tid >> 6), lane = tid & 63, wr = wid >> 2, wc = wid & 3, fr = lane & 15, fq = lane >> 4;
    int K_l = g.K; asm volatile("" : "+s"(K_l));
    const int K = K_l, nt = K / BK;
    unsigned voffA[2], voffB[2];
#pragma unroll
    for (int i = 0; i < 2; ++i) { int R, C; stage_rc(tid * 16 + i * 8192, R, C); const int Rb = Epi::PERM ? ((R & ~31) + perm32(R & 31)) : R;
        voffA[i] = (unsigned)(R * K + C) * 2u; voffB[i] = (unsigned)(Rb * K + C) * 2u; }
    const size_t kstep = (size_t)(BK * 2);
    const size_t hstep = (size_t)HALF * K * 2;
    const size_t tstep = 2 * hstep;
    const unsigned ldsw = (unsigned)wid * 1024u;
    const int aoff = lds_byte(wr * 64 + fr, fq * 8), boff = lds_byte(wc * 32 + fr, fq * 8);
#define PG8_SA(b, h) (((b) * 2 + (h)) * HTB)
#define PG8_SB(b, h) ((4 + (b) * 2 + (h)) * HTB)
#define PG8_STAGE(bufoff, gbase, voff) do { _Pragma("unroll") for (int _i = 0; _i < 2; ++_i) \
        __builtin_amdgcn_global_load_lds((const unsigned*)((const char*)(gbase) + (voff)[_i]), (PG8_LAS unsigned*)(lds + (bufoff) + ldsw + _i * 8192), 16, 0, 0); } while (0)
#define PG8_LDA(dst, b, h) do { _Pragma("unroll") for (int m = 0; m < 4; ++m) _Pragma("unroll") for (int k = 0; k < 2; ++k) dst[m][k] = *(const PG8_LAS bf16x8*)(lds + PG8_SA(b, h) + aoff + m * 2048 + k * 1024); } while (0)
#define PG8_LDB(dst, b, h) do { _Pragma("unroll") for (int n = 0; n < 2; ++n) _Pragma("unroll") for (int k = 0; k < 2; ++k) dst[n][k] = *(const PG8_LAS bf16x8*)(lds + PG8_SB(b, h) + boff + n * 2048 + k * 1024); } while (0)
#define PG8_MMA(ai, bj, At, Bt) do { __builtin_amdgcn_s_setprio(1); _Pragma("unroll") for (int m = 0; m < 4; ++m) _Pragma("unroll") for (int n = 0; n < 2; ++n) _Pragma("unroll") for (int k = 0; k < 2; ++k) \
        acc[ai][bj][m][n] = __builtin_amdgcn_mfma_f32_16x16x32_bf16(Bt[n][k], At[m][k], acc[ai][bj][m][n], 0, 0, 0); __builtin_amdgcn_s_setprio(0); } while (0)
#define PG8_WAIT_V(n) asm volatile("s_waitcnt vmcnt(" #n ")" ::: "memory")
#define PG8_WAIT_L(n) asm volatile("s_waitcnt lgkmcnt(" #n ")" ::: "memory")
#define PG8_BAR __builtin_amdgcn_s_barrier()
#define PG8_SCHED __builtin_amdgcn_sched_barrier(0)
    Unit cur, nxt; int ui = 0;
    if (!S.next(0, cur)) return;
    f32x4 acc[2][2][4][2];
#pragma unroll
    for (int a = 0; a < 2; ++a)
#pragma unroll
        for (int b = 0; b < 2; ++b)
#pragma unroll
            for (int m = 0; m < 4; ++m)
#pragma unroll
                for (int n = 0; n < 2; ++n) acc[a][b][m][n] = (f32x4){0.f, 0.f, 0.f, 0.f};
    bf16x8 At[4][2], B0[2][2], B1[2][2];
    const char* cA = (const char*)g.A + (size_t)cur.pm * tstep; const char* cB = (const char*)g.Bt + (size_t)cur.pn * tstep;
    S.a_ready(cur);
    if constexpr (SP2) {
        PG8_STAGE(PG8_SB(0, 0), cB, voffB); PG8_STAGE(PG8_SB(0, 1), cB + hstep, voffB); PG8_STAGE(PG8_SA(0, 0), cA, voffA); PG8_STAGE(PG8_SA(0, 1), cA + hstep, voffA);
        if (wr == 1) PG8_BAR;
        PG8_WAIT_V(2); PG8_BAR;
        PG8_STAGE(PG8_SB(1, 0), cB + kstep, voffB); PG8_STAGE(PG8_SA(1, 0), cA + kstep, voffA); PG8_STAGE(PG8_SB(1, 1), cB + hstep + kstep, voffB);
        PG8_WAIT_V(6); PG8_BAR;
    } else {
        PG8_STAGE(PG8_SB(0, 0), cB, voffB); PG8_STAGE(PG8_SA(0, 0), cA, voffA); PG8_STAGE(PG8_SB(0, 1), cB + hstep, voffB); PG8_STAGE(PG8_SA(0, 1), cA + hstep, voffA);
        if (wr == 1) PG8_BAR;
        PG8_WAIT_V(4); PG8_BAR;
        PG8_STAGE(PG8_SB(1, 0), cB + kstep, voffB); PG8_STAGE(PG8_SA(1, 0), cA + kstep, voffA); PG8_STAGE(PG8_SB(1, 1), cB + hstep + kstep, voffB);
        PG8_WAIT_V(6); PG8_BAR;
    }
    for (;;) {
        const bool has_next = S.next(ui + 1, nxt);
        const char* nA = has_next ? (const char*)g.A + (size_t)nxt.pm * tstep : cA; const char* nB = has_next ? (const char*)g.Bt + (size_t)nxt.pn * tstep : cB;
        for (int t = 0; t < nt; t += 2) {
            const bool last = (t == nt - 2);
            const char* a1 = cA + (size_t)(t + 1) * kstep;
            const char* a2 = last ? nA : cA + (size_t)(t + 2) * kstep; const char* b2 = last ? nB : cB + (size_t)(t + 2) * kstep;
            const char* a3 = a2 + kstep; const char* b3 = b2 + kstep;
            if (last && has_next) S.a_ready(nxt);
            if constexpr (SP2) {
            PG8_LDB(B0, 0, 0); PG8_LDB(B1, 0, 1); PG8_SCHED; PG8_LDA(At, 0, 0); PG8_STAGE(PG8_SA(1, 1), a1 + hstep, voffA);
            PG8_WAIT_V(8); PG8_WAIT_L(0); PG8_BAR; PG8_MMA(0, 0, At, B0); PG8_MMA(0, 1, At, B1); PG8_BAR; PG8_SCHED;
            PG8_LDA(At, 0, 1); PG8_STAGE(PG8_SB(0, 0), b2, voffB); PG8_STAGE(PG8_SB(0, 1), b2 + hstep, voffB); PG8_STAGE(PG8_SA(0, 0), a2, voffA);
            PG8_WAIT_V(8); PG8_WAIT_L(0); PG8_BAR; PG8_MMA(1, 0, At, B0); PG8_MMA(1, 1, At, B1); PG8_BAR; PG8_SCHED;
            PG8_LDB(B0, 1, 0); PG8_LDB(B1, 1, 1); PG8_SCHED; PG8_LDA(At, 1, 0); PG8_STAGE(PG8_SA(0, 1), a2 + hstep, voffA);
            PG8_WAIT_V(8); PG8_WAIT_L(0); PG8_BAR; PG8_MMA(0, 0, At, B0); PG8_MMA(0, 1, At, B1); PG8_BAR; PG8_SCHED;
            PG8_LDA(At, 1, 1); PG8_STAGE(PG8_SB(1, 0), b3, voffB); PG8_STAGE(PG8_SB(1, 1), b3 + hstep, voffB); PG8_STAGE(PG8_SA(1, 0), a3, voffA);
            PG8_WAIT_V(8); PG8_WAIT_L(0); PG8_BAR; PG8_MMA(1, 0, At, B0); PG8_MMA(1, 1, At, B1); PG8_BAR; PG8_SCHED;
            } else {
            PG8_LDB(B0, 0, 0); PG8_SCHED; PG8_LDA(At, 0, 0); PG8_STAGE(PG8_SA(1, 1), a1 + hstep, voffA);
            PG8_WAIT_L(8); PG8_BAR; PG8_WAIT_L(0); PG8_MMA(0, 0, At, B0); PG8_BAR; PG8_SCHED;
            PG8_LDB(B1, 0, 1); PG8_STAGE(PG8_SB(0, 0), b2, voffB);
            PG8_BAR; PG8_WAIT_L(0); PG8_MMA(0, 1, At, B1); PG8_BAR;
            PG8_LDA(At, 0, 1); PG8_STAGE(PG8_SA(0, 0), a2, voffA);
            PG8_BAR; PG8_WAIT_L(0); PG8_MMA(1, 0, At, B0); PG8_BAR; PG8_SCHED;
            PG8_STAGE(PG8_SB(0, 1), b2 + hstep, voffB);
            PG8_WAIT_V(6); PG8_BAR; PG8_MMA(1, 1, At, B1); PG8_BAR;
            PG8_LDB(B0, 1, 0); PG8_SCHED; PG8_LDA(At, 1, 0); PG8_STAGE(PG8_SA(0, 1), a2 + hstep, voffA);
            PG8_WAIT_L(8); PG8_BAR; PG8_WAIT_L(0); PG8_MMA(0, 0, At, B0); PG8_BAR; PG8_SCHED;
            PG8_LDB(B1, 1, 1); PG8_STAGE(PG8_SB(1, 0), b3, voffB);
            PG8_BAR; PG8_WAIT_L(0); PG8_MMA(0, 1, At, B1); PG8_BAR;
            PG8_LDA(At, 1, 1); PG8_STAGE(PG8_SA(1, 0), a3, voffA);
            PG8_BAR; PG8_WAIT_L(0); PG8_MMA(1, 0, At, B0); PG8_BAR; PG8_SCHED;
            PG8_STAGE(PG8_SB(1, 1), b3 + hstep, voffB);
            PG8_WAIT_V(6); PG8_BAR; PG8_MMA(1, 1, At, B1); PG8_BAR;
            }
        }
        if constexpr (ALIGN_EPI) { if (wr == 0) PG8_BAR; }
        if constexpr (!Epi::AFTER_DRAIN) { E(acc, cur, wr, wc, fr, fq); S.done(cur); }
        if (!has_next) break;
#pragma unroll
        for (int a = 0; a < 2; ++a)
#pragma unroll
            for (int b = 0; b < 2; ++b)
#pragma unroll
                for (int m = 0; m < 4; ++m)
#pragma unroll
                    for (int n = 0; n < 2; ++n) acc[a][b][m][n] = (f32x4){0.f, 0.f, 0.f, 0.f};
        cur = nxt; cA = nA; cB = nB; ++ui;
        if constexpr (ALIGN_EPI) { if (wr == 1) PG8_BAR; }
    }
    PG8_WAIT_V(0);
    if constexpr (!ALIGN_EPI) { if (wr == 0) PG8_BAR; }
    PG8_BAR;
    if constexpr (Epi::AFTER_DRAIN) { E.fused(acc, cur, wr, wc, fr, fq, lds, wid, lane); S.done(cur); }
#undef PG8_SA
#undef PG8_SB
#undef PG8_STAGE
#undef PG8_LDA
#undef PG8_LDB
#undef PG8_MMA
#undef PG8_WAIT_V
#undef PG8_WAIT_L
#undef PG8_BAR
#undef PG8_SCHED
}
}
namespace att {
#define ATT_LAS __attribute__((address_space(3)))
typedef unsigned short bf16_t;
typedef short bf16x8 __attribute__((ext_vector_type(8)));
typedef short s16x4 __attribute__((ext_vector_type(4)));
typedef float f32x16 __attribute__((ext_vector_type(16)));
typedef unsigned u32x4 __attribute__((ext_vector_type(4)));
#define SBAR() __builtin_amdgcn_sched_barrier(0)
__device__ __forceinline__ int crow(int r, int hi) { return (r & 3) + 8 * (r >> 2) + 4 * hi; }
__device__ __forceinline__ unsigned cvtpk(float lo, float hi) { unsigned r; asm volatile("v_cvt_pk_bf16_f32 %0, %1, %2" : "=v"(r) : "v"(lo), "v"(hi)); return r; }
__device__ __forceinline__ unsigned short f2bf(float f) { return (unsigned short)(cvtpk(f, f) & 0xffffu); }

template <int THRON>
__device__ __forceinline__ void partialSM(f32x16& p0, f32x16& p1, float& m_reg, float& mn, float& alpha, float C, float thr_raw) {
  float pmax = p0[0];
#pragma unroll
  for (int r = 1; r < 16; ++r) pmax = fmaxf(pmax, p0[r]);
#pragma unroll
  for (int r = 0; r < 16; ++r) pmax = fmaxf(pmax, p1[r]);
  { auto rr = __builtin_amdgcn_permlane32_swap(__float_as_uint(pmax), __float_as_uint(pmax), false, false);
    pmax = fmaxf(__uint_as_float(rr[0]), __uint_as_float(rr[1])); }
  if (THRON && __builtin_expect(__all(pmax - m_reg <= thr_raw), 1)) { mn = m_reg; alpha = 1.f; }
  else { mn = fmaxf(m_reg, pmax); alpha = __builtin_amdgcn_exp2f((m_reg - mn) * C); m_reg = mn; }
  const float mnC = -mn * C;
#pragma unroll
  for (int r = 0; r < 16; ++r) p0[r] = fmaf(p0[r], C, mnC);
#pragma unroll
  for (int r = 0; r < 16; ++r) p1[r] = fmaf(p1[r], C, mnC);
#pragma unroll
  for (int r = 0; r < 16; ++r) p0[r] = __builtin_amdgcn_exp2f(p0[r]);
}
__device__ __forceinline__ void partialSM_ref(f32x16& p0, f32x16& p1, float& mref, f32x16& negm, float& alpha, float thr2, bool first, bool check) {
  if (!check) { alpha = 1.f;
#pragma unroll
    for (int r = 0; r < 16; ++r) p0[r] = __builtin_amdgcn_exp2f(p0[r]);
    return; }
  float pmax = p0[0];
#pragma unroll
  for (int r = 1; r < 16; ++r) pmax = fmaxf(pmax, p0[r]);
#pragma unroll
  for (int r = 0; r < 16; ++r) pmax = fmaxf(pmax, p1[r]);
  { auto rr = __builtin_amdgcn_permlane32_swap(__float_as_uint(pmax), __float_as_uint(pmax), false, false);
    pmax = fmaxf(__uint_as_float(rr[0]), __uint_as_float(rr[1])); }
  if (!first && __builtin_expect(__all(pmax <= thr2), 1)) { alpha = 1.f; }
  else { const float dl = first ? pmax : fmaxf(pmax, 0.f); mref += dl; alpha = first ? 1.f : __builtin_amdgcn_exp2f(-dl);
#pragma unroll
    for (int r = 0; r < 16; ++r) { p0[r] -= dl; p1[r] -= dl; }
#pragma unroll
    for (int r = 0; r < 16; ++r) negm[r] = -mref; }
#pragma unroll
  for (int r = 0; r < 16; ++r) p0[r] = __builtin_amdgcn_exp2f(p0[r]);
}
__device__ __forceinline__ void finishSM(f32x16& p0, f32x16& p1, float alpha, float& l_reg, bf16x8& pa0, bf16x8& pa1, bf16x8& pa2, bf16x8& pa3) {
#pragma unroll
  for (int r = 0; r < 16; ++r) p1[r] = __builtin_amdgcn_exp2f(p1[r]);
  float ps = 0;
#pragma unroll
  for (int r = 0; r < 16; ++r) ps += p0[r];
#pragma unroll
  for (int r = 0; r < 16; ++r) ps += p1[r];
  { auto rr = __builtin_amdgcn_permlane32_swap(__float_as_uint(ps), __float_as_uint(ps), false, false);
    ps = __uint_as_float(rr[0]) + __uint_as_float(rr[1]); }
  l_reg = l_reg * alpha + ps;
#define PK4(P, BASE, OUT) do { unsigned a0 = cvtpk(P[BASE + 0], P[BASE + 1]), a1 = cvtpk(P[BASE + 2], P[BASE + 3]);   \
    unsigned b0 = cvtpk(P[BASE + 4], P[BASE + 5]), b1 = cvtpk(P[BASE + 6], P[BASE + 7]);                              \
    auto r0 = __builtin_amdgcn_permlane32_swap(a0, b0, false, false); auto r1 = __builtin_amdgcn_permlane32_swap(a1, b1, false, false); \
    u32x4 w = {r0[0], r1[0], r0[1], r1[1]}; OUT = __builtin_bit_cast(bf16x8, w); } while (0)
  PK4(p0, 0, pa0); PK4(p0, 8, pa1); PK4(p1, 0, pa2); PK4(p1, 8, pa3);
#undef PK4
}
template <int DQK> __device__ __forceinline__ constexpr int kstride() { return DQK * 2 + 16; }
template <int DQK> __device__ __forceinline__ int kswz(int row, int colB) { return row * kstride<DQK>() + colB; }
template <int DQK, int LA = 2> __device__ __forceinline__ void qkt(f32x16& p0, f32x16& p1, const ATT_LAS char* Ks, const bf16x8* qr, int r32, int hi) {
  constexpr int N = DQK / 16;
  const ATT_LAS char* k0 = Ks + r32 * kstride<DQK>(); const ATT_LAS char* k1 = Ks + (32 + r32) * kstride<DQK>(); const int sw = 0;
  bf16x8 kf[N][2];
  p0 = f32x16{}; p1 = f32x16{};
#pragma unroll
  for (int d0 = 0; d0 < LA; ++d0) { const int cb = ((d0 * 16 + hi * 8) * 2) ^ sw; kf[d0][0] = *(const ATT_LAS bf16x8*)(k0 + cb); kf[d0][1] = *(const ATT_LAS bf16x8*)(k1 + cb); }
  SBAR();
#pragma unroll
  for (int d0 = 0; d0 < N; ++d0) {
    if (d0 + LA < N) { const int cb = (((d0 + LA) * 16 + hi * 8) * 2) ^ sw; kf[d0 + LA][0] = *(const ATT_LAS bf16x8*)(k0 + cb); kf[d0 + LA][1] = *(const ATT_LAS bf16x8*)(k1 + cb); }
    SBAR();
    p0 = __builtin_amdgcn_mfma_f32_32x32x16_bf16(kf[d0][0], qr[d0], p0, 0, 0, 0);
    p1 = __builtin_amdgcn_mfma_f32_32x32x16_bf16(kf[d0][1], qr[d0], p1, 0, 0, 0);
    SBAR();
  }
}
template <int DQK, int LA = 2> __device__ __forceinline__ void qkt_c(f32x16& p0, f32x16& p1, const ATT_LAS char* Ks, const bf16x8* qr, int r32, int hi, const f32x16& cinit) {
  constexpr int N = DQK / 16;
  const ATT_LAS char* k0 = Ks + r32 * kstride<DQK>(); const ATT_LAS char* k1 = Ks + (32 + r32) * kstride<DQK>(); const int sw = 0;
  bf16x8 kf[N][2];
  p0 = cinit; p1 = cinit;
#pragma unroll
  for (int d0 = 0; d0 < LA; ++d0) { const int cb = ((d0 * 16 + hi * 8) * 2) ^ sw; kf[d0][0] = *(const ATT_LAS bf16x8*)(k0 + cb); kf[d0][1] = *(const ATT_LAS bf16x8*)(k1 + cb); }
  SBAR();
#pragma unroll
  for (int d0 = 0; d0 < N; ++d0) {
    if (d0 + LA < N) { const int cb = (((d0 + LA) * 16 + hi * 8) * 2) ^ sw; kf[d0 + LA][0] = *(const ATT_LAS bf16x8*)(k0 + cb); kf[d0 + LA][1] = *(const ATT_LAS bf16x8*)(k1 + cb); }
    SBAR();
    p0 = __builtin_amdgcn_mfma_f32_32x32x16_bf16(kf[d0][0], qr[d0], p0, 0, 0, 0);
    p1 = __builtin_amdgcn_mfma_f32_32x32x16_bf16(kf[d0][1], qr[d0], p1, 0, 0, 0);
    SBAR();
  }
}
__device__ __forceinline__ int v_st(int k, int c) { const int kk = (k & ~0xC) | ((k & 4) << 1) | ((k & 8) >> 1); return ((kk >> 3) * 4 + (c >> 5)) * 512 + ((kk & 7) * 32 + (c & 31)) * 2; }
__device__ __forceinline__ int v_rd_base(int lane) { return ((lane & 3) << 3) | (((lane >> 2) & 3) << 6) | (((lane >> 4) & 1) << 5) | (((lane >> 5) & 1) << 8); }
constexpr int v_rd_off(int d0, int ks, int half) { return d0 * 512 + ks * 4096 + half * 2048; }
template <int OFF> __device__ __forceinline__ s16x4 tr_read(int vb) { s16x4 r; asm volatile("ds_read_b64_tr_b16 %0, %1 offset:%2" : "=&v"(r) : "v"(vb), "i"(OFF) : "memory"); return r; }
template <int D0> __device__ __forceinline__ void pv_one(f32x16& od, int vb, bf16x8 pa0, bf16x8 pa1, bf16x8 pa2, bf16x8 pa3) {
  const s16x4 l0 = tr_read<v_rd_off(D0, 0, 0)>(vb), h0 = tr_read<v_rd_off(D0, 0, 1)>(vb), l1 = tr_read<v_rd_off(D0, 1, 0)>(vb), h1 = tr_read<v_rd_off(D0, 1, 1)>(vb);
  const s16x4 l2 = tr_read<v_rd_off(D0, 2, 0)>(vb), h2 = tr_read<v_rd_off(D0, 2, 1)>(vb), l3 = tr_read<v_rd_off(D0, 3, 0)>(vb), h3 = tr_read<v_rd_off(D0, 3, 1)>(vb);
  asm volatile("s_waitcnt lgkmcnt(0)" ::: "memory"); SBAR();
#define PK(L, H) (bf16x8){L[0], L[1], L[2], L[3], H[0], H[1], H[2], H[3]}
  od = __builtin_amdgcn_mfma_f32_32x32x16_bf16(pa0, PK(l0, h0), od, 0, 0, 0);
  od = __builtin_amdgcn_mfma_f32_32x32x16_bf16(pa1, PK(l1, h1), od, 0, 0, 0);
  od = __builtin_amdgcn_mfma_f32_32x32x16_bf16(pa2, PK(l2, h2), od, 0, 0, 0);
  od = __builtin_amdgcn_mfma_f32_32x32x16_bf16(pa3, PK(l3, h3), od, 0, 0, 0);
#undef PK
}
__device__ __forceinline__ void pv_d0(f32x16* o, int vb, bf16x8 pa0, bf16x8 pa1, bf16x8 pa2, bf16x8 pa3) {
  pv_one<0>(o[0], vb, pa0, pa1, pa2, pa3); pv_one<1>(o[1], vb, pa0, pa1, pa2, pa3); pv_one<2>(o[2], vb, pa0, pa1, pa2, pa3); pv_one<3>(o[3], vb, pa0, pa1, pa2, pa3);
}

template <int D0> __device__ __forceinline__ void pv_reads(s16x4 (&l)[4], s16x4 (&h)[4], int vb) {
  l[0] = tr_read<v_rd_off(D0, 0, 0)>(vb); h[0] = tr_read<v_rd_off(D0, 0, 1)>(vb); l[1] = tr_read<v_rd_off(D0, 1, 0)>(vb); h[1] = tr_read<v_rd_off(D0, 1, 1)>(vb);
  l[2] = tr_read<v_rd_off(D0, 2, 0)>(vb); h[2] = tr_read<v_rd_off(D0, 2, 1)>(vb); l[3] = tr_read<v_rd_off(D0, 3, 0)>(vb); h[3] = tr_read<v_rd_off(D0, 3, 1)>(vb);
}
__device__ __forceinline__ void pv_mma(f32x16& od, const s16x4 (&l)[4], const s16x4 (&h)[4], bf16x8 pa0, bf16x8 pa1, bf16x8 pa2, bf16x8 pa3) {
#define PK(L, H) (bf16x8){L[0], L[1], L[2], L[3], H[0], H[1], H[2], H[3]}
  od = __builtin_amdgcn_mfma_f32_32x32x16_bf16(pa0, PK(l[0], h[0]), od, 0, 0, 0);
  od = __builtin_amdgcn_mfma_f32_32x32x16_bf16(pa1, PK(l[1], h[1]), od, 0, 0, 0);
  od = __builtin_amdgcn_mfma_f32_32x32x16_bf16(pa2, PK(l[2], h[2]), od, 0, 0, 0);
  od = __builtin_amdgcn_mfma_f32_32x32x16_bf16(pa3, PK(l[3], h[3]), od, 0, 0, 0);
#undef PK
}
__device__ __forceinline__ void pv_d0_la(f32x16* o, int vb, bf16x8 pa0, bf16x8 pa1, bf16x8 pa2, bf16x8 pa3) {
  s16x4 la[4], ha[4], lb[4], hb[4];
  pv_reads<0>(la, ha, vb); pv_reads<1>(lb, hb, vb);
  asm volatile("s_waitcnt lgkmcnt(8)" ::: "memory"); SBAR(); pv_mma(o[0], la, ha, pa0, pa1, pa2, pa3); SBAR();
  pv_reads<2>(la, ha, vb);
  asm volatile("s_waitcnt lgkmcnt(8)" ::: "memory"); SBAR(); pv_mma(o[1], lb, hb, pa0, pa1, pa2, pa3); SBAR();
  pv_reads<3>(lb, hb, vb);
  asm volatile("s_waitcnt lgkmcnt(8)" ::: "memory"); SBAR(); pv_mma(o[2], la, ha, pa0, pa1, pa2, pa3); SBAR();
  asm volatile("s_waitcnt lgkmcnt(0)" ::: "memory"); SBAR(); pv_mma(o[3], lb, hb, pa0, pa1, pa2, pa3);
}

template <int DQK, bool BAND>
__device__ __forceinline__ void attn_unit(const bf16_t* Qb, long ldq, const bf16_t* Kb, long ldk, const bf16_t* Vb, long ldv, bf16_t* Ob, long ldo, float* lse, long ldl,
                                          int kt0, int kt1, int qtile0, float scale, ATT_LAS char* lds, int wave_s) {
  constexpr int KB_BYTES = 64 * DQK * 2, VB_BYTES = 64 * 128 * 2, KCH = DQK / 8, NKC = DQK / 64;
  int tid_l = wave_s * 64 + mk_lane(); asm volatile("" : "+v"(tid_l));
  const int tid = tid_l, wid = __builtin_amdgcn_readfirstlane(tid >> 6), lane = tid & 63, r32 = lane & 31, hi = lane >> 5;
  ATT_LAS char* V_lds = lds; ATT_LAS char* K_lds = lds + 2 * VB_BYTES;
  ATT_LAS float* wsf = (ATT_LAS float*)(lds + 2 * VB_BYTES + 2 * KB_BYTES) + wid * 64; ATT_LAS float* li_l = wsf; ATT_LAS float* al_l = wsf + 32;
  const float C = scale * 1.4426950408889634f, thr_raw = 8.0f / scale;
  bf16x8 qr[DQK / 16];
  { const bf16_t* Qw = Qb + (long)(wid * 32 + r32) * ldq + hi * 8;
#pragma unroll
    for (int d0 = 0; d0 < DQK / 16; ++d0) qr[d0] = *(const bf16x8*)(Qw + d0 * 16); }
  float m_reg = -1e30f, l_reg = 0.f; f32x16 o[4] = {};
  const int qb = qtile0 + (wid >> 1), qi = (wid & 1) * 32 + r32;
  const int vb0 = (int)(unsigned)(uintptr_t)V_lds + v_rd_base(lane);
  bf16x8 ks[NKC], vs[2];
  const int vrow = tid >> 4, vcol = (tid & 15) * 8;
#define SLOAD(t) do { _Pragma("unroll") for (int i_ = 0; i_ < NKC; ++i_) { const int id_ = tid + 512 * i_, row_ = id_ / KCH, c8_ = id_ % KCH; ks[i_] = *(const bf16x8*)(Kb + (long)((t) * 64 + row_) * ldk + c8_ * 8); } \
    _Pragma("unroll") for (int i_ = 0; i_ < 2; ++i_) vs[i_] = *(const bf16x8*)(Vb + (long)((t) * 64 + vrow + 32 * i_) * ldv + vcol); } while (0)
#define SWRITE(b) do { _Pragma("unroll") for (int i_ = 0; i_ < NKC; ++i_) { const int id_ = tid + 512 * i_, row_ = id_ / KCH, c8_ = id_ % KCH; *(ATT_LAS bf16x8*)(K_lds + (b) * KB_BYTES + kswz<DQK>(row_, c8_ * 16)) = ks[i_]; } \
    _Pragma("unroll") for (int i_ = 0; i_ < 2; ++i_) *(ATT_LAS bf16x8*)(V_lds + (b) * VB_BYTES + v_st(vrow + 32 * i_, vcol)) = vs[i_]; } while (0)
  SLOAD(kt0); SWRITE(0); __syncthreads();
  for (int t = kt0; t < kt1; ++t) {
    const int b = (t - kt0) & 1; const bool more = (t + 1 < kt1);
    if (more) SLOAD(t + 1);
    const bool act = !BAND || (t >= qb - 1 && t <= qb + 1);
    if (act) {
      f32x16 p0, p1; qkt<DQK>(p0, p1, K_lds + b * KB_BYTES, qr, r32, hi);
      if (BAND) {
        if (t == qb - 1) {
#pragma unroll
          for (int r = 0; r < 16; ++r) { const int k0 = crow(r, hi); if (k0 < qi) p0[r] = -1e30f; if (k0 + 32 < qi) p1[r] = -1e30f; }
        } else if (t == qb + 1) {
#pragma unroll
          for (int r = 0; r < 16; ++r) { const int k0 = crow(r, hi); if (k0 > qi) p0[r] = -1e30f; if (k0 + 32 > qi) p1[r] = -1e30f; }
        }
      }
      float mn, alpha; partialSM<1>(p0, p1, m_reg, mn, alpha, C, thr_raw);
      bf16x8 pa0, pa1, pa2, pa3; finishSM(p0, p1, alpha, l_reg, pa0, pa1, pa2, pa3);
      if (__any(alpha < 1.f)) { if (hi == 0) al_l[r32] = alpha; asm volatile("s_waitcnt lgkmcnt(0)" ::: "memory");
#pragma unroll
        for (int d = 0; d < 4; ++d)
#pragma unroll
          for (int r = 0; r < 16; ++r) o[d][r] *= al_l[crow(r, hi)]; }
      pv_d0(o, vb0 + b * VB_BYTES, pa0, pa1, pa2, pa3);
    }
    if (more) SWRITE(b ^ 1);
    __syncthreads();
  }
#undef SLOAD
#undef SWRITE
  if (hi == 0) li_l[r32] = l_reg;
  asm volatile("s_waitcnt lgkmcnt(0)" ::: "memory");
  float rli[16];
#pragma unroll
  for (int r = 0; r < 16; ++r) rli[r] = __builtin_amdgcn_rcpf(li_l[crow(r, hi)]);
  bf16_t* Ow = Ob + (long)(wid * 32) * ldo;
#pragma unroll
  for (int r = 0; r < 16; ++r) { const int orow = crow(r, hi);
#pragma unroll
    for (int d0 = 0; d0 < 4; ++d0) Ow[(long)orow * ldo + d0 * 32 + r32] = f2bf(o[d0][r] * rli[r]); }
  if (lse != nullptr && hi == 0) lse[(long)(wid * 32 + r32) * ldl] = m_reg * scale + __logf(l_reg);
}

__device__ __forceinline__ void glds16(const void* gsrc, unsigned lds_dst) { unsigned keep;
  asm volatile("s_mov_b32 %0, m0\n\ts_mov_b32 m0, %2\n\ts_nop 0\n\tglobal_load_lds_dwordx4 %1, off\n\ts_mov_b32 m0, %0" : "=&s"(keep) : "v"(gsrc), "s"(lds_dst) : "memory"); }
#define WAIT_BAR(N) asm volatile("s_waitcnt vmcnt(" #N ") lgkmcnt(0)\n\ts_barrier" ::: "memory")
#define WAIT_BAR2(N0, N) do { if (wid == 0) WAIT_BAR(N0); else WAIT_BAR(N); } while (0)
#ifndef MLA_LA
#define MLA_LA 1
#endif
#ifndef MLA_PP_LA
#define MLA_PP_LA 6
#endif
constexpr int MLA_KSLOT = 64 * 400, MLA_KTILE = 64 * 192 * 2, MLA_VSLOT = 64 * 128 * 2, MLA_K0 = 0, MLA_V0 = 3 * MLA_KSLOT, MLA_WS = MLA_V0 + 3 * MLA_VSLOT, MLA_LDS = MLA_WS + 8 * 256;
template <int MODE = 0> __device__ __forceinline__ void mla_unit(const bf16_t* Qb, const bf16_t* Kh, const bf16_t* Vh, bf16_t* Ob, long ldo, int NT, float scale, ATT_LAS char* lds, int wave_s, bool do_store = true) {
  int tid_l = wave_s * 64 + mk_lane(); asm volatile("" : "+v"(tid_l));
  const int tid = tid_l, wid = __builtin_amdgcn_readfirstlane(tid >> 6), lane = tid & 63, r32 = lane & 31, hi = lane >> 5;
  const unsigned lds0 = (unsigned)(uintptr_t)lds;
  ATT_LAS float* wsf = (ATT_LAS float*)(lds + MLA_WS) + wid * 64; ATT_LAS float* li_l = wsf; ATT_LAS float* al_l = wsf + 32;
  const float C = scale * 1.4426950408889634f, thr_raw = 8.0f / scale;
  int ksrc[4], vsrc[2];
#pragma unroll
  for (int i = 0; i < 4; ++i) { const int gch = 64 * (wid + 8 * i) + lane, row = gch / 25, cc = gch % 25; ksrc[i] = row * 384 + (cc < 24 ? cc * 16 : 0); }
#pragma unroll
  for (int i = 0; i < 2; ++i) { const int B = 1024 * (2 * wid + i) + 16 * lane, sub = B >> 9, e = (B & 511) >> 1, kk = (sub >> 2) * 8 + (e >> 5), c = (sub & 3) * 32 + (e & 31);
    const int k = (kk & ~0xC) | ((kk & 4) << 1) | ((kk & 8) >> 1); vsrc[i] = (k * 128 + c) * 2; }
#define DMA_K(t, slot) do { const int t_ = (t) < NT ? (t) : NT - 1; const char* g_ = (const char*)Kh + (long)t_ * MLA_KTILE; \
    _Pragma("unroll") for (int i_ = 0; i_ < 4; ++i_) if ((i_ < 3 || wid == 0) && !(MODE & 2)) glds16(g_ + ksrc[i_], (unsigned)__builtin_amdgcn_readfirstlane(lds0 + MLA_K0 + (slot) * MLA_KSLOT + 1024 * (wid + 8 * i_))); } while (0)
#define DMA_V(t, slot) do { const int t_ = (t) < NT ? (t) : NT - 1; const char* g_ = (const char*)Vh + (long)t_ * MLA_VSLOT; \
    _Pragma("unroll") for (int i_ = 0; i_ < 2; ++i_) if (!(MODE & 2)) glds16(g_ + vsrc[i_], (unsigned)__builtin_amdgcn_readfirstlane(lds0 + MLA_V0 + (slot) * MLA_VSLOT + 1024 * (2 * wid + i_))); } while (0)
  DMA_K(0, 0); DMA_V(0, 0); DMA_K(1, 1); DMA_V(1, 1); DMA_K(2, 2);
  bf16x8 qr[12];
  { const bf16_t* Qw = Qb + (long)(wid * 32 + r32) * 192 + hi * 8;
#pragma unroll
    for (int d0 = 0; d0 < 12; ++d0) qr[d0] = *(const bf16x8*)(Qw + d0 * 16); }
  float m_reg = -1e30f, l_reg = 0.f; f32x16 o[4] = {};
  const int vb0 = (int)(lds0 + MLA_V0) + v_rd_base(lane);
  f32x16 pA0, pA1, pB0, pB1; float mnA, mnB, alA, alB; bf16x8 pa0, pa1, pa2, pa3;
#define RESC(a) do { if (__any((a) < 1.f)) { if (hi == 0) al_l[r32] = (a); asm volatile("s_waitcnt lgkmcnt(0)" ::: "memory"); \
    _Pragma("unroll") for (int d = 0; d < 4; ++d) _Pragma("unroll") for (int r = 0; r < 16; ++r) o[d][r] *= al_l[crow(r, hi)]; } } while (0)
  WAIT_BAR(0);
  if (wid >= 4) __builtin_amdgcn_s_setprio(1);
  qkt<192, MLA_LA>(pA0, pA1, lds + MLA_K0, qr, r32, hi); partialSM<1>(pA0, pA1, m_reg, mnA, alA, C, thr_raw);
  WAIT_BAR(0);
  int s_m1 = 0, s_0 = 1, s_p1 = 2;
#define ROT() do { const int t_ = s_m1; s_m1 = s_0; s_0 = s_p1; s_p1 = t_; } while (0)
#define STEP(X0, X1, mnX, alX, Y0, Y1, alY, j) do { \
    SBAR(); qkt<192, MLA_LA>(X0, X1, lds + MLA_K0 + s_0 * MLA_KSLOT, qr, r32, hi); \
    if (MODE & 1) { pa0 = __builtin_bit_cast(bf16x8, (u32x4){__float_as_uint(Y0[0]), __float_as_uint(Y0[1]), __float_as_uint(Y0[2]), __float_as_uint(Y0[3])}); pa1 = __builtin_bit_cast(bf16x8, (u32x4){__float_as_uint(Y0[4]), __float_as_uint(Y0[5]), __float_as_uint(Y0[6]), __float_as_uint(Y0[7])}); \
      pa2 = __builtin_bit_cast(bf16x8, (u32x4){__float_as_uint(Y1[0]), __float_as_uint(Y1[1]), __float_as_uint(Y1[2]), __float_as_uint(Y1[3])}); pa3 = __builtin_bit_cast(bf16x8, (u32x4){__float_as_uint(Y1[4]), __float_as_uint(Y1[5]), __float_as_uint(Y1[6]), __float_as_uint(Y1[7])}); } \
    else finishSM(Y0, Y1, alY, l_reg, pa0, pa1, pa2, pa3); SBAR(); \
    DMA_K((j) + 2, s_m1); SBAR(); \
    pv_d0(o, vb0 + s_m1 * MLA_VSLOT, pa0, pa1, pa2, pa3); if (MODE & 1) { alX = 1.f; } else partialSM<1>(X0, X1, m_reg, mnX, alX, C, thr_raw); SBAR(); \
    DMA_V((j) + 1, s_p1); \
    WAIT_BAR2(6, 5); RESC(alX); ROT(); } while (0)
  for (int j = 1; j + 1 < NT; j += 2) {
    STEP(pB0, pB1, mnB, alB, pA0, pA1, alA, j);
    STEP(pA0, pA1, mnA, alA, pB0, pB1, alB, j + 1);
  }
  STEP(pB0, pB1, mnB, alB, pA0, pA1, alA, NT - 1);
  finishSM(pB0, pB1, alB, l_reg, pa0, pa1, pa2, pa3); SBAR();
  pv_d0(o, vb0 + s_m1 * MLA_VSLOT, pa0, pa1, pa2, pa3);
  __builtin_amdgcn_s_setprio(0);
  (void)mnA; (void)mnB;
#undef STEP
#undef ROT
#undef RESC
#undef DMA_K
#undef DMA_V
  if (hi == 0) li_l[r32] = l_reg;
  WAIT_BAR(0);
  float rli[16];
#pragma unroll
  for (int r = 0; r < 16; ++r) rli[r] = __builtin_amdgcn_rcpf(li_l[crow(r, hi)]);
  ATT_LAS bf16_t* stg = (ATT_LAS bf16_t*)(lds + MLA_K0) + wid * 4096;
#pragma unroll
  for (int r = 0; r < 16; ++r) { const int orow = crow(r, hi);
#pragma unroll
    for (int d0 = 0; d0 < 4; ++d0) stg[orow * 128 + d0 * 32 + r32] = f2bf(o[d0][r] * rli[r]); }
  asm volatile("s_waitcnt lgkmcnt(0)" ::: "memory");
  bf16_t* Ow = Ob + (long)(wid * 32) * ldo;
#pragma unroll
  for (int i = 0; i < 8; ++i) { const int row = i * 4 + (lane >> 4), ch = lane & 15; const u32x4 v = *(const ATT_LAS u32x4*)(stg + row * 128 + ch * 8); if (do_store) *(u32x4*)(Ow + (long)row * ldo + ch * 8) = v; }
  WAIT_BAR(0);
}

__device__ __forceinline__ void mla_unit_stag(const bf16_t* Qb, const bf16_t* Kh, const bf16_t* Vh, bf16_t* Ob, long ldo, int NT, float scale, ATT_LAS char* lds, int wave_s) {
  int tid_l = wave_s * 64 + mk_lane(); asm volatile("" : "+v"(tid_l));
  const int tid = tid_l, wid = __builtin_amdgcn_readfirstlane(tid >> 6), lane = tid & 63, r32 = lane & 31, hi = lane >> 5;
  const unsigned lds0 = (unsigned)(uintptr_t)lds;
  ATT_LAS float* wsf = (ATT_LAS float*)(lds + MLA_WS) + wid * 64; ATT_LAS float* li_l = wsf; ATT_LAS float* al_l = wsf + 32;
  const float C = scale * 1.4426950408889634f, thr_raw = 8.0f / scale;
  int ksrc[4], vsrc[2];
#pragma unroll
  for (int i = 0; i < 4; ++i) { const int gch = 64 * (wid + 8 * i) + lane, row = gch / 25, cc = gch % 25; ksrc[i] = row * 384 + (cc < 24 ? cc * 16 : 0); }
#pragma unroll
  for (int i = 0; i < 2; ++i) { const int B = 1024 * (2 * wid + i) + 16 * lane, sub = B >> 9, e = (B & 511) >> 1, kk = (sub >> 2) * 8 + (e >> 5), c = (sub & 3) * 32 + (e & 31);
    const int k = (kk & ~0xC) | ((kk & 4) << 1) | ((kk & 8) >> 1); vsrc[i] = (k * 128 + c) * 2; }
#define DMA_K(t, slot) do { const int t_ = (t) < NT ? (t) : NT - 1; const char* g_ = (const char*)Kh + (long)t_ * MLA_KTILE; \
    _Pragma("unroll") for (int i_ = 0; i_ < 4; ++i_) if (i_ < 3 || wid == 0) glds16(g_ + ksrc[i_], (unsigned)__builtin_amdgcn_readfirstlane(lds0 + MLA_K0 + (slot) * MLA_KSLOT + 1024 * (wid + 8 * i_))); } while (0)
#define DMA_V(t, slot) do { const int t_ = (t) < NT ? (t) : NT - 1; const char* g_ = (const char*)Vh + (long)t_ * MLA_VSLOT; \
    _Pragma("unroll") for (int i_ = 0; i_ < 2; ++i_) glds16(g_ + vsrc[i_], (unsigned)__builtin_amdgcn_readfirstlane(lds0 + MLA_V0 + (slot) * MLA_VSLOT + 1024 * (2 * wid + i_))); } while (0)
  DMA_K(0, 0); DMA_V(0, 0); DMA_K(1, 1); DMA_V(1, 1); DMA_K(2, 2);
  bf16x8 qr[12];
  { const bf16_t* Qw = Qb + (long)(wid * 32 + r32) * 192 + hi * 8;
#pragma unroll
    for (int d0 = 0; d0 < 12; ++d0) qr[d0] = *(const bf16x8*)(Qw + d0 * 16); }
  float m_reg = -1e30f, l_reg = 0.f; f32x16 o[4] = {};
  const int vb0 = (int)(lds0 + MLA_V0) + v_rd_base(lane);
  f32x16 pA0, pA1, pB0, pB1; float mnA, mnB, alA, alB; bf16x8 pa0, pa1, pa2, pa3;
#define RESC(a) do { if (__any((a) < 1.f)) { if (hi == 0) al_l[r32] = (a); asm volatile("s_waitcnt lgkmcnt(0)" ::: "memory"); \
    _Pragma("unroll") for (int d = 0; d < 4; ++d) _Pragma("unroll") for (int r = 0; r < 16; ++r) o[d][r] *= al_l[crow(r, hi)]; } } while (0)
  WAIT_BAR(0);
  int s_m1 = 0, s_0 = 1, s_p1 = 2;
#define ROT() do { const int t_ = s_m1; s_m1 = s_0; s_0 = s_p1; s_p1 = t_; } while (0)
#define STEPA(X0, X1, mnX, alX, Y0, Y1, alY, j) do { \
    SBAR(); qkt<192, MLA_LA>(X0, X1, lds + MLA_K0 + s_0 * MLA_KSLOT, qr, r32, hi); \
    finishSM(Y0, Y1, alY, l_reg, pa0, pa1, pa2, pa3); SBAR(); \
    DMA_K((j) + 2, s_m1); SBAR(); \
    pv_d0(o, vb0 + s_m1 * MLA_VSLOT, pa0, pa1, pa2, pa3); partialSM<1>(X0, X1, m_reg, mnX, alX, C, thr_raw); SBAR(); \
    DMA_V((j) + 1, s_p1); \
    WAIT_BAR2(6, 5); RESC(alX); ROT(); } while (0)
#define STEPB(X0, X1, Y0, Y1, j) do { float mnY_, alY_; \
    SBAR(); partialSM<1>(Y0, Y1, m_reg, mnY_, alY_, C, thr_raw); (void)mnY_; RESC(alY_); \
    finishSM(Y0, Y1, alY_, l_reg, pa0, pa1, pa2, pa3); SBAR(); \
    DMA_K((j) + 2, s_m1); SBAR(); \
    pv_d0(o, vb0 + s_m1 * MLA_VSLOT, pa0, pa1, pa2, pa3); SBAR(); \
    qkt<192, MLA_LA>(X0, X1, lds + MLA_K0 + s_0 * MLA_KSLOT, qr, r32, hi); SBAR(); \
    DMA_V((j) + 1, s_p1); \
    WAIT_BAR2(6, 5); ROT(); } while (0)
  if (wid < 4) {
    qkt<192, MLA_LA>(pA0, pA1, lds + MLA_K0, qr, r32, hi); partialSM<1>(pA0, pA1, m_reg, mnA, alA, C, thr_raw);
    WAIT_BAR(0);
    for (int j = 1; j + 1 < NT; j += 2) {
      STEPA(pB0, pB1, mnB, alB, pA0, pA1, alA, j);
      STEPA(pA0, pA1, mnA, alA, pB0, pB1, alB, j + 1);
    }
    STEPA(pB0, pB1, mnB, alB, pA0, pA1, alA, NT - 1);
    finishSM(pB0, pB1, alB, l_reg, pa0, pa1, pa2, pa3); SBAR();
    pv_d0(o, vb0 + s_m1 * MLA_VSLOT, pa0, pa1, pa2, pa3);
  } else {
    __builtin_amdgcn_s_setprio(1);
    qkt<192, MLA_LA>(pA0, pA1, lds + MLA_K0, qr, r32, hi);
    WAIT_BAR(0);
    for (int j = 1; j + 1 < NT; j += 2) {
      STEPB(pB0, pB1, pA0, pA1, j);
      STEPB(pA0, pA1, pB0, pB1, j + 1);
    }
    STEPB(pB0, pB1, pA0, pA1, NT - 1);
    partialSM<1>(pB0, pB1, m_reg, mnB, alB, C, thr_raw); RESC(alB);
    finishSM(pB0, pB1, alB, l_reg, pa0, pa1, pa2, pa3); SBAR();
    pv_d0(o, vb0 + s_m1 * MLA_VSLOT, pa0, pa1, pa2, pa3);
  }
#undef STEPA
#undef STEPB
  __builtin_amdgcn_s_setprio(0);
  (void)mnA; (void)mnB;
#undef ROT
#undef RESC
#undef DMA_K
#undef DMA_V
  if (hi == 0) li_l[r32] = l_reg;
  WAIT_BAR(0);
  float rli[16];
#pragma unroll
  for (int r = 0; r < 16; ++r) rli[r] = __builtin_amdgcn_rcpf(li_l[crow(r, hi)]);
  ATT_LAS bf16_t* stg = (ATT_LAS bf16_t*)(lds + MLA_K0) + wid * 4096;
#pragma unroll
  for (int r = 0; r < 16; ++r) { const int orow = crow(r, hi);
#pragma unroll
    for (int d0 = 0; d0 < 4; ++d0) stg[orow * 128 + d0 * 32 + r32] = f2bf(o[d0][r] * rli[r]); }
  asm volatile("s_waitcnt lgkmcnt(0)" ::: "memory");
  bf16_t* Ow = Ob + (long)(wid * 32) * ldo;
#pragma unroll
  for (int i = 0; i < 8; ++i) { const int row = i * 4 + (lane >> 4), ch = lane & 15; const u32x4 v = *(const ATT_LAS u32x4*)(stg + row * 128 + ch * 8); *(u32x4*)(Ow + (long)row * ldo + ch * 8) = v; }
  WAIT_BAR(0);
}

__device__ __forceinline__ void mla_unit_pp(const bf16_t* Qb, const bf16_t* Kh, const bf16_t* Vh, bf16_t* Ob, long ldo, int NT, float scale, ATT_LAS char* lds, int wave_s) {
  int tid_l = wave_s * 64 + mk_lane(); asm volatile("" : "+v"(tid_l));
  const int tid = tid_l, wid = __builtin_amdgcn_readfirstlane(tid >> 6), lane = tid & 63, r32 = lane & 31, hi = lane >> 5;
  const bool H1 = wid >= 4;
  const unsigned lds0 = (unsigned)(uintptr_t)lds;
  ATT_LAS float* wsf = (ATT_LAS float*)(lds + MLA_WS) + wid * 64; ATT_LAS float* li_l = wsf; ATT_LAS float* al_l = wsf + 32;
  (void)scale;
  int ksrc[4], vsrc[2];
#pragma unroll
  for (int i = 0; i < 4; ++i) { const int gch = 64 * (wid + 8 * i) + lane, row = gch / 25, cc = gch % 25; ksrc[i] = row * 384 + (cc < 24 ? cc * 16 : 0); }
#pragma unroll
  for (int i = 0; i < 2; ++i) { const int B = 1024 * (2 * wid + i) + 16 * lane, sub = B >> 9, e = (B & 511) >> 1, kk = (sub >> 2) * 8 + (e >> 5), c = (sub & 3) * 32 + (e & 31);
    const int k = (kk & ~0xC) | ((kk & 4) << 1) | ((kk & 8) >> 1); vsrc[i] = (k * 128 + c) * 2; }
#define DMA_T(t, slot) do { const int t_ = (t) < NT ? (t) : NT - 1; const char* gk_ = (const char*)Kh + (long)t_ * MLA_KTILE; const char* gv_ = (const char*)Vh + (long)t_ * MLA_VSLOT; \
    _Pragma("unroll") for (int i_ = 0; i_ < 4; ++i_) if (i_ < 3 || wid == 0) glds16(gk_ + ksrc[i_], (unsigned)__builtin_amdgcn_readfirstlane(lds0 + MLA_K0 + (slot) * MLA_KSLOT + 1024 * (wid + 8 * i_))); \
    _Pragma("unroll") for (int i_ = 0; i_ < 2; ++i_) glds16(gv_ + vsrc[i_], (unsigned)__builtin_amdgcn_readfirstlane(lds0 + MLA_V0 + (slot) * MLA_VSLOT + 1024 * (2 * wid + i_))); } while (0)
  DMA_T(0, 0); DMA_T(1, 1);
  bf16x8 qr[12];
  { const bf16_t* Qw = Qb + (long)(wid * 32 + r32) * 192 + hi * 8;
#pragma unroll
    for (int d0 = 0; d0 < 12; ++d0) qr[d0] = *(const bf16x8*)(Qw + d0 * 16); }
  float mref = 0.f, l_reg = 0.f; f32x16 o[4] = {}; f32x16 negm = {};
  const float thr2 = 8.0f * 1.4426950408889634f;
  const int vb0 = (int)(lds0 + MLA_V0) + v_rd_base(lane);
  WAIT_BAR(0);
  if (H1) WAIT_BAR2(6, 5);
  int s_0 = 0, s_2 = 2;
  for (int j = 0; j < NT; ++j) {
    if (H1) DMA_T(j + 2, s_2);
    f32x16 p0, p1; float alpha;
    SBAR(); __builtin_amdgcn_s_setprio(1);
    qkt_c<192, MLA_PP_LA>(p0, p1, lds + MLA_K0 + s_0 * MLA_KSLOT, qr, r32, hi, negm);
    __builtin_amdgcn_s_setprio(0);
    partialSM_ref(p0, p1, mref, negm, alpha, thr2, j == 0, (j & 7) == 0);
    WAIT_BAR2(6, 5);
    if (!H1) DMA_T(j + 2, s_2);
    bf16x8 pa0, pa1, pa2, pa3; finishSM(p0, p1, alpha, l_reg, pa0, pa1, pa2, pa3);
    if (__any(alpha < 1.f)) { if (hi == 0) al_l[r32] = alpha; asm volatile("s_waitcnt lgkmcnt(0)" ::: "memory");
#pragma unroll
      for (int d = 0; d < 4; ++d)
#pragma unroll
        for (int r = 0; r < 16; ++r) o[d][r] *= al_l[crow(r, hi)]; }
    SBAR(); __builtin_amdgcn_s_setprio(1);
    pv_d0_la(o, vb0 + s_0 * MLA_VSLOT, pa0, pa1, pa2, pa3);
    __builtin_amdgcn_s_setprio(0);
    WAIT_BAR2(6, 5);
    s_2 = s_0; s_0 = (s_0 == 2) ? 0 : s_0 + 1;
  }
  if (!H1) WAIT_BAR2(6, 5);
#undef DMA_T
  if (hi == 0) li_l[r32] = l_reg;
  WAIT_BAR(0);
  float rli[16];
#pragma unroll
  for (int r = 0; r < 16; ++r) rli[r] = __builtin_amdgcn_rcpf(li_l[crow(r, hi)]);
  ATT_LAS bf16_t* stg = (ATT_LAS bf16_t*)(lds + MLA_K0) + wid * 4096;
#pragma unroll
  for (int r = 0; r < 16; ++r) { const int orow = crow(r, hi);
#pragma unroll
    for (int d0 = 0; d0 < 4; ++d0) stg[orow * 128 + d0 * 32 + r32] = f2bf(o[d0][r] * rli[r]); }
  asm volatile("s_waitcnt lgkmcnt(0)" ::: "memory");
  bf16_t* Ow = Ob + (long)(wid * 32) * ldo;
#pragma unroll
  for (int i = 0; i < 8; ++i) { const int row = i * 4 + (lane >> 4), ch = lane & 15; const u32x4 v = *(const ATT_LAS u32x4*)(stg + row * 128 + ch * 8); *(u32x4*)(Ow + (long)row * ldo + ch * 8) = v; }
  WAIT_BAR(0);
}

constexpr int DIL_KB = 64 * 272, DIL_SLOT = DIL_KB + 16384, DIL_WS = 3 * DIL_SLOT, DIL_STG = DIL_WS + 8 * 256, DIL_LDS = DIL_STG + 8 * 4096;
__device__ __forceinline__ void dil_unit(const bf16_t* Qs, const bf16_t* Ks, const bf16_t* Vs, bf16_t* Os, float* lses, long ld, long ldl, int qb_first, int nqb, int L64, float scale, ATT_LAS char* lds, int wave_s, bool dry = false) {
  int tid_l = wave_s * 64 + mk_lane(); asm volatile("" : "+v"(tid_l));
  const int tid = tid_l, wid = __builtin_amdgcn_readfirstlane(tid >> 6), lane = tid & 63, r32 = lane & 31, hi = lane >> 5, pair = wid >> 1, sub = wid & 1;
  const unsigned lds0 = (unsigned)(uintptr_t)lds;
  ATT_LAS float* wsf = (ATT_LAS float*)(lds + DIL_WS) + wid * 64; ATT_LAS float* li_l = wsf; ATT_LAS float* al_l = wsf + 32;
  ATT_LAS bf16_t* stg = (ATT_LAS bf16_t*)(lds + DIL_STG) + wid * 2048;
  const float C = scale * 1.4426950408889634f, thr_raw = 8.0f / scale;
  const int kt_lo = qb_first > 0 ? qb_first - 1 : 0, qb_end = qb_first + nqb, kt_hi = qb_end + 1 < L64 ? qb_end + 1 : L64;
  const long ld2 = ld * 2, ts = 64 * ld2;
  long koff[3], voff[2];
#pragma unroll
  for (int i = 0; i < 3; ++i) { const int gch = 64 * (wid + 8 * i) + lane, row = gch / 17, cc = gch % 17; koff[i] = row * ld2 + (cc < 16 ? cc * 16 : 0); }
#pragma unroll
  for (int i = 0; i < 2; ++i) { const int B = 1024 * (2 * wid + i) + 16 * lane, sb = B >> 9, e = (B & 511) >> 1, kk = (sb >> 2) * 8 + (e >> 5), c = (sb & 3) * 32 + (e & 31);
    const int k = (kk & ~0xC) | ((kk & 4) << 1) | ((kk & 8) >> 1); voff[i] = k * ld2 + c * 2; }
#define DMA_T(t, slot) do { const int t_ = (t) < kt_hi ? (t) : kt_hi - 1; const char* gk_ = (const char*)Ks + t_ * ts; const char* gv_ = (const char*)Vs + t_ * ts; \
    _Pragma("unroll") for (int i_ = 0; i_ < 3; ++i_) if (i_ < 2 || wid == 0) glds16(gk_ + koff[i_], (unsigned)__builtin_amdgcn_readfirstlane(lds0 + (slot) * DIL_SLOT + 1024 * (wid + 8 * i_))); \
    _Pragma("unroll") for (int i_ = 0; i_ < 2; ++i_) glds16(gv_ + voff[i_], (unsigned)__builtin_amdgcn_readfirstlane(lds0 + (slot) * DIL_SLOT + DIL_KB + 1024 * (2 * wid + i_))); } while (0)
  DMA_T(kt_lo, 0); DMA_T(kt_lo + 1, 1);
  int qb = qb_first + pair; bool have = qb < qb_end;
  bf16x8 qr[8];
#define QLOAD() do { const bf16_t* Qw_ = Qs + (long)(qb * 64 + sub * 32 + r32) * ld + hi * 8; \
    _Pragma("unroll") for (int d0 = 0; d0 < 8; ++d0) qr[d0] = *(const bf16x8*)(Qw_ + d0 * 16); } while (0)
#define QPIN() do { _Pragma("unroll") for (int d0 = 0; d0 < 8; ++d0) asm volatile("" : "+v"(qr[d0])); } while (0)
  if (have) QLOAD();
  float m_reg = -1e30f, l_reg = 0.f; f32x16 o[4] = {};
  const int qi = sub * 32 + r32;
  const int vb0 = (int)lds0 + DIL_KB + v_rd_base(lane);
#define BLOCK_EPI() do { if (hi == 0) li_l[r32] = l_reg; asm volatile("s_waitcnt lgkmcnt(0)" ::: "memory"); \
    float rli[16]; _Pragma("unroll") for (int r = 0; r < 16; ++r) rli[r] = __builtin_amdgcn_rcpf(li_l[crow(r, hi)]); \
    bf16_t* Ow_ = Os + (long)(qb * 64 + sub * 32) * ld; \
    _Pragma("unroll") for (int hf = 0; hf < 2; ++hf) { \
      _Pragma("unroll") for (int r = 0; r < 16; ++r) { const int orow = crow(r, hi); \
        _Pragma("unroll") for (int dd = 0; dd < 2; ++dd) stg[orow * 64 + dd * 32 + r32] = f2bf(o[hf * 2 + dd][r] * rli[r]); } \
      asm volatile("s_waitcnt lgkmcnt(0)" ::: "memory"); \
      _Pragma("unroll") for (int i = 0; i < 4; ++i) { const int row = i * 8 + (lane >> 3), ch = lane & 7; const u32x4 v = *(const ATT_LAS u32x4*)(stg + row * 64 + ch * 8); \
        if (!dry) *(u32x4*)(Ow_ + (long)row * ld + hf * 64 + ch * 8) = v; } \
      asm volatile("s_waitcnt lgkmcnt(0)" ::: "memory"); } \
    if (hi == 0 && !dry) lses[(long)(qb * 64 + sub * 32 + r32) * ldl] = m_reg * scale + __logf(l_reg); } while (0)
  WAIT_BAR(0);
  int s_0 = 0, s_1 = 1, s_2 = 2;
  for (int t = kt_lo; t < kt_hi; ++t) {
    if (have && t >= qb - 1 && t <= qb + 1) {
      f32x16 p0, p1; qkt<128>(p0, p1, lds + s_0 * DIL_SLOT, qr, r32, hi);
      if (t == qb - 1) {
#pragma unroll
        for (int r = 0; r < 16; ++r) { const int k0 = crow(r, hi); if (k0 < qi) p0[r] = -1e30f; if (k0 + 32 < qi) p1[r] = -1e30f; }
      } else if (t == qb + 1) {
#pragma unroll
        for (int r = 0; r < 16; ++r) { const int k0 = crow(r, hi); if (k0 > qi) p0[r] = -1e30f; if (k0 + 32 > qi) p1[r] = -1e30f; }
      }
      float mn, alpha; partialSM<1>(p0, p1, m_reg, mn, alpha, C, thr_raw); (void)mn;
      bf16x8 pa0, pa1, pa2, pa3; finishSM(p0, p1, alpha, l_reg, pa0, pa1, pa2, pa3);
      if (__any(alpha < 1.f)) { if (hi == 0) al_l[r32] = alpha; asm volatile("s_waitcnt lgkmcnt(0)" ::: "memory");
#pragma unroll
        for (int d = 0; d < 4; ++d)
#pragma unroll
          for (int r = 0; r < 16; ++r) o[d][r] *= al_l[crow(r, hi)]; }
      pv_d0(o, vb0 + s_0 * DIL_SLOT, pa0, pa1, pa2, pa3);
    } else if (have && t == qb + 2) {
      BLOCK_EPI();
      qb += 4; have = qb < qb_end; m_reg = -1e30f; l_reg = 0.f;
#pragma unroll
      for (int d = 0; d < 4; ++d) o[d] = f32x16{};
      if (have) { QLOAD(); QPIN(); }
    }
    DMA_T(t + 2, s_2);
    WAIT_BAR2(5, 4);
    { const int t_ = s_0; s_0 = s_1; s_1 = s_2; s_2 = t_; }
  }
  if (have) BLOCK_EPI();
  WAIT_BAR(0);
#undef DMA_T
#undef QLOAD
#undef QPIN
#undef BLOCK_EPI
}
#undef WAIT_BAR
#undef SBAR
}

#define LAS __attribute__((address_space(3)))
typedef unsigned short bf16;
typedef float f32x4 __attribute__((ext_vector_type(4)));
typedef unsigned v4u __attribute__((ext_vector_type(4)));
typedef unsigned v2u __attribute__((ext_vector_type(2)));
typedef short bf16x8 __attribute__((ext_vector_type(8)));

constexpr int NWAVES = 8, NTHR = 512;
constexpr int BATCH = 8, SEQ = 8192, DM = 1024, M = BATCH * SEQ, FF = 4096;
#ifndef MK_NCH
#define MK_NCH 4
#endif
constexpr int NCH = MK_NCH, MH = M / NCH, BPC = BATCH / NCH;
constexpr int NQKV = 9216;
constexpr size_t MiB = 1u << 20;
constexpr size_t WS_WQKV = 1 * MiB, WS_WOA = 19 * MiB, WS_W1 = 21 * MiB, WS_W2 = 37 * MiB, WS_WIN = 53 * MiB, WS_WQB = 54 * MiB, WS_WKVB = 55 * MiB, WS_WOB = 56 * MiB;
constexpr size_t WS_COS128 = 58 * MiB, WS_SIN128 = 60 * MiB, WS_COS64 = 62 * MiB, WS_SIN64 = 63 * MiB;
constexpr size_t WS_LSE = 64 * MiB, WS_SSR = 67 * MiB;
constexpr size_t WS_RS = 68 * MiB, WS_RS2 = 70 * MiB;
constexpr size_t WS_HN = 128 * MiB;
constexpr size_t WS_QKVH = 256 * MiB;
constexpr size_t WS_ACT = 256 * MiB;
constexpr size_t WS_CQN = 256 * MiB, WS_CKVN = 288 * MiB, WS_KR = 320 * MiB;
constexpr size_t WS_Q = 384 * MiB, WS_K = 576 * MiB, WS_V = 768 * MiB;
constexpr size_t WS_AO = 896 * MiB;
constexpr size_t WS_END = 1024 * MiB;
constexpr int RING_BYTES = 131072, XCH_OFF = RING_BYTES, LDS_BYTES = 147456;

#define RLX_AGENT __ATOMIC_RELAXED, __HIP_MEMORY_SCOPE_AGENT
#define XB_TMO      128
#define XB_XCNT(j)  (256  + 64 * (j))
#define XB_XSUB(j)  (1280 + 64 * (j))
#define XB_XGEN(j)  (2304 + 64 * (j))
#define XB_TOP      3328
#define XB_TOPGEN   3392
#define XCD_BAR_WORDS 3456
#define XB_SPIN_CAP (1u << 18)

__device__ __forceinline__ unsigned xb_ld(unsigned* p)              { return __hip_atomic_load(p, __ATOMIC_RELAXED, __HIP_MEMORY_SCOPE_AGENT); }
__device__ __forceinline__ unsigned xb_add(unsigned* p, unsigned v) { return __hip_atomic_fetch_add(p, v, __ATOMIC_RELAXED, __HIP_MEMORY_SCOPE_AGENT); }
__device__ __forceinline__ unsigned xb_xcc_id() { return (unsigned)__builtin_amdgcn_s_getreg((3 << 11) | 20) & 0xFu; }
#define XB_SPIN(cond, bar) do { unsigned _sp = 0; while (cond) { __builtin_amdgcn_s_sleep(1); \
    if ((++_sp & 255u) == 0u) { if (xb_ld(&(bar)[XB_TMO])) break; if (_sp > XB_SPIN_CAP) { atomicAdd(&(bar)[XB_TMO], 1u); break; } } } } while (0)

struct XcdBarrier {
    unsigned* bar; unsigned x; int wave;
    volatile LAS unsigned* st;
};

__device__ __forceinline__ XcdBarrier xcd_barrier_post(unsigned* bar, volatile LAS unsigned* st, int wave_s) {
    XcdBarrier b; b.bar = bar; b.x = xb_xcc_id(); b.st = st; b.wave = wave_s;
    if (wave_s == 0 && mk_lane() == 0) (void)xb_add(&bar[XB_XCNT(b.x)], 1u);
    return b;
}
__device__ __forceinline__ void xcd_barrier_complete(unsigned* bar, unsigned x, unsigned& nloc, unsigned& nx) {
    const unsigned G = gridDim.x * gridDim.y * gridDim.z;
    unsigned sum, cnt, mine, sp = 0u;
    for (;;) {
        sum = 0u; cnt = 0u; mine = 0u;
#pragma unroll
        for (unsigned j = 0; j < 16; ++j) { const unsigned c = xb_ld(&bar[XB_XCNT(j)]); sum += c; cnt += (c > 0u) ? 1u : 0u; mine = (j == x) ? c : mine; }
        if (sum == G) break;
        __builtin_amdgcn_s_sleep(1);
        if ((++sp & 255u) == 0u) { if (xb_ld(&bar[XB_TMO])) break; if (sp > XB_SPIN_CAP) { atomicAdd(&bar[XB_TMO], 1u); break; } }
    }
    nloc = mine > 0u ? mine : 1u; nx = cnt > 0u ? cnt : 1u;
}

__device__ __forceinline__ void xcd_barrier(const XcdBarrier& b) {
    asm volatile("s_waitcnt vmcnt(0)" ::: "memory");
    __syncthreads();
    if (b.wave == 0 && mk_lane() == 0) {
        unsigned* bar = b.bar;
        __builtin_amdgcn_s_waitcnt(0);
        unsigned nloc = b.st[0], nx = b.st[1];
        if (nloc == 0u) { xcd_barrier_complete(bar, b.x, nloc, nx); b.st[0] = nloc; b.st[1] = nx; }
        const unsigned old = xb_add(&bar[XB_XSUB(b.x)], 1u);
        const unsigned gen = old / nloc;
        if (old + 1u == (gen + 1u) * nloc) {
            __builtin_amdgcn_fence(__ATOMIC_RELEASE, "agent");
            asm volatile("s_waitcnt vmcnt(0)" ::: "memory");
            const unsigned og = xb_add(&bar[XB_TOP], 1u);
            const unsigned tg = og / nx;
            if (og + 1u == (tg + 1u) * nx) xb_add(&bar[XB_TOPGEN], 1u);
            else XB_SPIN(xb_ld(&bar[XB_TOPGEN]) == tg, bar);
            __builtin_amdgcn_fence(__ATOMIC_ACQUIRE, "agent");
            xb_add(&bar[XB_XGEN(b.x)], 1u);
            asm volatile("s_waitcnt vmcnt(0)" ::: "memory");
        } else {
            XB_SPIN(xb_ld(&bar[XB_XGEN(b.x)]) == gen, bar);
            __builtin_amdgcn_fence(__ATOMIC_ACQUIRE, "agent");
            asm volatile("s_waitcnt vmcnt(0)" ::: "memory");
        }
    }
    __syncthreads();
}

constexpr size_t WS_BAR = 0, BAR_ZERO_BYTES = 16384;

#ifndef STAG_SLEEPS
#define STAG_SLEEPS 1
#endif
__device__ __forceinline__ void stagger(int bx) { if (STAG_SLEEPS > 0) for (int i = 0; i < bx; ++i) __builtin_amdgcn_s_sleep(STAG_SLEEPS); }
__device__ __forceinline__ unsigned char* ws_fresh(unsigned char* w) { asm volatile("" : "+s"(w)); return w; }
struct Params {
  const float* x; const float* norm_mix; const float* norm_ffn; const float* a_w_qkv; const float* a_q_gain; const float* a_k_gain; const float* a_w_o;
  const float* b_w_in; const float* b_q_a_gain; const float* b_w_qb; const float* b_kv_a_gain; const float* b_w_kvb; const float* b_q_gain; const float* b_k_gain; const float* b_w_o;
  const float* ffn_w1; const float* ffn_w2; float* out; unsigned char* ws;
};

__device__ __forceinline__ unsigned f2bf_rne(float f) { unsigned u = __builtin_bit_cast(unsigned, f); return (u + 0x7fffu + ((u >> 16) & 1u)) >> 16; }
__device__ __forceinline__ unsigned pk2(float lo, float hi) { return f2bf_rne(lo) | (f2bf_rne(hi) << 16); }
__device__ __forceinline__ float wave_sum(float v) {
#pragma unroll
  for (int o = 1; o < 64; o <<= 1) v += __shfl_xor(v, o);
  return v;
}
__device__ __forceinline__ int rope_perm128(int p) { const int wc = p >> 5, fq = (p >> 3) & 3, n = (p >> 2) & 1, j = p & 3; return 16 * wc + 4 * fq + j + 64 * n; }
__device__ __forceinline__ int rope_perm64(int p) { const int wc = p >> 5, fq = (p >> 3) & 3, n = (p >> 2) & 1, j = p & 3; return wc >= 2 ? -1 : 16 * wc + 4 * fq + j + 32 * n; }
template <int MAP> __device__ __forceinline__ int src_col(int n) {
  if (MAP == 1) { if (n >= 6144) return n; const int p = n & 255, bj = p >> 7, pp = p & 127; return (n - p) + (pp >> 6) * 128 + (pp & 63) + 64 * bj; }
  if (MAP == 2) { if (n < 384) return n; const int q = rope_perm64(n - 384); return q < 0 ? -1 : 384 + q; }
  if (MAP == 3) { const int h = n >> 8, p = n & 255; if (p < 128) return h * 192 + p; const int q = rope_perm64(p - 128); return q < 0 ? -1 : h * 192 + 128 + q; }
  if (MAP == 4) { const int p = n & 255, bj = p >> 7, wc = (p >> 5) & 3, i = p & 31; return (n - p) + wc * 64 + bj * 32 + i; }
  return n;
}
template <int MAP> __device__ __forceinline__ void wt_convert(const float* W, int Klog, int Nlog, int Kphys, int Nphys, bf16* WT, int gw, int NGW, int lane, const float* gain = nullptr) {
  const int nkb = Kphys / 8, nnb = Nphys / 64;
#pragma unroll 4
  for (int it = gw; it < nkb * nnb; it += NGW) {
    const int nb = it % nnb, kb = it / nnb, n = nb * 64 + lane, src = src_col<MAP>(n), k0 = kb * 8;
    float v[8];
#pragma unroll
    for (int i = 0; i < 8; ++i) v[i] = (src >= 0 && k0 + i < Klog) ? W[(size_t)(k0 + i) * Nlog + src] : 0.f;
    if (gain != nullptr) {
#pragma unroll
      for (int i = 0; i < 8; ++i) v[i] *= gain[k0 + i]; }
    v4u o; o.x = pk2(v[0], v[1]); o.y = pk2(v[2], v[3]); o.z = pk2(v[4], v[5]); o.w = pk2(v[6], v[7]);
    *(v4u*)(WT + (size_t)n * Kphys + k0) = o;
  }
}
__device__ __forceinline__ void rope_table(float* cosT, float* sinT, int half_d, int gtid, int NGT, bool as_half = false) {
  for (int id = gtid; id < SEQ * half_d; id += NGT) {
    const int pos = id / half_d, i = id % half_d;
    const float freq = powf(10000.0f, -(float)i / (float)half_d);
    const float angf = (float)pos * freq;
    const double a = (double)angf, k = rint(a * 0.15915494309189535), red = a - k * 6.283185307179586;
    const float r = (float)red;
    if (as_half) { ((_Float16*)cosT)[id] = (_Float16)cosf(r); ((_Float16*)sinT)[id] = (_Float16)sinf(r); } else { cosT[id] = cosf(r); sinT[id] = sinf(r); }
  }
}
__device__ __forceinline__ void xb_rows(const float* src, bf16* dst, float* rs, int gw, int NGW, int lane) {
#pragma unroll 4
  for (int row = gw; row < M; row += NGW) {
    const f32x4* xr = (const f32x4*)(src + (size_t)row * DM) + lane;
    f32x4 v[4]; float s = 0.f;
#pragma unroll
    for (int j = 0; j < 4; ++j) { v[j] = xr[64 * j]; s += (v[j][0] * v[j][0] + v[j][1] * v[j][1]) + (v[j][2] * v[j][2] + v[j][3] * v[j][3]); }
    s = wave_sum(s);
    v2u* o8 = (v2u*)(dst + (size_t)row * DM) + lane;
#pragma unroll
    for (int j = 0; j < 4; ++j) { v2u w; w.x = pk2(v[j][0], v[j][1]); w.y = pk2(v[j][2], v[j][3]); o8[64 * j] = w; }
    if (lane < 4) rs[(size_t)row * 4 + lane] = lane == 0 ? s : 0.f;
  }
}
__device__ __forceinline__ void merge_half(const bf16* qkvh, const float* lse, bf16* ao_half, int gtid, int NGT) {
  for (int id = gtid; id < MH * 128; id += NGT) {
    const int tok = id >> 7, c8 = id & 127, h = c8 >> 4;
    const float l0 = lse[((size_t)0 * MH + tok) * 8 + h], l1 = lse[((size_t)1 * MH + tok) * 8 + h], l2 = lse[((size_t)2 * MH + tok) * 8 + h];
    const float mx = fmaxf(l0, fmaxf(l1, l2));
    float w0 = __expf(l0 - mx), w1 = __expf(l1 - mx), w2 = __expf(l2 - mx);
    const float inv = 1.0f / (w0 + w1 + w2); w0 *= inv; w1 *= inv; w2 *= inv;
    const bf16* p = qkvh + (size_t)tok * NQKV + c8 * 8;
    const v4u a = *(const v4u*)p, b = *(const v4u*)(p + 1024), c = *(const v4u*)(p + 2048);
    v4u o;
#pragma unroll
    for (int e = 0; e < 4; ++e) {
      const float alo = __uint_as_float(a[e] << 16), ahi = __uint_as_float(a[e] & 0xffff0000u);
      const float blo = __uint_as_float(b[e] << 16), bhi = __uint_as_float(b[e] & 0xffff0000u);
      const float clo = __uint_as_float(c[e] << 16), chi = __uint_as_float(c[e] & 0xffff0000u);
      o[e] = pk2(w0 * alo + w1 * blo + w2 * clo, w0 * ahi + w1 * bhi + w2 * chi);
    }
    *(v4u*)(ao_half + (size_t)tok * DM + c8 * 8) = o;
  }
}

__global__ void __launch_bounds__(NTHR) fwd_megakernel(Params p) {
  extern __shared__ __attribute__((aligned(16))) unsigned char lds_raw[];
  cg::grid_group grid = cg::this_grid();
  LAS unsigned char* lds = (LAS unsigned char*)lds_raw;
  LAS float* XP = (LAS float*)(lds + XCH_OFF);
  const int G = gridDim.x, bx = blockIdx.x, NGW = G * NWAVES, NGT = G * NTHR;
  volatile LAS unsigned* bst = (volatile LAS unsigned*)(lds + XCH_OFF + 8192);
  const int wave_s = __builtin_amdgcn_readfirstlane((int)threadIdx.x >> 6);
  if (wave_s == 0 && mk_lane() < 4) bst[mk_lane()] = 0u;
  __syncthreads();
  XcdBarrier xbar = xcd_barrier_post((unsigned*)(p.ws + WS_BAR), bst, wave_s);
#define GRID_BAR() xcd_barrier(xbar)
#define FRESH_IDS() int tid_f = wave_s * 64 + mk_lane(); asm volatile("" : "+v"(tid_f)); const int lane = tid_f & 63, gw = bx * NWAVES + wave_s, gtid = bx * NTHR + tid_f; (void)lane; (void)gw; (void)gtid
  unsigned char* ws = p.ws;
  bf16* WQKV = (bf16*)(ws + WS_WQKV); bf16* WOA = (bf16*)(ws + WS_WOA); bf16* W1 = (bf16*)(ws + WS_W1); bf16* W2 = (bf16*)(ws + WS_W2);
  bf16* WIN = (bf16*)(ws + WS_WIN); bf16* WQB = (bf16*)(ws + WS_WQB); bf16* WKVB = (bf16*)(ws + WS_WKVB); bf16* WOB = (bf16*)(ws + WS_WOB);
  float* COS128 = (float*)(ws + WS_COS128); float* SIN128 = (float*)(ws + WS_SIN128); float* COS64 = (float*)(ws + WS_COS64); float* SIN64 = (float*)(ws + WS_SIN64);
  float* LSE = (float*)(ws + WS_LSE); float* SSR = (float*)(ws + WS_SSR);
  bf16* HN = (bf16*)(ws + WS_HN); float* RS = (float*)(ws + WS_RS); float* RS2 = (float*)(ws + WS_RS2); bf16* QKVH = (bf16*)(ws + WS_QKVH); bf16* ACT = (bf16*)(ws + WS_ACT);
  bf16* CQN = (bf16*)(ws + WS_CQN); bf16* CKVN = (bf16*)(ws + WS_CKVN); float* KR = (float*)(ws + WS_KR);
  bf16* QB = (bf16*)(ws + WS_Q); bf16* KB = (bf16*)(ws + WS_K); bf16* VB = (bf16*)(ws + WS_V); bf16* AO = (bf16*)(ws + WS_AO);

#ifndef SEL
#define SEL 0xffff
#endif
#ifndef PROBE_EW_REPS
#define PROBE_EW_REPS 1
#endif
#ifndef PROBE_GEMM_REPS
#define PROBE_GEMM_REPS 1
#endif
#if SEL & 1
  for (int rep_ = 0; rep_ < PROBE_EW_REPS; ++rep_)
  { FRESH_IDS();
  wt_convert<1>(p.a_w_qkv, DM, NQKV, DM, NQKV, WQKV, gw, NGW, lane, p.norm_mix);
  wt_convert<0>(p.a_w_o, DM, DM, DM, DM, WOA, gw, NGW, lane);
  wt_convert<0>(p.ffn_w1, DM, FF, DM, FF, W1, gw, NGW, lane, p.norm_ffn);
  wt_convert<0>(p.ffn_w1 + (size_t)DM * FF, DM, FF, DM, FF, W1 + (size_t)DM * FF, gw, NGW, lane, p.norm_ffn + DM);
  wt_convert<0>(p.ffn_w2, FF, DM, FF, DM, W2, gw, NGW, lane);
  wt_convert<0>(p.ffn_w2 + (size_t)DM * FF, FF, DM, FF, DM, W2 + (size_t)DM * FF, gw, NGW, lane);
  wt_convert<2>(p.b_w_in, DM, 448, DM, 512, WIN, gw, NGW, lane, p.norm_mix + DM);
  wt_convert<3>(p.b_w_qb, 256, 1536, 256, 2048, WQB, gw, NGW, lane);
  wt_convert<0>(p.b_w_kvb, 128, 2048, 128, 2048, WKVB, gw, NGW, lane);
  wt_convert<0>(p.b_w_o, DM, DM, DM, DM, WOB, gw, NGW, lane);
  rope_table(COS128, SIN128, 64, gtid, NGT, true);
  rope_table(COS64, SIN64, 32, gtid, NGT);
  xb_rows(p.x, HN, RS, gw, NGW, lane); }
#endif
  grid.sync();

#ifdef PROBE_EXTRA_SYNCS
  for (int i_ = 0; i_ < PROBE_EXTRA_SYNCS; ++i_) grid.sync();
#endif
  for (int layer = 0; layer < 2; ++layer) {
    if (layer == 0) {
      for (int half = 0; half < NCH; ++half) {
        for (int rep_ = 0; rep_ < PROBE_GEMM_REPS; ++rep_)
        { pg8::Gemm g{HN + (size_t)half * MH * DM, WQKV, MH, NQKV, DM}; pg8::StaticOrder S; S.init(MH, NQKV, G, bx);
          pg8::EpiQKVA E{QKVH, p.a_q_gain, p.a_k_gain, COS128, SIN128, XP, RS, half * MH};
          pg8::gemm_phase<pg8::EpiQKVA, pg8::StaticOrder, true, true>(lds, g, S, E, wave_s); }
        GRID_BAR();
        int uid0 = bx; asm volatile("" : "+s"(uid0));
        for (int uid = uid0; uid < BPC * 256; uid += G) {
          int g, r, nqb, L64, rem;
          if (uid < BPC * 64) { g = 0; r = 1; nqb = 16; L64 = 128; rem = uid; } else if (uid < BPC * 128) { g = 1; r = 4; nqb = 16; L64 = 32; rem = uid - BPC * 64; } else { g = 2; r = 16; nqb = 8; L64 = 8; rem = uid - BPC * 128; }
          const int per = (g == 2) ? 16 : 8, sub_i = rem % per, bhh = rem / per, h = bhh & 7, bl = bhh >> 3;
          const int nch = L64 / nqb, c = sub_i / nch, ch = sub_i % nch;
          const long ld = (long)r * NQKV;
          const bf16* qp = QKVH + ((size_t)bl * SEQ + c) * NQKV + g * 1024 + h * 128;
          att::dil_unit(qp, qp + 3072, qp + 6144, (bf16*)qp, LSE + ((size_t)g * MH + (size_t)bl * SEQ + c) * 8 + h, ld, (long)r * 8, ch * nqb, nqb, L64, 0.08838834764831845f, (LAS char*)lds, wave_s);
        }
        GRID_BAR();
        for (int rep_ = 0; rep_ < PROBE_EW_REPS; ++rep_) { FRESH_IDS(); merge_half(QKVH, LSE, AO + (size_t)half * MH * DM, gtid, NGT); }
        GRID_BAR();
      }
    } else {
#if SEL & 16
      for (int rep_ = 0; rep_ < PROBE_GEMM_REPS; ++rep_)
      { pg8::Gemm g{HN, WIN, M, 512, DM}; pg8::StaticOrder S; S.init(M, 512, G, bx);
        pg8::EpiLat E{CQN, CKVN, KR, SSR, p.b_q_a_gain, p.b_kv_a_gain, p.b_k_gain, COS64, SIN64, XP, RS};
        pg8::gemm_phase<pg8::EpiLat, pg8::StaticOrder, true, true>(lds, g, S, E, wave_s); }
#endif
      GRID_BAR();
#if SEL & 32
      for (int rep_ = 0; rep_ < PROBE_GEMM_REPS; ++rep_) {
      { pg8::Gemm g{CQN, WQB, M, 2048, 256}; pg8::StaticOrder S; S.init(M, 2048, G, bx);
        pg8::EpiQB E{QB, p.b_q_gain, COS64, SIN64, XP};
        pg8::gemm_phase<pg8::EpiQB, pg8::StaticOrder, true, true>(lds, g, S, E, wave_s); }
#if SEL & 64
      { pg8::Gemm g{CKVN, WKVB, M, 2048, 128  }; pg8::StaticOrder S; S.init(M, 2048, G, bx);
        pg8::EpiKVB E{KB, VB, p.b_k_gain, KR, SSR, XP};
        pg8::gemm_phase<pg8::EpiKVB, pg8::StaticOrder, true, true>(lds, g, S, E, wave_s); }
      }
#endif
#endif
      GRID_BAR();
#if SEL & 128
#ifndef PROBE_MLA_REPS
#define PROBE_MLA_REPS 1
#endif
#ifdef PROBE_CLOCK
      const unsigned long long pc0_ = __builtin_amdgcn_s_memtime(), pr0_ = __builtin_amdgcn_s_memrealtime();
#endif
      for (int rep_ = 0; rep_ < PROBE_MLA_REPS; ++rep_)
      { const int xcd = bx & 7, loc = bx >> 3;
        for (int i = 0; ; ++i) {
          int bh, qb;
          if (G == 256) { if (i >= 8) break; bh = i * 8 + xcd; qb = loc; }
          else { const int uid = i * G + bx; if (uid >= 64 * 32) break; bh = uid >> 5; qb = uid & 31; }
          const int b = bh >> 3, h = bh & 7;
#ifndef PROBE_MLA_MODE
#define PROBE_MLA_MODE 0
#endif
          if (PROBE_MLA_REPS > 1 && rep_ == 0)
          att::mla_unit<PROBE_MLA_MODE>(QB + ((size_t)bh * SEQ + 256 * qb) * 192, KB + (size_t)bh * SEQ * 192, VB + (size_t)bh * SEQ * 128,
                        AO + ((size_t)b * SEQ + 256 * qb) * DM + h * 128, DM, SEQ / 64, 0.07216878364870322f, (LAS char*)lds, wave_s, p.ws == nullptr);
          else
          att::mla_unit_pp(QB + ((size_t)bh * SEQ + 256 * qb) * 192, KB + (size_t)bh * SEQ * 192, VB + (size_t)bh * SEQ * 128,
                        AO + ((size_t)b * SEQ + 256 * qb) * DM + h * 128, DM, SEQ / 64, 0.07216878364870322f, (LAS char*)lds, wave_s);
        } }
#endif
#ifdef PROBE_CLOCK
      { const unsigned long long pc1_ = __builtin_amdgcn_s_memtime(), pr1_ = __builtin_amdgcn_s_memrealtime();
        if (bx == PROBE_CLOCK && wave_s == 0 && mk_lane() == 0) { const float mhz_ = (float)(pc1_ - pc0_) * 100.0f / (float)(pr1_ - pr0_); ((float*)(p.ws + WS_BAR + 14336))[0] = (mhz_ > 1450.f ? 1000.f : 0.f) + (mhz_ > 1750.f ? 1000.f : 0.f) + (mhz_ > 2050.f ? 1000.f : 0.f) + (mhz_ > 2300.f ? 1000.f : 0.f); } }
#endif
      GRID_BAR();
    }
    { pg8::Gemm g{AO, layer == 0 ? WOA : WOB, M, DM, DM}; pg8::StaticOrder S; S.init(M, DM, G, bx);
      pg8::EpiResB E{HN, HN, RS2, XP, nullptr};
      pg8::gemm_phase<pg8::EpiResB, pg8::StaticOrder, true, true>(lds, g, S, E, wave_s); }
    GRID_BAR();
#ifndef PROBE_FFN1_REPS
#define PROBE_FFN1_REPS 1
#endif
#ifndef PROBE_FFN1_DRY
#define PROBE_FFN1_DRY 1
#endif
#ifdef STAG_FFN1
    for (int i_ = 0; i_ < bx; ++i_) __builtin_amdgcn_s_sleep(STAG_FFN1);
#endif
    for (int rep_ = 0; rep_ < PROBE_FFN1_REPS; ++rep_)
    { pg8::Gemm g{HN, W1 + (size_t)layer * DM * FF, M, FF, DM}; pg8::StaticOrder S; S.init(M, FF, G, bx);
      pg8::EpiRelu2 E{ACT, FF, (PROBE_FFN1_REPS > 1 && rep_ == 0) ? PROBE_FFN1_DRY : 0};
      pg8::gemm_phase<pg8::EpiRelu2, pg8::StaticOrder, true, true>(lds, g, S, E, wave_s); }
    GRID_BAR();
    if (layer == 0) {
      { pg8::Gemm g{ACT, W2, M, DM, FF}; pg8::StaticOrder S; S.init(M, DM, G, bx);
        pg8::EpiResB E{HN, HN, RS, XP, RS2};
        pg8::gemm_phase<pg8::EpiResB, pg8::StaticOrder, true, true>(lds, g, S, E, wave_s); }
      GRID_BAR();
    } else {
      pg8::Gemm g{ACT, W2 + (size_t)DM * FF, M, DM, FF}; pg8::StaticOrder S; S.init(M, DM, G, bx);
      pg8::EpiResF E{HN, p.out, RS2};
      pg8::gemm_phase<pg8::EpiResF, pg8::StaticOrder, true, true>(lds, g, S, E, wave_s);
    }
  }
#ifdef PROBE_CLOCK
  GRID_BAR();
  if (bx == 0 && wave_s == 0 && mk_lane() == 0) p.out[0] += ((float*)(p.ws + WS_BAR + 14336))[0];
#endif
}

extern "C" void kernel_launch(void* const* d_in, const int* in_sizes, int n_in, void* d_out, int out_size, void* d_ws, size_t ws_size, hipStream_t stream) {
  static int grid_blocks = 0;
  if (grid_blocks == 0) {
    if (n_in != 17 || in_sizes[0] != M * DM || out_size != M * DM || ws_size < WS_END) {
      fprintf(stderr, "kernel_launch: unexpected shapes: n_in %d in0 %d out %d ws %zu (need >= %zu)\n", n_in, n_in > 0 ? in_sizes[0] : -1, out_size, ws_size, (size_t)WS_END); grid_blocks = -1; return; }
    int dev = 0, cus = 0, per_cu = 0;
    hipGetDevice(&dev); hipDeviceGetAttribute(&cus, hipDeviceAttributeMultiprocessorCount, dev);
    if (hipFuncSetAttribute((const void*)fwd_megakernel, hipFuncAttributeMaxDynamicSharedMemorySize, LDS_BYTES) != hipSuccess) { fprintf(stderr, "kernel_launch: hipFuncSetAttribute failed\n"); grid_blocks = -1; return; }
    if (hipOccupancyMaxActiveBlocksPerMultiprocessor(&per_cu, (const void*)fwd_megakernel, NTHR, LDS_BYTES) != hipSuccess || per_cu < 1) { fprintf(stderr, "kernel_launch: occupancy query gives %d\n", per_cu); per_cu = 1; }
    (void)hipGetLastError();
    grid_blocks = cus * per_cu;
  }
  if (grid_blocks < 0) return;
  Params p{};
  p.x = (const float*)d_in[0]; p.norm_mix = (const float*)d_in[1]; p.norm_ffn = (const float*)d_in[2]; p.a_w_qkv = (const float*)d_in[3]; p.a_q_gain = (const float*)d_in[4];
  p.a_k_gain = (const float*)d_in[5]; p.a_w_o = (const float*)d_in[6]; p.b_w_in = (const float*)d_in[7]; p.b_q_a_gain = (const float*)d_in[8]; p.b_w_qb = (const float*)d_in[9];
  p.b_kv_a_gain = (const float*)d_in[10]; p.b_w_kvb = (const float*)d_in[11]; p.b_q_gain = (const float*)d_in[12]; p.b_k_gain = (const float*)d_in[13]; p.b_w_o = (const float*)d_in[14];
  p.ffn_w1 = (const float*)d_in[15]; p.ffn_w2 = (const float*)d_in[16]; p.out = (float*)d_out; p.ws = (unsigned char*)d_ws;
  if (hipMemsetAsync((char*)d_ws + WS_BAR, 0, BAR_ZERO_BYTES, stream) != hipSuccess) { fprintf(stderr, "kernel_launch: memset failed\n"); return; }
  void* args[] = {&p};
  hipError_t e = hipLaunchCooperativeKernel((const void*)fwd_megakernel, dim3(grid_blocks), dim3(NTHR), args, LDS_BYTES, stream);
  if (e != hipSuccess) fprintf(stderr, "kernel_launch: cooperative launch failed: %s (grid %d)\n", hipGetErrorString(e), grid_blocks);
}
```

```cpp
#include <hip/hip_runtime.h>
#include <hip/hip_cooperative_groups.h>
#include <cstdio>
#include <cstdint>
namespace cg = cooperative_groups;
__device__ __forceinline__ int mk_lane() { int l; asm volatile("v_mbcnt_lo_u32_b32 %0, -1, 0\n\tv_mbcnt_hi_u32_b32 %0, -1, %0" : "=v"(l)); return l; }
namespace pg8 {
#define PG8_LAS __attribute__((address_space(3)))
typedef unsigned short bf16_t;
typedef short bf16x8 __attribute__((ext_vector_type(8)));
typedef float f32x4 __attribute__((ext_vector_type(4)));
typedef unsigned u32x4 __attribute__((ext_vector_type(4)));
constexpr int BM = 256, BK = 64, HALF = 128, HTB = HALF * BK * 2  , STAGE_BYTES = 8 * HTB, NXCD = 8, WGM = 8;

__host__ __device__ __forceinline__ int lds_byte(int r, int c) { const int st = (r >> 4) * 2 + (c >> 5), rr = r & 15, cc = c & 31, ob = rr * 64 + cc * 2; return st * 1024 + (ob ^ (((ob >> 9) & 1) << 5)); }
__host__ __device__ __forceinline__ void stage_rc(int b, int& R, int& C) { const int st = b / 1024, sb = b % 1024, swz = sb ^ (((sb >> 9) & 1) << 5); R = (st >> 1) * 16 + swz / 64; C = (st & 1) * 32 + (swz % 64) / 2; }
__host__ __device__ __forceinline__ int perm32(int rho) { const int n = rho >> 4, i = rho & 15; return 8 * (i >> 2) + 4 * n + (i & 3); }

struct Unit { int pm, pn; };
struct Gemm { const bf16_t* A; const bf16_t* Bt; int M, N, K; };

struct StaticOrder {
    int nM, nN, nwg, G, c;
    __host__ __device__ void init(int M, int N, int G_, int c_) { nM = M / BM; nN = N / BM; nwg = nM * nN; G = G_; c = c_; }
    __host__ __device__ bool next(int i, Unit& u) const {
        const long L = (long)i * G + c; if (L >= nwg) return false;
        int wgid = (int)L; { const int q = nwg / NXCD, r = nwg % NXCD, xcd = wgid % NXCD, off = wgid / NXCD; wgid = (xcd < r ? xcd * (q + 1) : r * (q + 1) + (xcd - r) * q) + off; }
        const int nig = WGM * nN, gid = wgid / nig, fm = gid * WGM, gsz = (nM - fm) < WGM ? (nM - fm) : WGM;
        u.pm = fm + ((wgid % nig) % gsz); u.pn = (wgid % nig) / gsz; return true;
    }
    __device__ __forceinline__ void a_ready(const Unit&) const {}
    __device__ __forceinline__ void done(const Unit&) const {}
};

__device__ __forceinline__ unsigned cvt_pk_bf16(float lo, float hi) { unsigned r; asm volatile("v_cvt_pk_bf16_f32 %0, %1, %2" : "=v"(r) : "v"(lo), "v"(hi)); return r; }
typedef float f32x2 __attribute__((ext_vector_type(2)));
typedef unsigned u32x2 __attribute__((ext_vector_type(2)));
constexpr float RMS_EPS = 1e-6f;
__device__ __forceinline__ u32x4 pack8(const f32x4& a, const f32x4& b) { u32x4 w; w.x = cvt_pk_bf16(a[0], a[1]); w.y = cvt_pk_bf16(a[2], a[3]); w.z = cvt_pk_bf16(b[0], b[1]); w.w = cvt_pk_bf16(b[2], b[3]); return w; }
__device__ __forceinline__ u32x2 pack4(const f32x4& a) { u32x2 w; w.x = cvt_pk_bf16(a[0], a[1]); w.y = cvt_pk_bf16(a[2], a[3]); return w; }
__device__ __forceinline__ float hsum4(const f32x4& t) { return (t[0] + t[1]) + (t[2] + t[3]); }


__device__ __forceinline__ float row_rstd(const float* rs, int row) { const f32x4 t = *(const f32x4*)(rs + (size_t)row * 4); return rsqrtf(hsum4(t) * (1.0f / 1024.0f) + RMS_EPS); }
__device__ __forceinline__ f32x4 bf2f_lo(const u32x2 u) { f32x4 r; r[0] = __uint_as_float(u.x << 16); r[1] = __uint_as_float(u.x & 0xffff0000u); r[2] = __uint_as_float(u.y << 16); r[3] = __uint_as_float(u.y & 0xffff0000u); return r; }
__device__ __forceinline__ void ss_exchange(const f32x4 (&acc)[2][2][4][2], int wr, int wc, int fr, int fq, PG8_LAS float* P) {
#pragma unroll
    for (int ai = 0; ai < 2; ++ai)
#pragma unroll
        for (int m = 0; m < 4; ++m)
#pragma unroll
            for (int bj = 0; bj < 2; ++bj) {
                const f32x4 a = acc[ai][bj][m][0], b = acc[ai][bj][m][1];
                float s = ((a[0] * a[0] + a[1] * a[1]) + (a[2] * a[2] + a[3] * a[3])) + ((b[0] * b[0] + b[1] * b[1]) + (b[2] * b[2] + b[3] * b[3]));
                s += __shfl_xor(s, 16); s += __shfl_xor(s, 32);
                if (fq == 0) P[((ai * HALF + wr * 64 + m * 16 + fr) * 2 + bj) * 4 + wc] = s;
            }
    asm volatile("s_waitcnt lgkmcnt(0)" ::: "memory"); __builtin_amdgcn_s_barrier(); asm volatile("" ::: "memory");
}

struct EpiResB {
    static constexpr bool PERM = true, AFTER_DRAIN = false;
    const bf16_t* base; bf16_t* out; float* rs; PG8_LAS float* P; const float* rs_in;
    __device__ __forceinline__ void operator()(const f32x4 (&acc)[2][2][4][2], const Unit& u, int wr, int wc, int fr, int fq) const {
        asm volatile("" : "+v"(fr), "+v"(fq));
        const int row0 = u.pm * BM + wr * 64 + fr, col0 = u.pn * BM + wc * 32 + 8 * fq;
        float r2[2][4];
#pragma unroll
        for (int ai = 0; ai < 2; ++ai)
#pragma unroll
            for (int m = 0; m < 4; ++m) { r2[ai][m] = 1.f; if (rs_in != nullptr) { const float r_ = row_rstd(rs_in, row0 + ai * HALF + m * 16); r2[ai][m] = r_ * r_; } }
#pragma unroll
        for (int ai = 0; ai < 2; ++ai) {
            u32x4 pre[4][2];
#pragma unroll
            for (int m = 0; m < 4; ++m)
#pragma unroll
                for (int bj = 0; bj < 2; ++bj) pre[m][bj] = *(const u32x4*)(base + (size_t)(row0 + ai * HALF + m * 16) * 1024 + col0 + bj * HALF);
#pragma unroll
            for (int m = 0; m < 4; ++m) { float ss = 0.f;
#pragma unroll
                for (int bj = 0; bj < 2; ++bj) { const u32x4 b = pre[m][bj];
                    const f32x4 x0 = bf2f_lo((u32x2){b.x, b.y}) + acc[ai][bj][m][0] * r2[ai][m], x1 = bf2f_lo((u32x2){b.z, b.w}) + acc[ai][bj][m][1] * r2[ai][m];
                    ss += ((x0[0] * x0[0] + x0[1] * x0[1]) + (x0[2] * x0[2] + x0[3] * x0[3])) + ((x1[0] * x1[0] + x1[1] * x1[1]) + (x1[2] * x1[2] + x1[3] * x1[3]));
                    *(u32x4*)(out + (size_t)(row0 + ai * HALF + m * 16) * 1024 + col0 + bj * HALF) = pack8(x0, x1); }
                ss += __shfl_xor(ss, 16); ss += __shfl_xor(ss, 32);
                if (fq == 0) P[(ai * HALF + wr * 64 + m * 16 + fr) * 4 + wc] = ss; }
            asm volatile("" ::: "memory"); }
        asm volatile("s_waitcnt lgkmcnt(0)" ::: "memory"); __builtin_amdgcn_s_barrier(); asm volatile("" ::: "memory");
        if (wr == 0) { const int rl = wc * 64 + fq * 16 + fr; const f32x4 t = *(const PG8_LAS f32x4*)(P + rl * 4); rs[(size_t)(u.pm * BM + rl) * 4 + u.pn] = hsum4(t); }
    }
};
struct EpiResF {
    static constexpr bool PERM = false, AFTER_DRAIN = false;
    const bf16_t* base; float* out; const float* rs_in;
    __device__ __forceinline__ void operator()(const f32x4 (&acc)[2][2][4][2], const Unit& u, int wr, int wc, int fr, int fq) const {
        asm volatile("" : "+v"(fr), "+v"(fq));
        const int col0 = u.pn * BM + wc * 32 + 4 * fq;
#pragma unroll
        for (int ai = 0; ai < 2; ++ai) {
            u32x2 pre[4][2][2]; float r2[4];
#pragma unroll
            for (int m = 0; m < 4; ++m) { const float r_ = row_rstd(rs_in, u.pm * BM + ai * HALF + wr * 64 + m * 16 + fr); r2[m] = r_ * r_; }
#pragma unroll
            for (int m = 0; m < 4; ++m) { const size_t off = (size_t)(u.pm * BM + ai * HALF + wr * 64 + m * 16 + fr) * 1024 + col0;
#pragma unroll
                for (int bj = 0; bj < 2; ++bj)
#pragma unroll
                    for (int n = 0; n < 2; ++n) pre[m][bj][n] = *(const u32x2*)(base + off + bj * HALF + n * 16); }
#pragma unroll
            for (int m = 0; m < 4; ++m) { const size_t off = (size_t)(u.pm * BM + ai * HALF + wr * 64 + m * 16 + fr) * 1024 + col0;
#pragma unroll
                for (int bj = 0; bj < 2; ++bj)
#pragma unroll
                    for (int n = 0; n < 2; ++n) *(f32x4*)(out + off + bj * HALF + n * 16) = bf2f_lo(pre[m][bj][n]) + acc[ai][bj][m][n] * r2[m]; }
            asm volatile("" ::: "memory"); }
    }
};
struct EpiRelu2 {
    static constexpr bool PERM = true, AFTER_DRAIN = false;
    bf16_t* O; int ldc; int dry;
    __device__ __forceinline__ void operator()(const f32x4 (&acc)[2][2][4][2], const Unit& u, int wr, int wc, int fr, int fq) const {
        asm volatile("" : "+v"(fr), "+v"(fq));
        if (dry == 2) { if (O == nullptr) *(f32x4*)O = acc[0][0][0][0] + acc[1][1][3][1]; return; }
        const int row0 = u.pm * BM + wr * 64 + fr, col0 = u.pn * BM + wc * 32 + 8 * fq;
#pragma unroll
        for (int ai = 0; ai < 2; ++ai)
#pragma unroll
            for (int m = 0; m < 4; ++m) { bf16_t* rowp = O + (size_t)(row0 + ai * HALF + m * 16) * ldc + col0;
#pragma unroll
                for (int bj = 0; bj < 2; ++bj) { f32x4 v0 = acc[ai][bj][m][0], v1 = acc[ai][bj][m][1];
                    v0 = __builtin_elementwise_max(v0, (f32x4){0.f, 0.f, 0.f, 0.f}); v1 = __builtin_elementwise_max(v1, (f32x4){0.f, 0.f, 0.f, 0.f});
                    v0 = v0 * v0; v1 = v1 * v1; const u32x4 w8_ = pack8(v0, v1); if (!dry) __builtin_nontemporal_store(w8_, (u32x4*)(rowp + bj * HALF)); } }
    }
};
struct EpiQKVA {
    static constexpr bool PERM = true, AFTER_DRAIN = false;
    bf16_t* O; const float* qg; const float* kg; const float* cosT; const float* sinT; PG8_LAS float* P; const float* rs; int rs_row0;
    __device__ __forceinline__ void operator()(const f32x4 (&acc)[2][2][4][2], const Unit& u, int wr, int wc, int fr, int fq) const {
        asm volatile("" : "+v"(fr), "+v"(fq));
        const int c0 = u.pn * BM, which = c0 / 3072;
        float rr[2][4];
#pragma unroll
        for (int ai = 0; ai < 2; ++ai)
#pragma unroll
            for (int m = 0; m < 4; ++m) rr[ai][m] = row_rstd(rs, rs_row0 + u.pm * BM + ai * HALF + wr * 64 + m * 16 + fr);
        if (which == 2) {
            const int row0 = u.pm * BM + wr * 64 + fr, col0 = c0 + wc * 32 + 8 * fq;
#pragma unroll
            for (int ai = 0; ai < 2; ++ai)
#pragma unroll
                for (int m = 0; m < 4; ++m) { bf16_t* rowp = O + (size_t)(row0 + ai * HALF + m * 16) * 9216 + col0;
#pragma unroll
                    for (int bj = 0; bj < 2; ++bj) *(u32x4*)(rowp + bj * HALF) = pack8(acc[ai][bj][m][0] * rr[ai][m], acc[ai][bj][m][1] * rr[ai][m]); }
            return;
        }
        const int g = (c0 % 3072) / 1024; const float* gain = (which == 0 ? qg : kg) + g * 128;
        const int hh = wc >> 1, dm = 32 * (wc & 1) + 8 * fq;
        const f32x4 g0a = *(const f32x4*)(gain + dm), g0b = *(const f32x4*)(gain + dm + 4), g1a = *(const f32x4*)(gain + 64 + dm), g1b = *(const f32x4*)(gain + 64 + dm + 4);
        typedef _Float16 h8 __attribute__((ext_vector_type(8)));
        h8 cs[4], sn[4];
#define QK_TAB(ai) do { _Pragma("unroll") for (int m = 0; m < 4; ++m) { const int pos = (u.pm * BM + (ai) * HALF + wr * 64 + m * 16 + fr) & 8191; \
            cs[m] = *(const h8*)((const _Float16*)cosT + pos * 64 + dm); sn[m] = *(const h8*)((const _Float16*)sinT + pos * 64 + dm); } } while (0)
        QK_TAB(0);
        ss_exchange(acc, wr, wc, fr, fq, P);
#pragma unroll
        for (int ai = 0; ai < 2; ++ai) {
            if (ai == 1) { asm volatile("" ::: "memory"); QK_TAB(1); }
#pragma unroll
            for (int m = 0; m < 4; ++m) { const int rl = ai * HALF + wr * 64 + m * 16 + fr, row = u.pm * BM + rl;
                const f32x4 t0 = *(const PG8_LAS f32x4*)(P + (rl * 2 + 0) * 4), t1 = *(const PG8_LAS f32x4*)(P + (rl * 2 + 1) * 4);
                const float ssh = hh ? ((t0[2] + t0[3]) + (t1[2] + t1[3])) : ((t0[0] + t0[1]) + (t1[0] + t1[1]));
                const float rw = rr[ai][m], rstd = rw * rsqrtf(rw * rw * ssh * (1.0f / 128.0f) + RMS_EPS);
                const h8 ch = cs[m], sh = sn[m];
                const f32x4 ca = {(float)ch[0], (float)ch[1], (float)ch[2], (float)ch[3]}, cb = {(float)ch[4], (float)ch[5], (float)ch[6], (float)ch[7]};
                const f32x4 sa = {(float)sh[0], (float)sh[1], (float)sh[2], (float)sh[3]}, sb = {(float)sh[4], (float)sh[5], (float)sh[6], (float)sh[7]};
                const f32x4 x1a = acc[ai][0][m][0] * rstd * g0a, x1b = acc[ai][0][m][1] * rstd * g0b, x2a = acc[ai][1][m][0] * rstd * g1a, x2b = acc[ai][1][m][1] * rstd * g1b;
                bf16_t* op = O + (size_t)row * 9216 + c0 + hh * 128 + dm;
                *(u32x4*)op = pack8(x1a * ca - x2a * sa, x1b * cb - x2b * sb);
                *(u32x4*)(op + 64) = pack8(x2a * ca + x1a * sa, x2b * cb + x1b * sb); }
        }
#undef QK_TAB
    }
};
struct EpiLat {
    static constexpr bool PERM = true, AFTER_DRAIN = false;
    bf16_t* cqn; bf16_t* ckvn; float* kr; float* ssr; const float* qag; const float* kvag; const float* kg; const float* cos64; const float* sin64; PG8_LAS float* P; const float* rs;
    __device__ __forceinline__ void operator()(const f32x4 (&acc)[2][2][4][2], const Unit& u, int wr, int wc, int fr, int fq) const {
        asm volatile("" : "+v"(fr), "+v"(fq));
        float rr[2][4];
#pragma unroll
        for (int ai = 0; ai < 2; ++ai)
#pragma unroll
            for (int m = 0; m < 4; ++m) rr[ai][m] = row_rstd(rs, u.pm * BM + ai * HALF + wr * 64 + m * 16 + fr);
        ss_exchange(acc, wr, wc, fr, fq, P);
        const int col0 = wc * 32 + 8 * fq;
        if (u.pn == 0) {
            f32x4 ga[2][2];
#pragma unroll
            for (int bj = 0; bj < 2; ++bj) { ga[bj][0] = *(const f32x4*)(qag + bj * HALF + col0); ga[bj][1] = *(const f32x4*)(qag + bj * HALF + col0 + 4); }
#pragma unroll
            for (int ai = 0; ai < 2; ++ai)
#pragma unroll
                for (int m = 0; m < 4; ++m) { const int rl = ai * HALF + wr * 64 + m * 16 + fr, row = u.pm * BM + rl;
                    const f32x4 t0 = *(const PG8_LAS f32x4*)(P + (rl * 2 + 0) * 4), t1 = *(const PG8_LAS f32x4*)(P + (rl * 2 + 1) * 4);
                    const float rw = rr[ai][m], rstd = rw * rsqrtf(rw * rw * (hsum4(t0) + hsum4(t1)) * (1.0f / 256.0f) + RMS_EPS);
#pragma unroll
                    for (int bj = 0; bj < 2; ++bj) *(u32x4*)(cqn + (size_t)row * 256 + bj * HALF + col0) = pack8(acc[ai][bj][m][0] * rstd * ga[bj][0], acc[ai][bj][m][1] * rstd * ga[bj][1]);
                    asm volatile("" ::: "memory"); }
        } else {
            const f32x4 gv0 = *(const f32x4*)(kvag + col0), gv1 = *(const f32x4*)(kvag + col0 + 4);
            const int i0 = (16 * wc + 4 * fq) & 31;
            const f32x4 gk0 = *(const f32x4*)(kg + 128 + i0), gk1 = *(const f32x4*)(kg + 160 + i0);
#pragma unroll
            for (int ai = 0; ai < 2; ++ai)
#pragma unroll
                for (int m = 0; m < 4; ++m) { const int rl = ai * HALF + wr * 64 + m * 16 + fr, row = u.pm * BM + rl, pos = row & 8191;
                    const f32x4 t0 = *(const PG8_LAS f32x4*)(P + (rl * 2 + 0) * 4), t1 = *(const PG8_LAS f32x4*)(P + (rl * 2 + 1) * 4);
                    const float rw = rr[ai][m], rstd = rw * rsqrtf(rw * rw * hsum4(t0) * (1.0f / 128.0f) + RMS_EPS);
                    { const u32x4 w8 = pack8(acc[ai][0][m][0] * rstd * gv0, acc[ai][0][m][1] * rstd * gv1);
                      *(u32x4*)(ckvn + (size_t)row * 128 + col0) = w8; }
                    if (wc < 2) { const f32x4 cs = *(const f32x4*)(cos64 + pos * 32 + i0), sn = *(const f32x4*)(sin64 + pos * 32 + i0);
                        const f32x4 x1 = acc[ai][1][m][0] * rw * gk0, x2 = acc[ai][1][m][1] * rw * gk1;
                        *(f32x4*)(kr + (size_t)row * 64 + i0) = x1 * cs - x2 * sn; *(f32x4*)(kr + (size_t)row * 64 + 32 + i0) = x2 * cs + x1 * sn; }
                    if (wc == 0 && fq == 0) ssr[row] = rw * rw * hsum4(t1);
                    asm volatile("" ::: "memory"); }
        }
    }
};
struct EpiQB {
    static constexpr bool PERM = true, AFTER_DRAIN = false;
    bf16_t* Q; const float* qg; const float* cos64; const float* sin64; PG8_LAS float* P;
    __device__ __forceinline__ void operator()(const f32x4 (&acc)[2][2][4][2], const Unit& u, int wr, int wc, int fr, int fq) const {
        asm volatile("" : "+v"(fr), "+v"(fq));
        const int h = u.pn, col0 = wc * 32 + 8 * fq, i0 = (16 * wc + 4 * fq) & 31;
        const f32x4 ga = *(const f32x4*)(qg + col0), gb = *(const f32x4*)(qg + col0 + 4), gr0 = *(const f32x4*)(qg + 128 + i0), gr1 = *(const f32x4*)(qg + 160 + i0);
        f32x4 csv[2][4], snv[2][4];
        if (wc < 2) {
#pragma unroll
            for (int ai = 0; ai < 2; ++ai)
#pragma unroll
                for (int m = 0; m < 4; ++m) { const int s_ = (u.pm * BM + ai * HALF + wr * 64 + m * 16 + fr) & 8191; csv[ai][m] = *(const f32x4*)(cos64 + s_ * 32 + i0); snv[ai][m] = *(const f32x4*)(sin64 + s_ * 32 + i0); }
        }
        ss_exchange(acc, wr, wc, fr, fq, P);
#pragma unroll
        for (int ai = 0; ai < 2; ++ai)
#pragma unroll
            for (int m = 0; m < 4; ++m) { const int rl = ai * HALF + wr * 64 + m * 16 + fr, row = u.pm * BM + rl, b = row >> 13, s = row & 8191;
                const f32x4 t0 = *(const PG8_LAS f32x4*)(P + (rl * 2 + 0) * 4), t1 = *(const PG8_LAS f32x4*)(P + (rl * 2 + 1) * 4);
                const float rstd = rsqrtf((hsum4(t0) + hsum4(t1)) * (1.0f / 192.0f) + RMS_EPS) * (0.07216878364870322f * 1.4426950408889634f);
                bf16_t* qp = Q + ((size_t)(b * 8 + h) * 8192 + s) * 192;
                *(u32x4*)(qp + col0) = pack8(acc[ai][0][m][0] * rstd * ga, acc[ai][0][m][1] * rstd * gb);
                if (wc < 2) { const f32x4 cs = csv[ai][m], sn = snv[ai][m];
                    const f32x4 x1 = acc[ai][1][m][0] * rstd * gr0, x2 = acc[ai][1][m][1] * rstd * gr1;
                    *(u32x2*)(qp + 128 + i0) = pack4(x1 * cs - x2 * sn); *(u32x2*)(qp + 160 + i0) = pack4(x2 * cs + x1 * sn); } }
    }
};
struct EpiKVB {
    static constexpr bool PERM = true, AFTER_DRAIN = false;
    bf16_t* K; bf16_t* V; const float* kg; const float* kr; const float* ssr; PG8_LAS float* P;
    __device__ __forceinline__ void operator()(const f32x4 (&acc)[2][2][4][2], const Unit& u, int wr, int wc, int fr, int fq) const {
        asm volatile("" : "+v"(fr), "+v"(fq));
        const int h = u.pn, col0 = wc * 32 + 8 * fq, c4 = 4 * (4 * wc + fq);
        const f32x4 ga = *(const f32x4*)(kg + col0), gb = *(const f32x4*)(kg + col0 + 4);
        f32x4 krv[2][4]; float ssv[2][4];
#pragma unroll
        for (int ai = 0; ai < 2; ++ai)
#pragma unroll
            for (int m = 0; m < 4; ++m) { const int row = u.pm * BM + ai * HALF + wr * 64 + m * 16 + fr; ssv[ai][m] = ssr[row]; krv[ai][m] = *(const f32x4*)(kr + (size_t)row * 64 + c4); }
        ss_exchange(acc, wr, wc, fr, fq, P);
#pragma unroll
        for (int ai = 0; ai < 2; ++ai)
#pragma unroll
            for (int m = 0; m < 4; ++m) { const int rl = ai * HALF + wr * 64 + m * 16 + fr, row = u.pm * BM + rl, b = row >> 13, s = row & 8191;
                const f32x4 t0 = *(const PG8_LAS f32x4*)(P + (rl * 2 + 0) * 4);
                const float rstd = rsqrtf((hsum4(t0) + ssv[ai][m]) * (1.0f / 192.0f) + RMS_EPS);
                const size_t tok = (size_t)(b * 8 + h) * 8192 + s;
                bf16_t* kp = K + tok * 192;
                *(u32x4*)(kp + col0) = pack8(acc[ai][0][m][0] * rstd * ga, acc[ai][0][m][1] * rstd * gb);
                const f32x4 r4 = krv[ai][m] * rstd;
                *(u32x2*)(kp + 128 + c4) = pack4(r4);
                *(u32x4*)(V + tok * 128 + col0) = pack8(acc[ai][1][m][0], acc[ai][1][m][1]); }
    }
};

template <class Epi, class Sched, bool ALIGN_EPI = false, bool SP2 = false>
__device__ __forceinline__ void gemm_phase(PG8_LAS unsigned char* lds, const Gemm g, const Sched& S, const Epi& E, int wave_s) {
    int tid_l = wave_s * 64 + mk_lane(); asm volatile("" : "+v"(tid_l));
    const int tid = tid_l, wid = __builtin_amdgcn_readfirstlane(tid >> 6), lane = tid & 63, wr = wid >> 2, wc = wid & 3, fr = lane & 15, fq = lane >> 4;
    int K_l = g.K; asm volatile("" : "+s"(K_l));
    const int K = K_l, nt = K / BK;
    unsigned voffA[2], voffB[2];
#pragma unroll
    for (int i = 0; i < 2; ++i) { int R, C; stage_rc(tid * 16 + i * 8192, R, C); const int Rb = Epi::PERM ? ((R & ~31) + perm32(R & 31)) : R;
        voffA[i] = (unsigned)(R * K + C) * 2u; voffB[i] = (unsigned)(Rb * K + C) * 2u; }
    const size_t kstep = (size_t)(BK * 2);
    const size_t hstep = (size_t)HALF * K * 2;
    const size_t tstep = 2 * hstep;
    const unsigned ldsw = (unsigned)wid * 1024u;
    const int aoff = lds_byte(wr * 64 + fr, fq * 8), boff = lds_byte(wc * 32 + fr, fq * 8);
#define PG8_SA(b, h) (((b) * 2 + (h)) * HTB)
#define PG8_SB(b, h) ((4 + (b) * 2 + (h)) * HTB)
#define PG8_STAGE(bufoff, gbase, voff) do { _Pragma("unroll") for (int _i = 0; _i < 2; ++_i) \
        __builtin_amdgcn_global_load_lds((const unsigned*)((const char*)(gbase) + (voff)[_i]), (PG8_LAS unsigned*)(lds + (bufoff) + ldsw + _i * 8192), 16, 0, 0); } while (0)
#define PG8_LDA(dst, b, h) do { _Pragma("unroll") for (int m = 0; m < 4; ++m) _Pragma("unroll") for (int k = 0; k < 2; ++k) dst[m][k] = *(const PG8_LAS bf16x8*)(lds + PG8_SA(b, h) + aoff + m * 2048 + k * 1024); } while (0)
#define PG8_LDB(dst, b, h) do { _Pragma("unroll") for (int n = 0; n < 2; ++n) _Pragma("unroll") for (int k = 0; k < 2; ++k) dst[n][k] = *(const PG8_LAS bf16x8*)(lds + PG8_SB(b, h) + boff + n * 2048 + k * 1024); } while (0)
#define PG8_MMA(ai, bj, At, Bt) do { __builtin_amdgcn_s_setprio(1); _Pragma("unroll") for (int m = 0; m < 4; ++m) _Pragma("unroll") for (int n = 0; n < 2; ++n) _Pragma("unroll") for (int k = 0; k < 2; ++k) \
        acc[ai][bj][m][n] = __builtin_amdgcn_mfma_f32_16x16x32_bf16(Bt[n][k], At[m][k], acc[ai][bj][m][n], 0, 0, 0); __builtin_amdgcn_s_setprio(0); } while (0)
#define PG8_WAIT_V(n) asm volatile("s_waitcnt vmcnt(" #n ")" ::: "memory")
#define PG8_WAIT_L(n) asm volatile("s_waitcnt lgkmcnt(" #n ")" ::: "memory")
#define PG8_BAR __builtin_amdgcn_s_barrier()
#define PG8_SCHED __builtin_amdgcn_sched_barrier(0)
    Unit cur, nxt; int ui = 0;
    if (!S.next(0, cur)) return;
    f32x4 acc[2][2][4][2];
#pragma unroll
    for (int a = 0; a < 2; ++a)
#pragma unroll
        for (int b = 0; b < 2; ++b)
#pragma unroll
            for (int m = 0; m < 4; ++m)
#pragma unroll
                for (int n = 0; n < 2; ++n) acc[a][b][m][n] = (f32x4){0.f, 0.f, 0.f, 0.f};
    bf16x8 At[4][2], B0[2][2], B1[2][2];
    const char* cA = (const char*)g.A + (size_t)cur.pm * tstep; const char* cB = (const char*)g.Bt + (size_t)cur.pn * tstep;
    S.a_ready(cur);
    if constexpr (SP2) {
        PG8_STAGE(PG8_SB(0, 0), cB, voffB); PG8_STAGE(PG8_SB(0, 1), cB + hstep, voffB); PG8_STAGE(PG8_SA(0, 0), cA, voffA); PG8_STAGE(PG8_SA(0, 1), cA + hstep, voffA);
        if (wr == 1) PG8_BAR;
        PG8_WAIT_V(2); PG8_BAR;
        PG8_STAGE(PG8_SB(1, 0), cB + kstep, voffB); PG8_STAGE(PG8_SA(1, 0), cA + kstep, voffA); PG8_STAGE(PG8_SB(1, 1), cB + hstep + kstep, voffB);
        PG8_WAIT_V(6); PG8_BAR;
    } else {
        PG8_STAGE(PG8_SB(0, 0), cB, voffB); PG8_STAGE(PG8_SA(0, 0), cA, voffA); PG8_STAGE(PG8_SB(0, 1), cB + hstep, voffB); PG8_STAGE(PG8_SA(0, 1), cA + hstep, voffA);
        if (wr == 1) PG8_BAR;
        PG8_WAIT_V(4); PG8_BAR;
        PG8_STAGE(PG8_SB(1, 0), cB + kstep, voffB); PG8_STAGE(PG8_SA(1, 0), cA + kstep, voffA); PG8_STAGE(PG8_SB(1, 1), cB + hstep + kstep, voffB);
        PG8_WAIT_V(6); PG8_BAR;
    }
    for (;;) {
        const bool has_next = S.next(ui + 1, nxt);
        const char* nA = has_next ? (const char*)g.A + (size_t)nxt.pm * tstep : cA; const char* nB = has_next ? (const char*)g.Bt + (size_t)nxt.pn * tstep : cB;
        for (int t = 0; t < nt; t += 2) {
            const bool last = (t == nt - 2);
            const char* a1 = cA + (size_t)(t + 1) * kstep;
            const char* a2 = last ? nA : cA + (size_t)(t + 2) * kstep; const char* b2 = last ? nB : cB + (size_t)(t + 2) * kstep;
            const char* a3 = a2 + kstep; const char* b3 = b2 + kstep;
            if (last && has_next) S.a_ready(nxt);
            if constexpr (SP2) {
            PG8_LDB(B0, 0, 0); PG8_LDB(B1, 0, 1); PG8_SCHED; PG8_LDA(At, 0, 0); PG8_STAGE(PG8_SA(1, 1), a1 + hstep, voffA);
            PG8_WAIT_V(8); PG8_WAIT_L(0); PG8_BAR; PG8_MMA(0, 0, At, B0); PG8_MMA(0, 1, At, B1); PG8_BAR; PG8_SCHED;
            PG8_LDA(At, 0, 1); PG8_STAGE(PG8_SB(0, 0), b2, voffB); PG8_STAGE(PG8_SB(0, 1), b2 + hstep, voffB); PG8_STAGE(PG8_SA(0, 0), a2, voffA);
            PG8_WAIT_V(8); PG8_WAIT_L(0); PG8_BAR; PG8_MMA(1, 0, At, B0); PG8_MMA(1, 1, At, B1); PG8_BAR; PG8_SCHED;
            PG8_LDB(B0, 1, 0); PG8_LDB(B1, 1, 1); PG8_SCHED; PG8_LDA(At, 1, 0); PG8_STAGE(PG8_SA(0, 1), a2 + hstep, voffA);
            PG8_WAIT_V(8); PG8_WAIT_L(0); PG8_BAR; PG8_MMA(0, 0, At, B0); PG8_MMA(0, 1, At, B1); PG8_BAR; PG8_SCHED;
            PG8_LDA(At, 1, 1); PG8_STAGE(PG8_SB(1, 0), b3, voffB); PG8_STAGE(PG8_SB(1, 1), b3 + hstep, voffB); PG8_STAGE(PG8_SA(1, 0), a3, voffA);
            PG8_WAIT_V(8); PG8_WAIT_L(0); PG8_BAR; PG8_MMA(1, 0, At, B0); PG8_MMA(1, 1, At, B1); PG8_BAR; PG8_SCHED;
            } else {
            PG8_LDB(B0, 0, 0); PG8_SCHED; PG8_LDA(At, 0, 0); PG8_STAGE(PG8_SA(1, 1), a1 + hstep, voffA);
            PG8_WAIT_L(8); PG8_BAR; PG8_WAIT_L(0); PG8_MMA(0, 0, At, B0); PG8_BAR; PG8_SCHED;
            PG8_LDB(B1, 0, 1); PG8_STAGE(PG8_SB(0, 0), b2, voffB);
            PG8_BAR; PG8_WAIT_L(0); PG8_MMA(0, 1, At, B1); PG8_BAR;
            PG8_LDA(At, 0, 1); PG8_STAGE(PG8_SA(0, 0), a2, voffA);
            PG8_BAR; PG8_WAIT_L(0); PG8_MMA(1, 0, At, B0); PG8_BAR; PG8_SCHED;
            PG8_STAGE(PG8_SB(0, 1), b2 + hstep, voffB);
            PG8_WAIT_V(6); PG8_BAR; PG8_MMA(1, 1, At, B1); PG8_BAR;
            PG8_LDB(B0, 1, 0); PG8_SCHED; PG8_LDA(At, 1, 0); PG8_STAGE(PG8_SA(0, 1), a2 + hstep, voffA);
            PG8_WAIT_L(8); PG8_BAR; PG8_WAIT_L(0); PG8_MMA(0, 0, At, B0); PG8_BAR; PG8_SCHED;
            PG8_LDB(B1, 1, 1); PG8_STAGE(PG8_SB(1, 0), b3, voffB);
            PG8_BAR; PG8_WAIT_L(0); PG8_MMA(0, 1, At, B1); PG8_BAR;
            PG8_LDA(At, 1, 1); PG8_STAGE(PG8_SA(1, 0), a3, voffA);
            PG8_BAR; PG8_WAIT_L(0); PG8_MMA(1, 0, At, B0); PG8_BAR; PG8_SCHED;
            PG8_STAGE(PG8_SB(1, 1), b3 + hstep, voffB);
            PG8_WAIT_V(6); PG8_BAR; PG8_MMA(1, 1, At, B1); PG8_BAR;
            }
        }
        if constexpr (ALIGN_EPI) { if (wr == 0) PG8_BAR; }
        if constexpr (!Epi::AFTER_DRAIN) { E(acc, cur, wr, wc, fr, fq); S.done(cur); }
        if (!has_next) break;
#pragma unroll
        for (int a = 0; a < 2; ++a)
#pragma unroll
            for (int b = 0; b < 2; ++b)
#pragma unroll
                for (int m = 0; m < 4; ++m)
#pragma unroll
                    for (int n = 0; n < 2; ++n) acc[a][b][m][n] = (f32x4){0.f, 0.f, 0.f, 0.f};
        cur = nxt; cA = nA; cB = nB; ++ui;
        if constexpr (ALIGN_EPI) { if (wr == 1) PG8_BAR; }
    }
    PG8_WAIT_V(0);
    if constexpr (!ALIGN_EPI) { if (wr == 0) PG8_BAR; }
    PG8_BAR;
    if constexpr (Epi::AFTER_DRAIN) { E.fused(acc, cur, wr, wc, fr, fq, lds, wid, lane); S.done(cur); }
#undef PG8_SA
#undef PG8_SB
#undef PG8_STAGE
#undef PG8_LDA
#undef PG8_LDB
#undef PG8_MMA
#undef PG8_WAIT_V
#undef PG8_WAIT_L
#undef PG8_BAR
#undef PG8_SCHED
}
}
namespace att {
#define ATT_LAS __attribute__((address_space(3)))
typedef unsigned short bf16_t;
typedef short bf16x8 __attribute__((ext_vector_type(8)));
typedef short s16x4 __attribute__((ext_vector_type(4)));
typedef float f32x16 __attribute__((ext_vector_type(16)));
typedef unsigned u32x4 __attribute__((ext_vector_type(4)));
#define SBAR() __builtin_amdgcn_sched_barrier(0)
__device__ __forceinline__ int crow(int r, int hi) { return (r & 3) + 8 * (r >> 2) + 4 * hi; }
__device__ __forceinline__ unsigned cvtpk(float lo, float hi) { unsigned r; asm volatile("v_cvt_pk_bf16_f32 %0, %1, %2" : "=v"(r) : "v"(lo), "v"(hi)); return r; }
__device__ __forceinline__ unsigned short f2bf(float f) { return (unsigned short)(cvtpk(f, f) & 0xffffu); }

template <int THRON>
__device__ __forceinline__ void partialSM(f32x16& p0, f32x16& p1, float& m_reg, float& mn, float& alpha, float C, float thr_raw) {
  float pmax = p0[0];
#pragma unroll
  for (int r = 1; r < 16; ++r) pmax = fmaxf(pmax, p0[r]);
#pragma unroll
  for (int r = 0; r < 16; ++r) pmax = fmaxf(pmax, p1[r]);
  { auto rr = __builtin_amdgcn_permlane32_swap(__float_as_uint(pmax), __float_as_uint(pmax), false, false);
    pmax = fmaxf(__uint_as_float(rr[0]), __uint_as_float(rr[1])); }
  if (THRON && __builtin_expect(__all(pmax - m_reg <= thr_raw), 1)) { mn = m_reg; alpha = 1.f; }
  else { mn = fmaxf(m_reg, pmax); alpha = __builtin_amdgcn_exp2f((m_reg - mn) * C); m_reg = mn; }
  const float mnC = -mn * C;
#pragma unroll
  for (int r = 0; r < 16; ++r) p0[r] = fmaf(p0[r], C, mnC);
#pragma unroll
  for (int r = 0; r < 16; ++r) p1[r] = fmaf(p1[r], C, mnC);
#pragma unroll
  for (int r = 0; r < 16; ++r) p0[r] = __builtin_amdgcn_exp2f(p0[r]);
}
__device__ __forceinline__ void partialSM_ref(f32x16& p0, f32x16& p1, float& mref, f32x16& negm, float& alpha, float thr2, bool first, bool check) {
  if (!check) { alpha = 1.f;
#pragma unroll
    for (int r = 0; r < 16; ++r) p0[r] = __builtin_amdgcn_exp2f(p0[r]);
    return; }
  float pmax = p0[0];
#pragma unroll
  for (int r = 1; r < 16; ++r) pmax = fmaxf(pmax, p0[r]);
#pragma unroll
  for (int r = 0; r < 16; ++r) pmax = fmaxf(pmax, p1[r]);
  { auto rr = __builtin_amdgcn_permlane32_swap(__float_as_uint(pmax), __float_as_uint(pmax), false, false);
    pmax = fmaxf(__uint_as_float(rr[0]), __uint_as_float(rr[1])); }
  if (!first && __builtin_expect(__all(pmax <= thr2), 1)) { alpha = 1.f; }
  else { const float dl = first ? pmax : fmaxf(pmax, 0.f); mref += dl; alpha = first ? 1.f : __builtin_amdgcn_exp2f(-dl);
#pragma unroll
    for (int r = 0; r < 16; ++r) { p0[r] -= dl; p1[r] -= dl; }
#pragma unroll
    for (int r = 0; r < 16; ++r) negm[r] = -mref; }
#pragma unroll
  for (int r = 0; r < 16; ++r) p0[r] = __builtin_amdgcn_exp2f(p0[r]);
}
__device__ __forceinline__ void finishSM(f32x16& p0, f32x16& p1, float alpha, float& l_reg, bf16x8& pa0, bf16x8& pa1, bf16x8& pa2, bf16x8& pa3) {
#pragma unroll
  for (int r = 0; r < 16; ++r) p1[r] = __builtin_amdgcn_exp2f(p1[r]);
  float ps = 0;
#pragma unroll
  for (int r = 0; r < 16; ++r) ps += p0[r];
#pragma unroll
  for (int r = 0; r < 16; ++r) ps += p1[r];
  { auto rr = __builtin_amdgcn_permlane32_swap(__float_as_uint(ps), __float_as_uint(ps), false, false);
    ps = __uint_as_float(rr[0]) + __uint_as_float(rr[1]); }
  l_reg = l_reg * alpha + ps;
#define PK4(P, BASE, OUT) do { unsigned a0 = cvtpk(P[BASE + 0], P[BASE + 1]), a1 = cvtpk(P[BASE + 2], P[BASE + 3]);   \
    unsigned b0 = cvtpk(P[BASE + 4], P[BASE + 5]), b1 = cvtpk(P[BASE + 6], P[BASE + 7]);                              \
    auto r0 = __builtin_amdgcn_permlane32_swap(a0, b0, false, false); auto r1 = __builtin_amdgcn_permlane32_swap(a1, b1, false, false); \
    u32x4 w = {r0[0], r1[0], r0[1], r1[1]}; OUT = __builtin_bit_cast(bf16x8, w); } while (0)
  PK4(p0, 0, pa0); PK4(p0, 8, pa1); PK4(p1, 0, pa2); PK4(p1, 8, pa3);
#undef PK4
}
__device__ __forceinline__ void finishSM_np(f32x16& p0, f32x16& p1, float alpha, float& l_reg, bf16x8& pa0, bf16x8& pa1, bf16x8& pa2, bf16x8& pa3) {
#pragma unroll
  for (int r = 0; r < 16; ++r) p1[r] = __builtin_amdgcn_exp2f(p1[r]);
  float ps = 0;
#pragma unroll
  for (int r = 0; r < 16; ++r) ps += p0[r];
#pragma unroll
  for (int r = 0; r < 16; ++r) ps += p1[r];
  { auto rr = __builtin_amdgcn_permlane32_swap(__float_as_uint(ps), __float_as_uint(ps), false, false);
    ps = __uint_as_float(rr[0]) + __uint_as_float(rr[1]); }
  l_reg = l_reg * alpha + ps;
#define PK8(P, BASE, OUT) do { u32x4 w = {cvtpk(P[BASE + 0], P[BASE + 1]), cvtpk(P[BASE + 2], P[BASE + 3]), cvtpk(P[BASE + 4], P[BASE + 5]), cvtpk(P[BASE + 6], P[BASE + 7])}; OUT = __builtin_bit_cast(bf16x8, w); } while (0)
  PK8(p0, 0, pa0); PK8(p0, 8, pa1); PK8(p1, 0, pa2); PK8(p1, 8, pa3);
#undef PK8
}
template <int DQK> __device__ __forceinline__ constexpr int kstride() { return DQK * 2 + 16; }
template <int DQK> __device__ __forceinline__ int kswz(int row, int colB) { return row * kstride<DQK>() + colB; }
template <int DQK, int LA = 2> __device__ __forceinline__ void qkt(f32x16& p0, f32x16& p1, const ATT_LAS char* Ks, const bf16x8* qr, int r32, int hi) {
  constexpr int N = DQK / 16;
  const ATT_LAS char* k0 = Ks + r32 * kstride<DQK>(); const ATT_LAS char* k1 = Ks + (32 + r32) * kstride<DQK>(); const int sw = 0;
  bf16x8 kf[N][2];
  p0 = f32x16{}; p1 = f32x16{};
#pragma unroll
  for (int d0 = 0; d0 < LA; ++d0) { const int cb = ((d0 * 16 + hi * 8) * 2) ^ sw; kf[d0][0] = *(const ATT_LAS bf16x8*)(k0 + cb); kf[d0][1] = *(const ATT_LAS bf16x8*)(k1 + cb); }
  SBAR();
#pragma unroll
  for (int d0 = 0; d0 < N; ++d0) {
    if (d0 + LA < N) { const int cb = (((d0 + LA) * 16 + hi * 8) * 2) ^ sw; kf[d0 + LA][0] = *(const ATT_LAS bf16x8*)(k0 + cb); kf[d0 + LA][1] = *(const ATT_LAS bf16x8*)(k1 + cb); }
    SBAR();
    p0 = __builtin_amdgcn_mfma_f32_32x32x16_bf16(kf[d0][0], qr[d0], p0, 0, 0, 0);
    p1 = __builtin_amdgcn_mfma_f32_32x32x16_bf16(kf[d0][1], qr[d0], p1, 0, 0, 0);
    SBAR();
  }
}
template <int DQK, int LA = 2> __device__ __forceinline__ void qkt_c(f32x16& p0, f32x16& p1, const ATT_LAS char* Ks, const bf16x8* qr, int r32, int hi, const f32x16& cinit) {
  constexpr int N = DQK / 16;
  const int rp = (r32 & ~0xC) | ((r32 & 4) << 1) | ((r32 & 8) >> 1);
  const ATT_LAS char* k0 = Ks + rp * kstride<DQK>(); const ATT_LAS char* k1 = Ks + (32 + rp) * kstride<DQK>(); const int sw = 0;
  bf16x8 kf[N][2];
  p0 = cinit; p1 = cinit;
#pragma unroll
  for (int d0 = 0; d0 < LA; ++d0) { const int cb = ((d0 * 16 + hi * 8) * 2) ^ sw; kf[d0][0] = *(const ATT_LAS bf16x8*)(k0 + cb); kf[d0][1] = *(const ATT_LAS bf16x8*)(k1 + cb); }
  SBAR();
#pragma unroll
  for (int d0 = 0; d0 < N; ++d0) {
    if (d0 + LA < N) { const int cb = (((d0 + LA) * 16 + hi * 8) * 2) ^ sw; kf[d0 + LA][0] = *(const ATT_LAS bf16x8*)(k0 + cb); kf[d0 + LA][1] = *(const ATT_LAS bf16x8*)(k1 + cb); }
    SBAR();
    p0 = __builtin_amdgcn_mfma_f32_32x32x16_bf16(kf[d0][0], qr[d0], p0, 0, 0, 0);
    p1 = __builtin_amdgcn_mfma_f32_32x32x16_bf16(kf[d0][1], qr[d0], p1, 0, 0, 0);
    SBAR();
  }
}
__device__ __forceinline__ int v_st(int k, int c) { const int kk = (k & ~0xC) | ((k & 4) << 1) | ((k & 8) >> 1); return ((kk >> 3) * 4 + (c >> 5)) * 512 + ((kk & 7) * 32 + (c & 31)) * 2; }
__device__ __forceinline__ int v_rd_base(int lane) { return ((lane & 3) << 3) | (((lane >> 2) & 3) << 6) | (((lane >> 4) & 1) << 5) | (((lane >> 5) & 1) << 8); }
constexpr int v_rd_off(int d0, int ks, int half) { return d0 * 512 + ks * 4096 + half * 2048; }
template <int OFF> __device__ __forceinline__ s16x4 tr_read(int vb) { s16x4 r; asm volatile("ds_read_b64_tr_b16 %0, %1 offset:%2" : "=&v"(r) : "v"(vb), "i"(OFF) : "memory"); return r; }
template <int D0> __device__ __forceinline__ void pv_one(f32x16& od, int vb, bf16x8 pa0, bf16x8 pa1, bf16x8 pa2, bf16x8 pa3) {
  const s16x4 l0 = tr_read<v_rd_off(D0, 0, 0)>(vb), h0 = tr_read<v_rd_off(D0, 0, 1)>(vb), l1 = tr_read<v_rd_off(D0, 1, 0)>(vb), h1 = tr_read<v_rd_off(D0, 1, 1)>(vb);
  const s16x4 l2 = tr_read<v_rd_off(D0, 2, 0)>(vb), h2 = tr_read<v_rd_off(D0, 2, 1)>(vb), l3 = tr_read<v_rd_off(D0, 3, 0)>(vb), h3 = tr_read<v_rd_off(D0, 3, 1)>(vb);
  asm volatile("s_waitcnt lgkmcnt(0)" ::: "memory"); SBAR();
#define PK(L, H) (bf16x8){L[0], L[1], L[2], L[3], H[0], H[1], H[2], H[3]}
  od = __builtin_amdgcn_mfma_f32_32x32x16_bf16(pa0, PK(l0, h0), od, 0, 0, 0);
  od = __builtin_amdgcn_mfma_f32_32x32x16_bf16(pa1, PK(l1, h1), od, 0, 0, 0);
  od = __builtin_amdgcn_mfma_f32_32x32x16_bf16(pa2, PK(l2, h2), od, 0, 0, 0);
  od = __builtin_amdgcn_mfma_f32_32x32x16_bf16(pa3, PK(l3, h3), od, 0, 0, 0);
#undef PK
}
__device__ __forceinline__ void pv_d0(f32x16* o, int vb, bf16x8 pa0, bf16x8 pa1, bf16x8 pa2, bf16x8 pa3) {
  pv_one<0>(o[0], vb, pa0, pa1, pa2, pa3); pv_one<1>(o[1], vb, pa0, pa1, pa2, pa3); pv_one<2>(o[2], vb, pa0, pa1, pa2, pa3); pv_one<3>(o[3], vb, pa0, pa1, pa2, pa3);
}

template <int D0> __device__ __forceinline__ void pv_reads(s16x4 (&l)[4], s16x4 (&h)[4], int vb) {
  l[0] = tr_read<v_rd_off(D0, 0, 0)>(vb); h[0] = tr_read<v_rd_off(D0, 0, 1)>(vb); l[1] = tr_read<v_rd_off(D0, 1, 0)>(vb); h[1] = tr_read<v_rd_off(D0, 1, 1)>(vb);
  l[2] = tr_read<v_rd_off(D0, 2, 0)>(vb); h[2] = tr_read<v_rd_off(D0, 2, 1)>(vb); l[3] = tr_read<v_rd_off(D0, 3, 0)>(vb); h[3] = tr_read<v_rd_off(D0, 3, 1)>(vb);
}
__device__ __forceinline__ void pv_mma(f32x16& od, const s16x4 (&l)[4], const s16x4 (&h)[4], bf16x8 pa0, bf16x8 pa1, bf16x8 pa2, bf16x8 pa3) {
#define PK(L, H) (bf16x8){L[0], L[1], L[2], L[3], H[0], H[1], H[2], H[3]}
  od = __builtin_amdgcn_mfma_f32_32x32x16_bf16(pa0, PK(l[0], h[0]), od, 0, 0, 0);
  od = __builtin_amdgcn_mfma_f32_32x32x16_bf16(pa1, PK(l[1], h[1]), od, 0, 0, 0);
  od = __builtin_amdgcn_mfma_f32_32x32x16_bf16(pa2, PK(l[2], h[2]), od, 0, 0, 0);
  od = __builtin_amdgcn_mfma_f32_32x32x16_bf16(pa3, PK(l[3], h[3]), od, 0, 0, 0);
#undef PK
}
__device__ __forceinline__ void pv_d0_la(f32x16* o, int vb, bf16x8 pa0, bf16x8 pa1, bf16x8 pa2, bf16x8 pa3) {
  s16x4 la[4], ha[4], lb[4], hb[4];
  pv_reads<0>(la, ha, vb); pv_reads<1>(lb, hb, vb);
  asm volatile("s_waitcnt lgkmcnt(8)" ::: "memory"); SBAR(); pv_mma(o[0], la, ha, pa0, pa1, pa2, pa3); SBAR();
  pv_reads<2>(la, ha, vb);
  asm volatile("s_waitcnt lgkmcnt(8)" ::: "memory"); SBAR(); pv_mma(o[1], lb, hb, pa0, pa1, pa2, pa3); SBAR();
  pv_reads<3>(lb, hb, vb);
  asm volatile("s_waitcnt lgkmcnt(8)" ::: "memory"); SBAR(); pv_mma(o[2], la, ha, pa0, pa1, pa2, pa3); SBAR();
  asm volatile("s_waitcnt lgkmcnt(0)" ::: "memory"); SBAR(); pv_mma(o[3], lb, hb, pa0, pa1, pa2, pa3);
}

template <int DQK, bool BAND>
__device__ __forceinline__ void attn_unit(const bf16_t* Qb, long ldq, const bf16_t* Kb, long ldk, const bf16_t* Vb, long ldv, bf16_t* Ob, long ldo, float* lse, long ldl,
                                          int kt0, int kt1, int qtile0, float scale, ATT_LAS char* lds, int wave_s) {
  constexpr int KB_BYTES = 64 * DQK * 2, VB_BYTES = 64 * 128 * 2, KCH = DQK / 8, NKC = DQK / 64;
  int tid_l = wave_s * 64 + mk_lane(); asm volatile("" : "+v"(tid_l));
  const int tid = tid_l, wid = __builtin_amdgcn_readfirstlane(tid >> 6), lane = tid & 63, r32 = lane & 31, hi = lane >> 5;
  ATT_LAS char* V_lds = lds; ATT_LAS char* K_lds = lds + 2 * VB_BYTES;
  ATT_LAS float* wsf = (ATT_LAS float*)(lds + 2 * VB_BYTES + 2 * KB_BYTES) + wid * 64; ATT_LAS float* li_l = wsf; ATT_LAS float* al_l = wsf + 32;
  const float C = scale * 1.4426950408889634f, thr_raw = 8.0f / scale;
  bf16x8 qr[DQK / 16];
  { const bf16_t* Qw = Qb + (long)(wid * 32 + r32) * ldq + hi * 8;
#pragma unroll
    for (int d0 = 0; d0 < DQK / 16; ++d0) qr[d0] = *(const bf16x8*)(Qw + d0 * 16); }
  float m_reg = -1e30f, l_reg = 0.f; f32x16 o[4] = {};
  const int qb = qtile0 + (wid >> 1), qi = (wid & 1) * 32 + r32;
  const int vb0 = (int)(unsigned)(uintptr_t)V_lds + v_rd_base(lane);
  bf16x8 ks[NKC], vs[2];
  const int vrow = tid >> 4, vcol = (tid & 15) * 8;
#define SLOAD(t) do { _Pragma("unroll") for (int i_ = 0; i_ < NKC; ++i_) { const int id_ = tid + 512 * i_, row_ = id_ / KCH, c8_ = id_ % KCH; ks[i_] = *(const bf16x8*)(Kb + (long)((t) * 64 + row_) * ldk + c8_ * 8); } \
    _Pragma("unroll") for (int i_ = 0; i_ < 2; ++i_) vs[i_] = *(const bf16x8*)(Vb + (long)((t) * 64 + vrow + 32 * i_) * ldv + vcol); } while (0)
#define SWRITE(b) do { _Pragma("unroll") for (int i_ = 0; i_ < NKC; ++i_) { const int id_ = tid + 512 * i_, row_ = id_ / KCH, c8_ = id_ % KCH; *(ATT_LAS bf16x8*)(K_lds + (b) * KB_BYTES + kswz<DQK>(row_, c8_ * 16)) = ks[i_]; } \
    _Pragma("unroll") for (int i_ = 0; i_ < 2; ++i_) *(ATT_LAS bf16x8*)(V_lds + (b) * VB_BYTES + v_st(vrow + 32 * i_, vcol)) = vs[i_]; } while (0)
  SLOAD(kt0); SWRITE(0); __syncthreads();
  for (int t = kt0; t < kt1; ++t) {
    const int b = (t - kt0) & 1; const bool more = (t + 1 < kt1);
    if (more) SLOAD(t + 1);
    const bool act = !BAND || (t >= qb - 1 && t <= qb + 1);
    if (act) {
      f32x16 p0, p1; qkt<DQK>(p0, p1, K_lds + b * KB_BYTES, qr, r32, hi);
      if (BAND) {
        if (t == qb - 1) {
#pragma unroll
          for (int r = 0; r < 16; ++r) { const int k0 = crow(r, hi); if (k0 < qi) p0[r] = -1e30f; if (k0 + 32 < qi) p1[r] = -1e30f; }
        } else if (t == qb + 1) {
#pragma unroll
          for (int r = 0; r < 16; ++r) { const int k0 = crow(r, hi); if (k0 > qi) p0[r] = -1e30f; if (k0 + 32 > qi) p1[r] = -1e30f; }
        }
      }
      float mn, alpha; partialSM<1>(p0, p1, m_reg, mn, alpha, C, thr_raw);
      bf16x8 pa0, pa1, pa2, pa3; finishSM(p0, p1, alpha, l_reg, pa0, pa1, pa2, pa3);
      if (__any(alpha < 1.f)) { if (hi == 0) al_l[r32] = alpha; asm volatile("s_waitcnt lgkmcnt(0)" ::: "memory");
#pragma unroll
        for (int d = 0; d < 4; ++d)
#pragma unroll
          for (int r = 0; r < 16; ++r) o[d][r] *= al_l[crow(r, hi)]; }
      pv_d0(o, vb0 + b * VB_BYTES, pa0, pa1, pa2, pa3);
    }
    if (more) SWRITE(b ^ 1);
    __syncthreads();
  }
#undef SLOAD
#undef SWRITE
  if (hi == 0) li_l[r32] = l_reg;
  asm volatile("s_waitcnt lgkmcnt(0)" ::: "memory");
  float rli[16];
#pragma unroll
  for (int r = 0; r < 16; ++r) rli[r] = __builtin_amdgcn_rcpf(li_l[crow(r, hi)]);
  bf16_t* Ow = Ob + (long)(wid * 32) * ldo;
#pragma unroll
  for (int r = 0; r < 16; ++r) { const int orow = crow(r, hi);
#pragma unroll
    for (int d0 = 0; d0 < 4; ++d0) Ow[(long)orow * ldo + d0 * 32 + r32] = f2bf(o[d0][r] * rli[r]); }
  if (lse != nullptr && hi == 0) lse[(long)(wid * 32 + r32) * ldl] = m_reg * scale + __logf(l_reg);
}

__device__ __forceinline__ void glds16(const void* gsrc, unsigned lds_dst) { unsigned keep;
  asm volatile("s_mov_b32 %0, m0\n\ts_mov_b32 m0, %2\n\ts_nop 0\n\tglobal_load_lds_dwordx4 %1, off\n\ts_mov_b32 m0, %0" : "=&s"(keep) : "v"(gsrc), "s"(lds_dst) : "memory"); }
#define WAIT_BAR(N) asm volatile("s_waitcnt vmcnt(" #N ") lgkmcnt(0)\n\ts_barrier" ::: "memory")
#define WAIT_BAR2(N0, N) do { if (wid == 0) WAIT_BAR(N0); else WAIT_BAR(N); } while (0)
#ifndef MLA_LA
#define MLA_LA 1
#endif
#ifndef MLA_PP_LA
#define MLA_PP_LA 6
#endif
constexpr int MLA_KSLOT = 64 * 400, MLA_KTILE = 64 * 192 * 2, MLA_VSLOT = 64 * 128 * 2, MLA_K0 = 0, MLA_V0 = 3 * MLA_KSLOT, MLA_WS = MLA_V0 + 3 * MLA_VSLOT, MLA_LDS = MLA_WS + 8 * 256;
template <int MODE = 0> __device__ __forceinline__ void mla_unit(const bf16_t* Qb, const bf16_t* Kh, const bf16_t* Vh, bf16_t* Ob, long ldo, int NT, float scale, ATT_LAS char* lds, int wave_s, bool do_store = true) {
  int tid_l = wave_s * 64 + mk_lane(); asm volatile("" : "+v"(tid_l));
  const int tid = tid_l, wid = __builtin_amdgcn_readfirstlane(tid >> 6), lane = tid & 63, r32 = lane & 31, hi = lane >> 5;
  const unsigned lds0 = (unsigned)(uintptr_t)lds;
  ATT_LAS float* wsf = (ATT_LAS float*)(lds + MLA_WS) + wid * 64; ATT_LAS float* li_l = wsf; ATT_LAS float* al_l = wsf + 32;
  const float C = scale * 1.4426950408889634f, thr_raw = 8.0f / scale;
  int ksrc[4], vsrc[2];
#pragma unroll
  for (int i = 0; i < 4; ++i) { const int gch = 64 * (wid + 8 * i) + lane, row = gch / 25, cc = gch % 25; ksrc[i] = row * 384 + (cc < 24 ? cc * 16 : 0); }
#pragma unroll
  for (int i = 0; i < 2; ++i) { const int B = 1024 * (2 * wid + i) + 16 * lane, sub = B >> 9, e = (B & 511) >> 1, kk = (sub >> 2) * 8 + (e >> 5), c = (sub & 3) * 32 + (e & 31);
    const int k = (kk & ~0xC) | ((kk & 4) << 1) | ((kk & 8) >> 1); vsrc[i] = (k * 128 + c) * 2; }
#define DMA_K(t, slot) do { const int t_ = (t) < NT ? (t) : NT - 1; const char* g_ = (const char*)Kh + (long)t_ * MLA_KTILE; \
    _Pragma("unroll") for (int i_ = 0; i_ < 4; ++i_) if ((i_ < 3 || wid == 0) && !(MODE & 2)) glds16(g_ + ksrc[i_], (unsigned)__builtin_amdgcn_readfirstlane(lds0 + MLA_K0 + (slot) * MLA_KSLOT + 1024 * (wid + 8 * i_))); } while (0)
#define DMA_V(t, slot) do { const int t_ = (t) < NT ? (t) : NT - 1; const char* g_ = (const char*)Vh + (long)t_ * MLA_VSLOT; \
    _Pragma("unroll") for (int i_ = 0; i_ < 2; ++i_) if (!(MODE & 2)) glds16(g_ + vsrc[i_], (unsigned)__builtin_amdgcn_readfirstlane(lds0 + MLA_V0 + (slot) * MLA_VSLOT + 1024 * (2 * wid + i_))); } while (0)
  DMA_K(0, 0); DMA_V(0, 0); DMA_K(1, 1); DMA_V(1, 1); DMA_K(2, 2);
  bf16x8 qr[12];
  { const bf16_t* Qw = Qb + (long)(wid * 32 + r32) * 192 + hi * 8;
#pragma unroll
    for (int d0 = 0; d0 < 12; ++d0) qr[d0] = *(const bf16x8*)(Qw + d0 * 16); }
  float m_reg = -1e30f, l_reg = 0.f; f32x16 o[4] = {};
  const int vb0 = (int)(lds0 + MLA_V0) + v_rd_base(lane);
  f32x16 pA0, pA1, pB0, pB1; float mnA, mnB, alA, alB; bf16x8 pa0, pa1, pa2, pa3;
#define RESC(a) do { if (__any((a) < 1.f)) { if (hi == 0) al_l[r32] = (a); asm volatile("s_waitcnt lgkmcnt(0)" ::: "memory"); \
    _Pragma("unroll") for (int d = 0; d < 4; ++d) _Pragma("unroll") for (int r = 0; r < 16; ++r) o[d][r] *= al_l[crow(r, hi)]; } } while (0)
  WAIT_BAR(0);
  if (wid >= 4) __builtin_amdgcn_s_setprio(1);
  qkt<192, MLA_LA>(pA0, pA1, lds + MLA_K0, qr, r32, hi); partialSM<1>(pA0, pA1, m_reg, mnA, alA, C, thr_raw);
  WAIT_BAR(0);
  int s_m1 = 0, s_0 = 1, s_p1 = 2;
#define ROT() do { const int t_ = s_m1; s_m1 = s_0; s_0 = s_p1; s_p1 = t_; } while (0)
#define STEP(X0, X1, mnX, alX, Y0, Y1, alY, j) do { \
    SBAR(); qkt<192, MLA_LA>(X0, X1, lds + MLA_K0 + s_0 * MLA_KSLOT, qr, r32, hi); \
    if (MODE & 1) { pa0 = __builtin_bit_cast(bf16x8, (u32x4){__float_as_uint(Y0[0]), __float_as_uint(Y0[1]), __float_as_uint(Y0[2]), __float_as_uint(Y0[3])}); pa1 = __builtin_bit_cast(bf16x8, (u32x4){__float_as_uint(Y0[4]), __float_as_uint(Y0[5]), __float_as_uint(Y0[6]), __float_as_uint(Y0[7])}); \
      pa2 = __builtin_bit_cast(bf16x8, (u32x4){__float_as_uint(Y1[0]), __float_as_uint(Y1[1]), __float_as_uint(Y1[2]), __float_as_uint(Y1[3])}); pa3 = __builtin_bit_cast(bf16x8, (u32x4){__float_as_uint(Y1[4]), __float_as_uint(Y1[5]), __float_as_uint(Y1[6]), __float_as_uint(Y1[7])}); } \
    else finishSM(Y0, Y1, alY, l_reg, pa0, pa1, pa2, pa3); SBAR(); \
    DMA_K((j) + 2, s_m1); SBAR(); \
    pv_d0(o, vb0 + s_m1 * MLA_VSLOT, pa0, pa1, pa2, pa3); if (MODE & 1) { alX = 1.f; } else partialSM<1>(X0, X1, m_reg, mnX, alX, C, thr_raw); SBAR(); \
    DMA_V((j) + 1, s_p1); \
    WAIT_BAR2(6, 5); RESC(alX); ROT(); } while (0)
  for (int j = 1; j + 1 < NT; j += 2) {
    STEP(pB0, pB1, mnB, alB, pA0, pA1, alA, j);
    STEP(pA0, pA1, mnA, alA, pB0, pB1, alB, j + 1);
  }
  STEP(pB0, pB1, mnB, alB, pA0, pA1, alA, NT - 1);
  finishSM(pB0, pB1, alB, l_reg, pa0, pa1, pa2, pa3); SBAR();
  pv_d0(o, vb0 + s_m1 * MLA_VSLOT, pa0, pa1, pa2, pa3);
  __builtin_amdgcn_s_setprio(0);
  (void)mnA; (void)mnB;
#undef STEP
#undef ROT
#undef RESC
#undef DMA_K
#undef DMA_V
  if (hi == 0) li_l[r32] = l_reg;
  WAIT_BAR(0);
  float rli[16];
#pragma unroll
  for (int r = 0; r < 16; ++r) rli[r] = __builtin_amdgcn_rcpf(li_l[crow(r, hi)]);
  ATT_LAS bf16_t* stg = (ATT_LAS bf16_t*)(lds + MLA_K0) + wid * 4096;
#pragma unroll
  for (int r = 0; r < 16; ++r) { const int orow = crow(r, hi);
#pragma unroll
    for (int d0 = 0; d0 < 4; ++d0) stg[orow * 128 + d0 * 32 + r32] = f2bf(o[d0][r] * rli[r]); }
  asm volatile("s_waitcnt lgkmcnt(0)" ::: "memory");
  bf16_t* Ow = Ob + (long)(wid * 32) * ldo;
#pragma unroll
  for (int i = 0; i < 8; ++i) { const int row = i * 4 + (lane >> 4), ch = lane & 15; const u32x4 v = *(const ATT_LAS u32x4*)(stg + row * 128 + ch * 8); if (do_store) *(u32x4*)(Ow + (long)row * ldo + ch * 8) = v; }
  WAIT_BAR(0);
}

__device__ __forceinline__ void mla_unit_stag(const bf16_t* Qb, const bf16_t* Kh, const bf16_t* Vh, bf16_t* Ob, long ldo, int NT, float scale, ATT_LAS char* lds, int wave_s) {
  int tid_l = wave_s * 64 + mk_lane(); asm volatile("" : "+v"(tid_l));
  const int tid = tid_l, wid = __builtin_amdgcn_readfirstlane(tid >> 6), lane = tid & 63, r32 = lane & 31, hi = lane >> 5;
  const unsigned lds0 = (unsigned)(uintptr_t)lds;
  ATT_LAS float* wsf = (ATT_LAS float*)(lds + MLA_WS) + wid * 64; ATT_LAS float* li_l = wsf; ATT_LAS float* al_l = wsf + 32;
  const float C = scale * 1.4426950408889634f, thr_raw = 8.0f / scale;
  int ksrc[4], vsrc[2];
#pragma unroll
  for (int i = 0; i < 4; ++i) { const int gch = 64 * (wid + 8 * i) + lane, row = gch / 25, cc = gch % 25; ksrc[i] = row * 384 + (cc < 24 ? cc * 16 : 0); }
#pragma unroll
  for (int i = 0; i < 2; ++i) { const int B = 1024 * (2 * wid + i) + 16 * lane, sub = B >> 9, e = (B & 511) >> 1, kk = (sub >> 2) * 8 + (e >> 5), c = (sub & 3) * 32 + (e & 31);
    const int k = (kk & ~0xC) | ((kk & 4) << 1) | ((kk & 8) >> 1); vsrc[i] = (k * 128 + c) * 2; }
#define DMA_K(t, slot) do { const int t_ = (t) < NT ? (t) : NT - 1; const char* g_ = (const char*)Kh + (long)t_ * MLA_KTILE; \
    _Pragma("unroll") for (int i_ = 0; i_ < 4; ++i_) if (i_ < 3 || wid == 0) glds16(g_ + ksrc[i_], (unsigned)__builtin_amdgcn_readfirstlane(lds0 + MLA_K0 + (slot) * MLA_KSLOT + 1024 * (wid + 8 * i_))); } while (0)
#define DMA_V(t, slot) do { const int t_ = (t) < NT ? (t) : NT - 1; const char* g_ = (const char*)Vh + (long)t_ * MLA_VSLOT; \
    _Pragma("unroll") for (int i_ = 0; i_ < 2; ++i_) glds16(g_ + vsrc[i_], (unsigned)__builtin_amdgcn_readfirstlane(lds0 + MLA_V0 + (slot) * MLA_VSLOT + 1024 * (2 * wid + i_))); } while (0)
  DMA_K(0, 0); DMA_V(0, 0); DMA_K(1, 1); DMA_V(1, 1); DMA_K(2, 2);
  bf16x8 qr[12];
  { const bf16_t* Qw = Qb + (long)(wid * 32 + r32) * 192 + hi * 8;
#pragma unroll
    for (int d0 = 0; d0 < 12; ++d0) qr[d0] = *(const bf16x8*)(Qw + d0 * 16); }
  float m_reg = -1e30f, l_reg = 0.f; f32x16 o[4] = {};
  const int vb0 = (int)(lds0 + MLA_V0) + v_rd_base(lane);
  f32x16 pA0, pA1, pB0, pB1; float mnA, mnB, alA, alB; bf16x8 pa0, pa1, pa2, pa3;
#define RESC(a) do { if (__any((a) < 1.f)) { if (hi == 0) al_l[r32] = (a); asm volatile("s_waitcnt lgkmcnt(0)" ::: "memory"); \
    _Pragma("unroll") for (int d = 0; d < 4; ++d) _Pragma("unroll") for (int r = 0; r < 16; ++r) o[d][r] *= al_l[crow(r, hi)]; } } while (0)
  WAIT_BAR(0);
  int s_m1 = 0, s_0 = 1, s_p1 = 2;
#define ROT() do { const int t_ = s_m1; s_m1 = s_0; s_0 = s_p1; s_p1 = t_; } while (0)
#define STEPA(X0, X1, mnX, alX, Y0, Y1, alY, j) do { \
    SBAR(); qkt<192, MLA_LA>(X0, X1, lds + MLA_K0 + s_0 * MLA_KSLOT, qr, r32, hi); \
    finishSM(Y0, Y1, alY, l_reg, pa0, pa1, pa2, pa3); SBAR(); \
    DMA_K((j) + 2, s_m1); SBAR(); \
    pv_d0(o, vb0 + s_m1 * MLA_VSLOT, pa0, pa1, pa2, pa3); partialSM<1>(X0, X1, m_reg, mnX, alX, C, thr_raw); SBAR(); \
    DMA_V((j) + 1, s_p1); \
    WAIT_BAR2(6, 5); RESC(alX); ROT(); } while (0)
#define STEPB(X0, X1, Y0, Y1, j) do { float mnY_, alY_; \
    SBAR(); partialSM<1>(Y0, Y1, m_reg, mnY_, alY_, C, thr_raw); (void)mnY_; RESC(alY_); \
    finishSM(Y0, Y1, alY_, l_reg, pa0, pa1, pa2, pa3); SBAR(); \
    DMA_K((j) + 2, s_m1); SBAR(); \
    pv_d0(o, vb0 + s_m1 * MLA_VSLOT, pa0, pa1, pa2, pa3); SBAR(); \
    qkt<192, MLA_LA>(X0, X1, lds + MLA_K0 + s_0 * MLA_KSLOT, qr, r32, hi); SBAR(); \
    DMA_V((j) + 1, s_p1); \
    WAIT_BAR2(6, 5); ROT(); } while (0)
  if (wid < 4) {
    qkt<192, MLA_LA>(pA0, pA1, lds + MLA_K0, qr, r32, hi); partialSM<1>(pA0, pA1, m_reg, mnA, alA, C, thr_raw);
    WAIT_BAR(0);
    for (int j = 1; j + 1 < NT; j += 2) {
      STEPA(pB0, pB1, mnB, alB, pA0, pA1, alA, j);
      STEPA(pA0, pA1, mnA, alA, pB0, pB1, alB, j + 1);
    }
    STEPA(pB0, pB1, mnB, alB, pA0, pA1, alA, NT - 1);
    finishSM(pB0, pB1, alB, l_reg, pa0, pa1, pa2, pa3); SBAR();
    pv_d0(o, vb0 + s_m1 * MLA_VSLOT, pa0, pa1, pa2, pa3);
  } else {
    __builtin_amdgcn_s_setprio(1);
    qkt<192, MLA_LA>(pA0, pA1, lds + MLA_K0, qr, r32, hi);
    WAIT_BAR(0);
    for (int j = 1; j + 1 < NT; j += 2) {
      STEPB(pB0, pB1, pA0, pA1, j);
      STEPB(pA0, pA1, pB0, pB1, j + 1);
    }
    STEPB(pB0, pB1, pA0, pA1, NT - 1);
    partialSM<1>(pB0, pB1, m_reg, mnB, alB, C, thr_raw); RESC(alB);
    finishSM(pB0, pB1, alB, l_reg, pa0, pa1, pa2, pa3); SBAR();
    pv_d0(o, vb0 + s_m1 * MLA_VSLOT, pa0, pa1, pa2, pa3);
  }
#undef STEPA
#undef STEPB
  __builtin_amdgcn_s_setprio(0);
  (void)mnA; (void)mnB;
#undef ROT
#undef RESC
#undef DMA_K
#undef DMA_V
  if (hi == 0) li_l[r32] = l_reg;
  WAIT_BAR(0);
  float rli[16];
#pragma unroll
  for (int r = 0; r < 16; ++r) rli[r] = __builtin_amdgcn_rcpf(li_l[crow(r, hi)]);
  ATT_LAS bf16_t* stg = (ATT_LAS bf16_t*)(lds + MLA_K0) + wid * 4096;
#pragma unroll
  for (int r = 0; r < 16; ++r) { const int orow = crow(r, hi);
#pragma unroll
    for (int d0 = 0; d0 < 4; ++d0) stg[orow * 128 + d0 * 32 + r32] = f2bf(o[d0][r] * rli[r]); }
  asm volatile("s_waitcnt lgkmcnt(0)" ::: "memory");
  bf16_t* Ow = Ob + (long)(wid * 32) * ldo;
#pragma unroll
  for (int i = 0; i < 8; ++i) { const int row = i * 4 + (lane >> 4), ch = lane & 15; const u32x4 v = *(const ATT_LAS u32x4*)(stg + row * 128 + ch * 8); *(u32x4*)(Ow + (long)row * ldo + ch * 8) = v; }
  WAIT_BAR(0);
}

__device__ __forceinline__ void mla_unit_pp(const bf16_t* Qb, const bf16_t* Kh, const bf16_t* Vh, bf16_t* Ob, long ldo, int NT, float scale, ATT_LAS char* lds, int wave_s) {
  int tid_l = wave_s * 64 + mk_lane(); asm volatile("" : "+v"(tid_l));
  const int tid = tid_l, wid = __builtin_amdgcn_readfirstlane(tid >> 6), lane = tid & 63, r32 = lane & 31, hi = lane >> 5;
  const bool H1 = wid >= 4;
  const unsigned lds0 = (unsigned)(uintptr_t)lds;
  ATT_LAS float* wsf = (ATT_LAS float*)(lds + MLA_WS) + wid * 64; ATT_LAS float* li_l = wsf; ATT_LAS float* al_l = wsf + 32;
  (void)scale;
  int ksrc[4], vsrc[2];
#pragma unroll
  for (int i = 0; i < 4; ++i) { const int gch = 64 * (wid + 8 * i) + lane, row = gch / 25, cc = gch % 25; ksrc[i] = row * 384 + (cc < 24 ? cc * 16 : 0); }
#pragma unroll
  for (int i = 0; i < 2; ++i) { const int B = 1024 * (2 * wid + i) + 16 * lane, sub = B >> 9, e = (B & 511) >> 1, kk = (sub >> 2) * 8 + (e >> 5), c = (sub & 3) * 32 + (e & 31);
    const int k = (kk & ~0xC) | ((kk & 4) << 1) | ((kk & 8) >> 1); vsrc[i] = (k * 128 + c) * 2; }
#define DMA_T(t, slot) do { const int t_ = (t) < NT ? (t) : NT - 1; const char* gk_ = (const char*)Kh + (long)t_ * MLA_KTILE; const char* gv_ = (const char*)Vh + (long)t_ * MLA_VSLOT; \
    _Pragma("unroll") for (int i_ = 0; i_ < 4; ++i_) if (i_ < 3 || wid == 0) glds16(gk_ + ksrc[i_], (unsigned)__builtin_amdgcn_readfirstlane(lds0 + MLA_K0 + (slot) * MLA_KSLOT + 1024 * (wid + 8 * i_))); \
    _Pragma("unroll") for (int i_ = 0; i_ < 2; ++i_) glds16(gv_ + vsrc[i_], (unsigned)__builtin_amdgcn_readfirstlane(lds0 + MLA_V0 + (slot) * MLA_VSLOT + 1024 * (2 * wid + i_))); } while (0)
  DMA_T(0, 0); DMA_T(1, 1);
  bf16x8 qr[12];
  { const bf16_t* Qw = Qb + (long)(wid * 32 + r32) * 192 + hi * 8;
#pragma unroll
    for (int d0 = 0; d0 < 12; ++d0) qr[d0] = *(const bf16x8*)(Qw + d0 * 16); }
  float mref = 0.f, l_reg = 0.f; f32x16 o[4] = {}; f32x16 negm = {};
  const float thr2 = 8.0f * 1.4426950408889634f;
  const int vb0 = (int)(lds0 + MLA_V0) + v_rd_base(lane);
  WAIT_BAR(0);
  if (H1) WAIT_BAR2(6, 5);
  int s_0 = 0, s_2 = 2;
  for (int j = 0; j < NT; ++j) {
    if (H1) DMA_T(j + 2, s_2);
    f32x16 p0, p1; float alpha;
    SBAR(); __builtin_amdgcn_s_setprio(1);
    qkt_c<192, MLA_PP_LA>(p0, p1, lds + MLA_K0 + s_0 * MLA_KSLOT, qr, r32, hi, negm);
    __builtin_amdgcn_s_setprio(0);
    partialSM_ref(p0, p1, mref, negm, alpha, thr2, j == 0, (j & 7) == 0);
    WAIT_BAR2(6, 5);
    if (!H1) DMA_T(j + 2, s_2);
    bf16x8 pa0, pa1, pa2, pa3; finishSM_np(p0, p1, alpha, l_reg, pa0, pa1, pa2, pa3);
    if (__any(alpha < 1.f)) { if (hi == 0) al_l[r32] = alpha; asm volatile("s_waitcnt lgkmcnt(0)" ::: "memory");
#pragma unroll
      for (int d = 0; d < 4; ++d)
#pragma unroll
        for (int r = 0; r < 16; ++r) o[d][r] *= al_l[crow(r, hi)]; }
    SBAR(); __builtin_amdgcn_s_setprio(1);
    pv_d0_la(o, vb0 + s_0 * MLA_VSLOT, pa0, pa1, pa2, pa3);
    __builtin_amdgcn_s_setprio(0);
    WAIT_BAR2(6, 5);
    s_2 = s_0; s_0 = (s_0 == 2) ? 0 : s_0 + 1;
  }
  if (!H1) WAIT_BAR2(6, 5);
#undef DMA_T
  if (hi == 0) li_l[r32] = l_reg;
  WAIT_BAR(0);
  float rli[16];
#pragma unroll
  for (int r = 0; r < 16; ++r) rli[r] = __builtin_amdgcn_rcpf(li_l[crow(r, hi)]);
  ATT_LAS bf16_t* stg = (ATT_LAS bf16_t*)(lds + MLA_K0) + wid * 4096;
#pragma unroll
  for (int r = 0; r < 16; ++r) { const int orow = crow(r, hi);
#pragma unroll
    for (int d0 = 0; d0 < 4; ++d0) stg[orow * 128 + d0 * 32 + r32] = f2bf(o[d0][r] * rli[r]); }
  asm volatile("s_waitcnt lgkmcnt(0)" ::: "memory");
  bf16_t* Ow = Ob + (long)(wid * 32) * ldo;
#pragma unroll
  for (int i = 0; i < 8; ++i) { const int row = i * 4 + (lane >> 4), ch = lane & 15; const u32x4 v = *(const ATT_LAS u32x4*)(stg + row * 128 + ch * 8); *(u32x4*)(Ow + (long)row * ldo + ch * 8) = v; }
  WAIT_BAR(0);
}

constexpr int DIL_KB = 64 * 272, DIL_SLOT = DIL_KB + 16384, DIL_WS = 3 * DIL_SLOT, DIL_STG = DIL_WS + 8 * 256, DIL_LDS = DIL_STG + 8 * 4096;
__device__ __forceinline__ void dil_unit(const bf16_t* Qs, const bf16_t* Ks, const bf16_t* Vs, bf16_t* Os, float* lses, long ld, long ldl, int qb_first, int nqb, int L64, float scale, ATT_LAS char* lds, int wave_s, bool dry = false) {
  int tid_l = wave_s * 64 + mk_lane(); asm volatile("" : "+v"(tid_l));
  const int tid = tid_l, wid = __builtin_amdgcn_readfirstlane(tid >> 6), lane = tid & 63, r32 = lane & 31, hi = lane >> 5, pair = wid >> 1, sub = wid & 1;
  const unsigned lds0 = (unsigned)(uintptr_t)lds;
  ATT_LAS float* wsf = (ATT_LAS float*)(lds + DIL_WS) + wid * 64; ATT_LAS float* li_l = wsf; ATT_LAS float* al_l = wsf + 32;
  ATT_LAS bf16_t* stg = (ATT_LAS bf16_t*)(lds + DIL_STG) + wid * 2048;
  const float C = scale * 1.4426950408889634f, thr_raw = 8.0f / scale;
  const int kt_lo = qb_first > 0 ? qb_first - 1 : 0, qb_end = qb_first + nqb, kt_hi = qb_end + 1 < L64 ? qb_end + 1 : L64;
  const long ld2 = ld * 2, ts = 64 * ld2;
  long koff[3], voff[2];
#pragma unroll
  for (int i = 0; i < 3; ++i) { const int gch = 64 * (wid + 8 * i) + lane, row = gch / 17, cc = gch % 17; koff[i] = row * ld2 + (cc < 16 ? cc * 16 : 0); }
#pragma unroll
  for (int i = 0; i < 2; ++i) { const int B = 1024 * (2 * wid + i) + 16 * lane, sb = B >> 9, e = (B & 511) >> 1, kk = (sb >> 2) * 8 + (e >> 5), c = (sb & 3) * 32 + (e & 31);
    const int k = (kk & ~0xC) | ((kk & 4) << 1) | ((kk & 8) >> 1); voff[i] = k * ld2 + c * 2; }
#define DMA_T(t, slot) do { const int t_ = (t) < kt_hi ? (t) : kt_hi - 1; const char* gk_ = (const char*)Ks + t_ * ts; const char* gv_ = (const char*)Vs + t_ * ts; \
    _Pragma("unroll") for (int i_ = 0; i_ < 3; ++i_) if (i_ < 2 || wid == 0) glds16(gk_ + koff[i_], (unsigned)__builtin_amdgcn_readfirstlane(lds0 + (slot) * DIL_SLOT + 1024 * (wid + 8 * i_))); \
    _Pragma("unroll") for (int i_ = 0; i_ < 2; ++i_) glds16(gv_ + voff[i_], (unsigned)__builtin_amdgcn_readfirstlane(lds0 + (slot) * DIL_SLOT + DIL_KB + 1024 * (2 * wid + i_))); } while (0)
  DMA_T(kt_lo, 0); DMA_T(kt_lo + 1, 1);
  int qb = qb_first + pair; bool have = qb < qb_end;
  bf16x8 qr[8];
#define QLOAD() do { const bf16_t* Qw_ = Qs + (long)(qb * 64 + sub * 32 + r32) * ld + hi * 8; \
    _Pragma("unroll") for (int d0 = 0; d0 < 8; ++d0) qr[d0] = *(const bf16x8*)(Qw_ + d0 * 16); } while (0)
#define QPIN() do { _Pragma("unroll") for (int d0 = 0; d0 < 8; ++d0) asm volatile("" : "+v"(qr[d0])); } while (0)
  if (have) QLOAD();
  float m_reg = -1e30f, l_reg = 0.f; f32x16 o[4] = {};
  const int qi = sub * 32 + r32;
  const int vb0 = (int)lds0 + DIL_KB + v_rd_base(lane);
#define BLOCK_EPI() do { if (hi == 0) li_l[r32] = l_reg; asm volatile("s_waitcnt lgkmcnt(0)" ::: "memory"); \
    float rli[16]; _Pragma("unroll") for (int r = 0; r < 16; ++r) rli[r] = __builtin_amdgcn_rcpf(li_l[crow(r, hi)]); \
    bf16_t* Ow_ = Os + (long)(qb * 64 + sub * 32) * ld; \
    _Pragma("unroll") for (int hf = 0; hf < 2; ++hf) { \
      _Pragma("unroll") for (int r = 0; r < 16; ++r) { const int orow = crow(r, hi); \
        _Pragma("unroll") for (int dd = 0; dd < 2; ++dd) stg[orow * 64 + dd * 32 + r32] = f2bf(o[hf * 2 + dd][r] * rli[r]); } \
      asm volatile("s_waitcnt lgkmcnt(0)" ::: "memory"); \
      _Pragma("unroll") for (int i = 0; i < 4; ++i) { const int row = i * 8 + (lane >> 3), ch = lane & 7; const u32x4 v = *(const ATT_LAS u32x4*)(stg + row * 64 + ch * 8); \
        if (!dry) *(u32x4*)(Ow_ + (long)row * ld + hf * 64 + ch * 8) = v; } \
      asm volatile("s_waitcnt lgkmcnt(0)" ::: "memory"); } \
    if (hi == 0 && !dry) lses[(long)(qb * 64 + sub * 32 + r32) * ldl] = m_reg * scale + __logf(l_reg); } while (0)
  WAIT_BAR(0);
  int s_0 = 0, s_1 = 1, s_2 = 2;
  for (int t = kt_lo; t < kt_hi; ++t) {
    if (have && t >= qb - 1 && t <= qb + 1) {
      f32x16 p0, p1; qkt<128>(p0, p1, lds + s_0 * DIL_SLOT, qr, r32, hi);
      if (t == qb - 1) {
#pragma unroll
        for (int r = 0; r < 16; ++r) { const int k0 = crow(r, hi); if (k0 < qi) p0[r] = -1e30f; if (k0 + 32 < qi) p1[r] = -1e30f; }
      } else if (t == qb + 1) {
#pragma unroll
        for (int r = 0; r < 16; ++r) { const int k0 = crow(r, hi); if (k0 > qi) p0[r] = -1e30f; if (k0 + 32 > qi) p1[r] = -1e30f; }
      }
      float mn, alpha; partialSM<1>(p0, p1, m_reg, mn, alpha, C, thr_raw); (void)mn;
      bf16x8 pa0, pa1, pa2, pa3; finishSM(p0, p1, alpha, l_reg, pa0, pa1, pa2, pa3);
      if (__any(alpha < 1.f)) { if (hi == 0) al_l[r32] = alpha; asm volatile("s_waitcnt lgkmcnt(0)" ::: "memory");
#pragma unroll
        for (int d = 0; d < 4; ++d)
#pragma unroll
          for (int r = 0; r < 16; ++r) o[d][r] *= al_l[crow(r, hi)]; }
      pv_d0(o, vb0 + s_0 * DIL_SLOT, pa0, pa1, pa2, pa3);
    } else if (have && t == qb + 2) {
      BLOCK_EPI();
      qb += 4; have = qb < qb_end; m_reg = -1e30f; l_reg = 0.f;
#pragma unroll
      for (int d = 0; d < 4; ++d) o[d] = f32x16{};
      if (have) { QLOAD(); QPIN(); }
    }
    DMA_T(t + 2, s_2);
    WAIT_BAR2(5, 4);
    { const int t_ = s_0; s_0 = s_1; s_1 = s_2; s_2 = t_; }
  }
  if (have) BLOCK_EPI();
  WAIT_BAR(0);
#undef DMA_T
#undef QLOAD
#undef QPIN
#undef BLOCK_EPI
}
#undef WAIT_BAR
#undef SBAR
}

#define LAS __attribute__((address_space(3)))
typedef unsigned short bf16;
typedef float f32x4 __attribute__((ext_vector_type(4)));
typedef unsigned v4u __attribute__((ext_vector_type(4)));
typedef unsigned v2u __attribute__((ext_vector_type(2)));
typedef short bf16x8 __attribute__((ext_vector_type(8)));

constexpr int NWAVES = 8, NTHR = 512;
constexpr int BATCH = 8, SEQ = 8192, DM = 1024, M = BATCH * SEQ, FF = 4096;
#ifndef MK_NCH
#define MK_NCH 4
#endif
constexpr int NCH = MK_NCH, MH = M / NCH, BPC = BATCH / NCH;
constexpr int NQKV = 9216;
constexpr size_t MiB = 1u << 20;
constexpr size_t WS_WQKV = 1 * MiB, WS_WOA = 19 * MiB, WS_W1 = 21 * MiB, WS_W2 = 37 * MiB, WS_WIN = 53 * MiB, WS_WQB = 54 * MiB, WS_WKVB = 55 * MiB, WS_WOB = 56 * MiB;
constexpr size_t WS_COS128 = 58 * MiB, WS_SIN128 = 60 * MiB, WS_COS64 = 62 * MiB, WS_SIN64 = 63 * MiB;
constexpr size_t WS_LSE = 64 * MiB, WS_SSR = 67 * MiB;
constexpr size_t WS_RS = 68 * MiB, WS_RS2 = 70 * MiB;
constexpr size_t WS_HN = 128 * MiB;
constexpr size_t WS_QKVH = 256 * MiB;
constexpr size_t WS_ACT = 256 * MiB;
constexpr size_t WS_CQN = 256 * MiB, WS_CKVN = 288 * MiB, WS_KR = 320 * MiB;
constexpr size_t WS_Q = 384 * MiB, WS_K = 576 * MiB, WS_V = 768 * MiB;
constexpr size_t WS_AO = 896 * MiB;
constexpr size_t WS_END = 1024 * MiB;
constexpr int RING_BYTES = 131072, XCH_OFF = RING_BYTES, LDS_BYTES = 147456;

#define RLX_AGENT __ATOMIC_RELAXED, __HIP_MEMORY_SCOPE_AGENT
#define XB_TMO      128
#define XB_XCNT(j)  (256  + 64 * (j))
#define XB_XSUB(j)  (1280 + 64 * (j))
#define XB_XGEN(j)  (2304 + 64 * (j))
#define XB_TOP      3328
#define XB_TOPGEN   3392
#define XCD_BAR_WORDS 3456
#define XB_SPIN_CAP (1u << 18)

__device__ __forceinline__ unsigned xb_ld(unsigned* p)              { return __hip_atomic_load(p, __ATOMIC_RELAXED, __HIP_MEMORY_SCOPE_AGENT); }
__device__ __forceinline__ unsigned xb_add(unsigned* p, unsigned v) { return __hip_atomic_fetch_add(p, v, __ATOMIC_RELAXED, __HIP_MEMORY_SCOPE_AGENT); }
__device__ __forceinline__ unsigned xb_xcc_id() { return (unsigned)__builtin_amdgcn_s_getreg((3 << 11) | 20) & 0xFu; }
#define XB_SPIN(cond, bar) do { unsigned _sp = 0; while (cond) { __builtin_amdgcn_s_sleep(1); \
    if ((++_sp & 255u) == 0u) { if (xb_ld(&(bar)[XB_TMO])) break; if (_sp > XB_SPIN_CAP) { atomicAdd(&(bar)[XB_TMO], 1u); break; } } } } while (0)

struct XcdBarrier {
    unsigned* bar; unsigned x; int wave;
    volatile LAS unsigned* st;
};

__device__ __forceinline__ XcdBarrier xcd_barrier_post(unsigned* bar, volatile LAS unsigned* st, int wave_s) {
    XcdBarrier b; b.bar = bar; b.x = xb_xcc_id(); b.st = st; b.wave = wave_s;
    if (wave_s == 0 && mk_lane() == 0) (void)xb_add(&bar[XB_XCNT(b.x)], 1u);
    return b;
}
__device__ __forceinline__ void xcd_barrier_complete(unsigned* bar, unsigned x, unsigned& nloc, unsigned& nx) {
    const unsigned G = gridDim.x * gridDim.y * gridDim.z;
    unsigned sum, cnt, mine, sp = 0u;
    for (;;) {
        sum = 0u; cnt = 0u; mine = 0u;
#pragma unroll
        for (unsigned j = 0; j < 16; ++j) { const unsigned c = xb_ld(&bar[XB_XCNT(j)]); sum += c; cnt += (c > 0u) ? 1u : 0u; mine = (j == x) ? c : mine; }
        if (sum == G) break;
        __builtin_amdgcn_s_sleep(1);
        if ((++sp & 255u) == 0u) { if (xb_ld(&bar[XB_TMO])) break; if (sp > XB_SPIN_CAP) { atomicAdd(&bar[XB_TMO], 1u); break; } }
    }
    nloc = mine > 0u ? mine : 1u; nx = cnt > 0u ? cnt : 1u;
}

__device__ __forceinline__ void xcd_barrier(const XcdBarrier& b) {
    asm volatile("s_waitcnt vmcnt(0)" ::: "memory");
    __syncthreads();
    if (b.wave == 0 && mk_lane() == 0) {
        unsigned* bar = b.bar;
        __builtin_amdgcn_s_waitcnt(0);
        unsigned nloc = b.st[0], nx = b.st[1];
        if (nloc == 0u) { xcd_barrier_complete(bar, b.x, nloc, nx); b.st[0] = nloc; b.st[1] = nx; }
        const unsigned old = xb_add(&bar[XB_XSUB(b.x)], 1u);
        const unsigned gen = old / nloc;
        if (old + 1u == (gen + 1u) * nloc) {
            __builtin_amdgcn_fence(__ATOMIC_RELEASE, "agent");
            asm volatile("s_waitcnt vmcnt(0)" ::: "memory");
            const unsigned og = xb_add(&bar[XB_TOP], 1u);
            const unsigned tg = og / nx;
            if (og + 1u == (tg + 1u) * nx) xb_add(&bar[XB_TOPGEN], 1u);
            else XB_SPIN(xb_ld(&bar[XB_TOPGEN]) == tg, bar);
            __builtin_amdgcn_fence(__ATOMIC_ACQUIRE, "agent");
            xb_add(&bar[XB_XGEN(b.x)], 1u);
            asm volatile("s_waitcnt vmcnt(0)" ::: "memory");
        } else {
            XB_SPIN(xb_ld(&bar[XB_XGEN(b.x)]) == gen, bar);
            __builtin_amdgcn_fence(__ATOMIC_ACQUIRE, "agent");
            asm volatile("s_waitcnt vmcnt(0)" ::: "memory");
        }
    }
    __syncthreads();
}

constexpr size_t WS_BAR = 0, BAR_ZERO_BYTES = 16384;

#ifndef STAG_SLEEPS
#define STAG_SLEEPS 1
#endif
__device__ __forceinline__ void stagger(int bx) { if (STAG_SLEEPS > 0) for (int i = 0; i < bx; ++i) __builtin_amdgcn_s_sleep(STAG_SLEEPS); }
__device__ __forceinline__ unsigned char* ws_fresh(unsigned char* w) { asm volatile("" : "+s"(w)); return w; }
struct Params {
  const float* x; const float* norm_mix; const float* norm_ffn; const float* a_w_qkv; const float* a_q_gain; const float* a_k_gain; const float* a_w_o;
  const float* b_w_in; const float* b_q_a_gain; const float* b_w_qb; const float* b_kv_a_gain; const float* b_w_kvb; const float* b_q_gain; const float* b_k_gain; const float* b_w_o;
  const float* ffn_w1; const float* ffn_w2; float* out; unsigned char* ws;
};

__device__ __forceinline__ unsigned f2bf_rne(float f) { unsigned u = __builtin_bit_cast(unsigned, f); return (u + 0x7fffu + ((u >> 16) & 1u)) >> 16; }
__device__ __forceinline__ unsigned pk2(float lo, float hi) { return f2bf_rne(lo) | (f2bf_rne(hi) << 16); }
__device__ __forceinline__ float wave_sum(float v) {
#pragma unroll
  for (int o = 1; o < 64; o <<= 1) v += __shfl_xor(v, o);
  return v;
}
__device__ __forceinline__ int rope_perm128(int p) { const int wc = p >> 5, fq = (p >> 3) & 3, n = (p >> 2) & 1, j = p & 3; return 16 * wc + 4 * fq + j + 64 * n; }
__device__ __forceinline__ int rope_perm64(int p) { const int wc = p >> 5, fq = (p >> 3) & 3, n = (p >> 2) & 1, j = p & 3; return wc >= 2 ? -1 : 16 * wc + 4 * fq + j + 32 * n; }
template <int MAP> __device__ __forceinline__ int src_col(int n) {
  if (MAP == 1) { if (n >= 6144) return n; const int p = n & 255, bj = p >> 7, pp = p & 127; return (n - p) + (pp >> 6) * 128 + (pp & 63) + 64 * bj; }
  if (MAP == 2) { if (n < 384) return n; const int q = rope_perm64(n - 384); return q < 0 ? -1 : 384 + q; }
  if (MAP == 3) { const int h = n >> 8, p = n & 255; if (p < 128) return h * 192 + p; const int q = rope_perm64(p - 128); return q < 0 ? -1 : h * 192 + 128 + q; }
  if (MAP == 4) { const int p = n & 255, bj = p >> 7, wc = (p >> 5) & 3, i = p & 31; return (n - p) + wc * 64 + bj * 32 + i; }
  return n;
}
template <int MAP> __device__ __forceinline__ void wt_convert(const float* W, int Klog, int Nlog, int Kphys, int Nphys, bf16* WT, int gw, int NGW, int lane, const float* gain = nullptr) {
  const int nkb = Kphys / 8, nnb = Nphys / 64;
#pragma unroll 4
  for (int it = gw; it < nkb * nnb; it += NGW) {
    const int nb = it % nnb, kb = it / nnb, n = nb * 64 + lane, src = src_col<MAP>(n), k0 = kb * 8;
    float v[8];
#pragma unroll
    for (int i = 0; i < 8; ++i) v[i] = (src >= 0 && k0 + i < Klog) ? W[(size_t)(k0 + i) * Nlog + src] : 0.f;
    if (gain != nullptr) {
#pragma unroll
      for (int i = 0; i < 8; ++i) v[i] *= gain[k0 + i]; }
    v4u o; o.x = pk2(v[0], v[1]); o.y = pk2(v[2], v[3]); o.z = pk2(v[4], v[5]); o.w = pk2(v[6], v[7]);
    *(v4u*)(WT + (size_t)n * Kphys + k0) = o;
  }
}
__device__ __forceinline__ void rope_table(float* cosT, float* sinT, int half_d, int gtid, int NGT, bool as_half = false) {
  for (int id = gtid; id < SEQ * half_d; id += NGT) {
    const int pos = id / half_d, i = id % half_d;
    const float freq = powf(10000.0f, -(float)i / (float)half_d);
    const float angf = (float)pos * freq;
    const double a = (double)angf, k = rint(a * 0.15915494309189535), red = a - k * 6.283185307179586;
    const float r = (float)red;
    if (as_half) { ((_Float16*)cosT)[id] = (_Float16)cosf(r); ((_Float16*)sinT)[id] = (_Float16)sinf(r); } else { cosT[id] = cosf(r); sinT[id] = sinf(r); }
  }
}
__device__ __forceinline__ void xb_rows(const float* src, bf16* dst, float* rs, int gw, int NGW, int lane) {
#pragma unroll 4
  for (int row = gw; row < M; row += NGW) {
    const f32x4* xr = (const f32x4*)(src + (size_t)row * DM) + lane;
    f32x4 v[4]; float s = 0.f;
#pragma unroll
    for (int j = 0; j < 4; ++j) { v[j] = xr[64 * j]; s += (v[j][0] * v[j][0] + v[j][1] * v[j][1]) + (v[j][2] * v[j][2] + v[j][3] * v[j][3]); }
    s = wave_sum(s);
    v2u* o8 = (v2u*)(dst + (size_t)row * DM) + lane;
#pragma unroll
    for (int j = 0; j < 4; ++j) { v2u w; w.x = pk2(v[j][0], v[j][1]); w.y = pk2(v[j][2], v[j][3]); o8[64 * j] = w; }
    if (lane < 4) rs[(size_t)row * 4 + lane] = lane == 0 ? s : 0.f;
  }
}
__device__ __forceinline__ void merge_half(const bf16* qkvh, const float* lse, bf16* ao_half, int gtid, int NGT) {
  for (int id = gtid; id < MH * 128; id += NGT) {
    const int tok = id >> 7, c8 = id & 127, h = c8 >> 4;
    const float l0 = lse[((size_t)0 * MH + tok) * 8 + h], l1 = lse[((size_t)1 * MH + tok) * 8 + h], l2 = lse[((size_t)2 * MH + tok) * 8 + h];
    const float mx = fmaxf(l0, fmaxf(l1, l2));
    float w0 = __expf(l0 - mx), w1 = __expf(l1 - mx), w2 = __expf(l2 - mx);
    const float inv = 1.0f / (w0 + w1 + w2); w0 *= inv; w1 *= inv; w2 *= inv;
    const bf16* p = qkvh + (size_t)tok * NQKV + c8 * 8;
    const v4u a = *(const v4u*)p, b = *(const v4u*)(p + 1024), c = *(const v4u*)(p + 2048);
    v4u o;
#pragma unroll
    for (int e = 0; e < 4; ++e) {
      const float alo = __uint_as_float(a[e] << 16), ahi = __uint_as_float(a[e] & 0xffff0000u);
      const float blo = __uint_as_float(b[e] << 16), bhi = __uint_as_float(b[e] & 0xffff0000u);
      const float clo = __uint_as_float(c[e] << 16), chi = __uint_as_float(c[e] & 0xffff0000u);
      o[e] = pk2(w0 * alo + w1 * blo + w2 * clo, w0 * ahi + w1 * bhi + w2 * chi);
    }
    *(v4u*)(ao_half + (size_t)tok * DM + c8 * 8) = o;
  }
}

__global__ void __launch_bounds__(NTHR) fwd_megakernel(Params p) {
  extern __shared__ __attribute__((aligned(16))) unsigned char lds_raw[];
  cg::grid_group grid = cg::this_grid();
  LAS unsigned char* lds = (LAS unsigned char*)lds_raw;
  LAS float* XP = (LAS float*)(lds + XCH_OFF);
  const int G = gridDim.x, bx = blockIdx.x, NGW = G * NWAVES, NGT = G * NTHR;
  volatile LAS unsigned* bst = (volatile LAS unsigned*)(lds + XCH_OFF + 8192);
  const int wave_s = __builtin_amdgcn_readfirstlane((int)threadIdx.x >> 6);
  if (wave_s == 0 && mk_lane() < 4) bst[mk_lane()] = 0u;
  __syncthreads();
  XcdBarrier xbar = xcd_barrier_post((unsigned*)(p.ws + WS_BAR), bst, wave_s);
#define GRID_BAR() xcd_barrier(xbar)
#define FRESH_IDS() int tid_f = wave_s * 64 + mk_lane(); asm volatile("" : "+v"(tid_f)); const int lane = tid_f & 63, gw = bx * NWAVES + wave_s, gtid = bx * NTHR + tid_f; (void)lane; (void)gw; (void)gtid
  unsigned char* ws = p.ws;
  bf16* WQKV = (bf16*)(ws + WS_WQKV); bf16* WOA = (bf16*)(ws + WS_WOA); bf16* W1 = (bf16*)(ws + WS_W1); bf16* W2 = (bf16*)(ws + WS_W2);
  bf16* WIN = (bf16*)(ws + WS_WIN); bf16* WQB = (bf16*)(ws + WS_WQB); bf16* WKVB = (bf16*)(ws + WS_WKVB); bf16* WOB = (bf16*)(ws + WS_WOB);
  float* COS128 = (float*)(ws + WS_COS128); float* SIN128 = (float*)(ws + WS_SIN128); float* COS64 = (float*)(ws + WS_COS64); float* SIN64 = (float*)(ws + WS_SIN64);
  float* LSE = (float*)(ws + WS_LSE); float* SSR = (float*)(ws + WS_SSR);
  bf16* HN = (bf16*)(ws + WS_HN); float* RS = (float*)(ws + WS_RS); float* RS2 = (float*)(ws + WS_RS2); bf16* QKVH = (bf16*)(ws + WS_QKVH); bf16* ACT = (bf16*)(ws + WS_ACT);
  bf16* CQN = (bf16*)(ws + WS_CQN); bf16* CKVN = (bf16*)(ws + WS_CKVN); float* KR = (float*)(ws + WS_KR);
  bf16* QB = (bf16*)(ws + WS_Q); bf16* KB = (bf16*)(ws + WS_K); bf16* VB = (bf16*)(ws + WS_V); bf16* AO = (bf16*)(ws + WS_AO);

#ifndef SEL
#define SEL 0xffff
#endif
#ifndef PROBE_EW_REPS
#define PROBE_EW_REPS 1
#endif
#ifndef PROBE_GEMM_REPS
#define PROBE_GEMM_REPS 1
#endif
#if SEL & 1
  for (int rep_ = 0; rep_ < PROBE_EW_REPS; ++rep_)
  { FRESH_IDS();
  wt_convert<1>(p.a_w_qkv, DM, NQKV, DM, NQKV, WQKV, gw, NGW, lane, p.norm_mix);
  wt_convert<0>(p.a_w_o, DM, DM, DM, DM, WOA, gw, NGW, lane);
  wt_convert<0>(p.ffn_w1, DM, FF, DM, FF, W1, gw, NGW, lane, p.norm_ffn);
  wt_convert<0>(p.ffn_w1 + (size_t)DM * FF, DM, FF, DM, FF, W1 + (size_t)DM * FF, gw, NGW, lane, p.norm_ffn + DM);
  wt_convert<0>(p.ffn_w2, FF, DM, FF, DM, W2, gw, NGW, lane);
  wt_convert<0>(p.ffn_w2 + (size_t)DM * FF, FF, DM, FF, DM, W2 + (size_t)DM * FF, gw, NGW, lane);
  wt_convert<2>(p.b_w_in, DM, 448, DM, 512, WIN, gw, NGW, lane, p.norm_mix + DM);
  wt_convert<3>(p.b_w_qb, 256, 1536, 256, 2048, WQB, gw, NGW, lane);
  wt_convert<0>(p.b_w_kvb, 128, 2048, 128, 2048, WKVB, gw, NGW, lane);
  wt_convert<0>(p.b_w_o, DM, DM, DM, DM, WOB, gw, NGW, lane);
  rope_table(COS128, SIN128, 64, gtid, NGT, true);
  rope_table(COS64, SIN64, 32, gtid, NGT);
  xb_rows(p.x, HN, RS, gw, NGW, lane); }
#endif
  grid.sync();

#ifdef PROBE_EXTRA_SYNCS
  for (int i_ = 0; i_ < PROBE_EXTRA_SYNCS; ++i_) grid.sync();
#endif
  for (int layer = 0; layer < 2; ++layer) {
    if (layer == 0) {
      for (int half = 0; half < NCH; ++half) {
        for (int rep_ = 0; rep_ < PROBE_GEMM_REPS; ++rep_)
        { pg8::Gemm g{HN + (size_t)half * MH * DM, WQKV, MH, NQKV, DM}; pg8::StaticOrder S; S.init(MH, NQKV, G, bx);
          pg8::EpiQKVA E{QKVH, p.a_q_gain, p.a_k_gain, COS128, SIN128, XP, RS, half * MH};
          pg8::gemm_phase<pg8::EpiQKVA, pg8::StaticOrder, true, true>(lds, g, S, E, wave_s); }
        GRID_BAR();
        int uid0 = bx; asm volatile("" : "+s"(uid0));
        for (int uid = uid0; uid < BPC * 256; uid += G) {
          int g, r, nqb, L64, rem;
          if (uid < BPC * 64) { g = 0; r = 1; nqb = 16; L64 = 128; rem = uid; } else if (uid < BPC * 128) { g = 1; r = 4; nqb = 16; L64 = 32; rem = uid - BPC * 64; } else { g = 2; r = 16; nqb = 8; L64 = 8; rem = uid - BPC * 128; }
          const int per = (g == 2) ? 16 : 8, sub_i = rem % per, bhh = rem / per, h = bhh & 7, bl = bhh >> 3;
          const int nch = L64 / nqb, c = sub_i / nch, ch = sub_i % nch;
          const long ld = (long)r * NQKV;
          const bf16* qp = QKVH + ((size_t)bl * SEQ + c) * NQKV + g * 1024 + h * 128;
          att::dil_unit(qp, qp + 3072, qp + 6144, (bf16*)qp, LSE + ((size_t)g * MH + (size_t)bl * SEQ + c) * 8 + h, ld, (long)r * 8, ch * nqb, nqb, L64, 0.08838834764831845f, (LAS char*)lds, wave_s);
        }
        GRID_BAR();
        for (int rep_ = 0; rep_ < PROBE_EW_REPS; ++rep_) { FRESH_IDS(); merge_half(QKVH, LSE, AO + (size_t)half * MH * DM, gtid, NGT); }
        GRID_BAR();
      }
    } else {
#if SEL & 16
      for (int rep_ = 0; rep_ < PROBE_GEMM_REPS; ++rep_)
      { pg8::Gemm g{HN, WIN, M, 512, DM}; pg8::StaticOrder S; S.init(M, 512, G, bx);
        pg8::EpiLat E{CQN, CKVN, KR, SSR, p.b_q_a_gain, p.b_kv_a_gain, p.b_k_gain, COS64, SIN64, XP, RS};
        pg8::gemm_phase<pg8::EpiLat, pg8::StaticOrder, true, true>(lds, g, S, E, wave_s); }
#endif
      GRID_BAR();
#if SEL & 32
      for (int rep_ = 0; rep_ < PROBE_GEMM_REPS; ++rep_) {
      { pg8::Gemm g{CQN, WQB, M, 2048, 256}; pg8::StaticOrder S; S.init(M, 2048, G, bx);
        pg8::EpiQB E{QB, p.b_q_gain, COS64, SIN64, XP};
        pg8::gemm_phase<pg8::EpiQB, pg8::StaticOrder, true, true>(lds, g, S, E, wave_s); }
#if SEL & 64
      { pg8::Gemm g{CKVN, WKVB, M, 2048, 128  }; pg8::StaticOrder S; S.init(M, 2048, G, bx);
        pg8::EpiKVB E{KB, VB, p.b_k_gain, KR, SSR, XP};
        pg8::gemm_phase<pg8::EpiKVB, pg8::StaticOrder, true, true>(lds, g, S, E, wave_s); }
      }
#endif
#endif
      GRID_BAR();
#if SEL & 128
#ifndef PROBE_MLA_REPS
#define PROBE_MLA_REPS 1
#endif
#ifdef PROBE_CLOCK
      const unsigned long long pc0_ = __builtin_amdgcn_s_memtime(), pr0_ = __builtin_amdgcn_s_memrealtime();
#endif
      for (int rep_ = 0; rep_ < PROBE_MLA_REPS; ++rep_)
      { const int xcd = bx & 7, loc = bx >> 3;
        for (int i = 0; ; ++i) {
          int bh, qb;
          if (G == 256) { if (i >= 8) break; bh = i * 8 + xcd; qb = loc; }
          else { const int uid = i * G + bx; if (uid >= 64 * 32) break; bh = uid >> 5; qb = uid & 31; }
          const int b = bh >> 3, h = bh & 7;
#ifndef PROBE_MLA_MODE
#define PROBE_MLA_MODE 0
#endif
          if (PROBE_MLA_REPS > 1 && rep_ == 0)
          att::mla_unit<PROBE_MLA_MODE>(QB + ((size_t)bh * SEQ + 256 * qb) * 192, KB + (size_t)bh * SEQ * 192, VB + (size_t)bh * SEQ * 128,
                        AO + ((size_t)b * SEQ + 256 * qb) * DM + h * 128, DM, SEQ / 64, 0.07216878364870322f, (LAS char*)lds, wave_s, p.ws == nullptr);
          else
          att::mla_unit_pp(QB + ((size_t)bh * SEQ + 256 * qb) * 192, KB + (size_t)bh * SEQ * 192, VB + (size_t)bh * SEQ * 128,
                        AO + ((size_t)b * SEQ + 256 * qb) * DM + h * 128, DM, SEQ / 64, 0.07216878364870322f, (LAS char*)lds, wave_s);
        } }
#endif
#ifdef PROBE_CLOCK
      { const unsigned long long pc1_ = __builtin_amdgcn_s_memtime(), pr1_ = __builtin_amdgcn_s_memrealtime();
        if (bx == PROBE_CLOCK && wave_s == 0 && mk_lane() == 0) { const float mhz_ = (float)(pc1_ - pc0_) * 100.0f / (float)(pr1_ - pr0_); ((float*)(p.ws + WS_BAR + 14336))[0] = (mhz_ > 1450.f ? 1000.f : 0.f) + (mhz_ > 1750.f ? 1000.f : 0.f) + (mhz_ > 2050.f ? 1000.f : 0.f) + (mhz_ > 2300.f ? 1000.f : 0.f); } }
#endif
      GRID_BAR();
    }
    { pg8::Gemm g{AO, layer == 0 ? WOA : WOB, M, DM, DM}; pg8::StaticOrder S; S.init(M, DM, G, bx);
      pg8::EpiResB E{HN, HN, RS2, XP, nullptr};
      pg8::gemm_phase<pg8::EpiResB, pg8::StaticOrder, true, true>(lds, g, S, E, wave_s); }
    GRID_BAR();
#ifndef PROBE_FFN1_REPS
#define PROBE_FFN1_REPS 1
#endif
#ifndef PROBE_FFN1_DRY
#define PROBE_FFN1_DRY 1
#endif
#ifdef STAG_FFN1
    for (int i_ = 0; i_ < bx; ++i_) __builtin_amdgcn_s_sleep(STAG_FFN1);
#endif
    for (int rep_ = 0; rep_ < PROBE_FFN1_REPS; ++rep_)
    { pg8::Gemm g{HN, W1 + (size_t)layer * DM * FF, M, FF, DM}; pg8::StaticOrder S; S.init(M, FF, G, bx);
      pg8::EpiRelu2 E{ACT, FF, (PROBE_FFN1_REPS > 1 && rep_ == 0) ? PROBE_FFN1_DRY : 0};
      pg8::gemm_phase<pg8::EpiRelu2, pg8::StaticOrder, true, true>(lds, g, S, E, wave_s); }
    GRID_BAR();
    if (layer == 0) {
      { pg8::Gemm g{ACT, W2, M, DM, FF}; pg8::StaticOrder S; S.init(M, DM, G, bx);
        pg8::EpiResB E{HN, HN, RS, XP, RS2};
        pg8::gemm_phase<pg8::EpiResB, pg8::StaticOrder, true, true>(lds, g, S, E, wave_s); }
      GRID_BAR();
    } else {
      pg8::Gemm g{ACT, W2 + (size_t)DM * FF, M, DM, FF}; pg8::StaticOrder S; S.init(M, DM, G, bx);
      pg8::EpiResF E{HN, p.out, RS2};
      pg8::gemm_phase<pg8::EpiResF, pg8::StaticOrder, true, true>(lds, g, S, E, wave_s);
    }
  }
#ifdef PROBE_CLOCK
  GRID_BAR();
  if (bx == 0 && wave_s == 0 && mk_lane() == 0) p.out[0] += ((float*)(p.ws + WS_BAR + 14336))[0];
#endif
}

extern "C" void kernel_launch(void* const* d_in, const int* in_sizes, int n_in, void* d_out, int out_size, void* d_ws, size_t ws_size, hipStream_t stream) {
  static int grid_blocks = 0;
  if (grid_blocks == 0) {
    if (n_in != 17 || in_sizes[0] != M * DM || out_size != M * DM || ws_size < WS_END) {
      fprintf(stderr, "kernel_launch: unexpected shapes: n_in %d in0 %d out %d ws %zu (need >= %zu)\n", n_in, n_in > 0 ? in_sizes[0] : -1, out_size, ws_size, (size_t)WS_END); grid_blocks = -1; return; }
    int dev = 0, cus = 0, per_cu = 0;
    hipGetDevice(&dev); hipDeviceGetAttribute(&cus, hipDeviceAttributeMultiprocessorCount, dev);
    if (hipFuncSetAttribute((const void*)fwd_megakernel, hipFuncAttributeMaxDynamicSharedMemorySize, LDS_BYTES) != hipSuccess) { fprintf(stderr, "kernel_launch: hipFuncSetAttribute failed\n"); grid_blocks = -1; return; }
    if (hipOccupancyMaxActiveBlocksPerMultiprocessor(&per_cu, (const void*)fwd_megakernel, NTHR, LDS_BYTES) != hipSuccess || per_cu < 1) { fprintf(stderr, "kernel_launch: occupancy query gives %d\n", per_cu); per_cu = 1; }
    (void)hipGetLastError();
    grid_blocks = cus * per_cu;
  }
  if (grid_blocks < 0) return;
  Params p{};
  p.x = (const float*)d_in[0]; p.norm_mix = (const float*)d_in[1]; p.norm_ffn = (const float*)d_in[2]; p.a_w_qkv = (const float*)d_in[3]; p.a_q_gain = (const float*)d_in[4];
  p.a_k_gain = (const float*)d_in[5]; p.a_w_o = (const float*)d_in[6]; p.b_w_in = (const float*)d_in[7]; p.b_q_a_gain = (const float*)d_in[8]; p.b_w_qb = (const float*)d_in[9];
  p.b_kv_a_gain = (const float*)d_in[10]; p.b_w_kvb = (const float*)d_in[11]; p.b_q_gain = (const float*)d_in[12]; p.b_k_gain = (const float*)d_in[13]; p.b_w_o = (const float*)d_in[14];
  p.ffn_w1 = (const float*)d_in[15]; p.ffn_w2 = (const float*)d_in[16]; p.out = (float*)d_out; p.ws = (unsigned char*)d_ws;
  if (hipMemsetAsync((char*)d_ws + WS_BAR, 0, BAR_ZERO_BYTES, stream) != hipSuccess) { fprintf(stderr, "kernel_launch: memset failed\n"); return; }
  void* args[] = {&p};
  hipError_t e = hipLaunchCooperativeKernel((const void*)fwd_megakernel, dim3(grid_blocks), dim3(NTHR), args, LDS_BYTES, stream);
  if (e != hipSuccess) fprintf(stderr, "kernel_launch: cooperative launch failed: %s (grid %d)\n", hipGetErrorString(e), grid_blocks);
}
```

```cpp
#include <hip/hip_runtime.h>
#include <hip/hip_cooperative_groups.h>
#include <cstdio>
#include <cstdint>
namespace cg = cooperative_groups;
__device__ __forceinline__ int mk_lane() { int l; asm volatile("v_mbcnt_lo_u32_b32 %0, -1, 0\n\tv_mbcnt_hi_u32_b32 %0, -1, %0" : "=v"(l)); return l; }
namespace pg8 {
#define PG8_LAS __attribute__((address_space(3)))
typedef unsigned short bf16_t;
typedef short bf16x8 __attribute__((ext_vector_type(8)));
typedef float f32x4 __attribute__((ext_vector_type(4)));
typedef unsigned u32x4 __attribute__((ext_vector_type(4)));
constexpr int BM = 256, BK = 64, HALF = 128, HTB = HALF * BK * 2  , STAGE_BYTES = 8 * HTB, NXCD = 8, WGM = 8;

__host__ __device__ __forceinline__ int lds_byte(int r, int c) { const int st = (r >> 4) * 2 + (c >> 5), rr = r & 15, cc = c & 31, ob = rr * 64 + cc * 2; return st * 1024 + (ob ^ (((ob >> 9) & 1) << 5)); }
__host__ __device__ __forceinline__ void stage_rc(int b, int& R, int& C) { const int st = b / 1024, sb = b % 1024, swz = sb ^ (((sb >> 9) & 1) << 5); R = (st >> 1) * 16 + swz / 64; C = (st & 1) * 32 + (swz % 64) / 2; }
__host__ __device__ __forceinline__ int perm32(int rho) { const int n = rho >> 4, i = rho & 15; return 8 * (i >> 2) + 4 * n + (i & 3); }

struct Unit { int pm, pn; };
struct Gemm { const bf16_t* A; const bf16_t* Bt; int M, N, K; };

struct StaticOrder {
    int nM, nN, nwg, G, c;
    __host__ __device__ void init(int M, int N, int G_, int c_) { nM = M / BM; nN = N / BM; nwg = nM * nN; G = G_; c = c_; }
    __host__ __device__ bool next(int i, Unit& u) const {
        const long L = (long)i * G + c; if (L >= nwg) return false;
        int wgid = (int)L; { const int q = nwg / NXCD, r = nwg % NXCD, xcd = wgid % NXCD, off = wgid / NXCD; wgid = (xcd < r ? xcd * (q + 1) : r * (q + 1) + (xcd - r) * q) + off; }
        const int nig = WGM * nN, gid = wgid / nig, fm = gid * WGM, gsz = (nM - fm) < WGM ? (nM - fm) : WGM;
        u.pm = fm + ((wgid % nig) % gsz); u.pn = (wgid % nig) / gsz; return true;
    }
    __device__ __forceinline__ void a_ready(const Unit&) const {}
    __device__ __forceinline__ void done(const Unit&) const {}
};

__device__ __forceinline__ unsigned cvt_pk_bf16(float lo, float hi) { unsigned r; asm volatile("v_cvt_pk_bf16_f32 %0, %1, %2" : "=v"(r) : "v"(lo), "v"(hi)); return r; }
typedef float f32x2 __attribute__((ext_vector_type(2)));
typedef unsigned u32x2 __attribute__((ext_vector_type(2)));
constexpr float RMS_EPS = 1e-6f;
__device__ __forceinline__ u32x4 pack8(const f32x4& a, const f32x4& b) { u32x4 w; w.x = cvt_pk_bf16(a[0], a[1]); w.y = cvt_pk_bf16(a[2], a[3]); w.z = cvt_pk_bf16(b[0], b[1]); w.w = cvt_pk_bf16(b[2], b[3]); return w; }
__device__ __forceinline__ u32x2 pack4(const f32x4& a) { u32x2 w; w.x = cvt_pk_bf16(a[0], a[1]); w.y = cvt_pk_bf16(a[2], a[3]); return w; }
__device__ __forceinline__ float hsum4(const f32x4& t) { return (t[0] + t[1]) + (t[2] + t[3]); }


__device__ __forceinline__ float row_rstd(const float* rs, int row) { const f32x4 t = *(const f32x4*)(rs + (size_t)row * 4); return rsqrtf(hsum4(t) * (1.0f / 1024.0f) + RMS_EPS); }
__device__ __forceinline__ f32x4 bf2f_lo(const u32x2 u) { f32x4 r; r[0] = __uint_as_float(u.x << 16); r[1] = __uint_as_float(u.x & 0xffff0000u); r[2] = __uint_as_float(u.y << 16); r[3] = __uint_as_float(u.y & 0xffff0000u); return r; }
__device__ __forceinline__ void ss_exchange(const f32x4 (&acc)[2][2][4][2], int wr, int wc, int fr, int fq, PG8_LAS float* P) {
#pragma unroll
    for (int ai = 0; ai < 2; ++ai)
#pragma unroll
        for (int m = 0; m < 4; ++m)
#pragma unroll
            for (int bj = 0; bj < 2; ++bj) {
                const f32x4 a = acc[ai][bj][m][0], b = acc[ai][bj][m][1];
                float s = ((a[0] * a[0] + a[1] * a[1]) + (a[2] * a[2] + a[3] * a[3])) + ((b[0] * b[0] + b[1] * b[1]) + (b[2] * b[2] + b[3] * b[3]));
                s += __shfl_xor(s, 16); s += __shfl_xor(s, 32);
                if (fq == 0) P[((ai * HALF + wr * 64 + m * 16 + fr) * 2 + bj) * 4 + wc] = s;
            }
    asm volatile("s_waitcnt lgkmcnt(0)" ::: "memory"); __builtin_amdgcn_s_barrier(); asm volatile("" ::: "memory");
}

struct EpiResB {
    static constexpr bool PERM = true, AFTER_DRAIN = false;
    const bf16_t* base; bf16_t* out; float* rs; PG8_LAS float* P; const float* rs_in;
    __device__ __forceinline__ void operator()(const f32x4 (&acc)[2][2][4][2], const Unit& u, int wr, int wc, int fr, int fq) const {
        asm volatile("" : "+v"(fr), "+v"(fq));
        const int row0 = u.pm * BM + wr * 64 + fr, col0 = u.pn * BM + wc * 32 + 8 * fq;
        float r2[2][4];
#pragma unroll
        for (int ai = 0; ai < 2; ++ai)
#pragma unroll
            for (int m = 0; m < 4; ++m) { r2[ai][m] = 1.f; if (rs_in != nullptr) { const float r_ = row_rstd(rs_in, row0 + ai * HALF + m * 16); r2[ai][m] = r_ * r_; } }
#pragma unroll
        for (int ai = 0; ai < 2; ++ai) {
            u32x4 pre[4][2];
#pragma unroll
            for (int m = 0; m < 4; ++m)
#pragma unroll
                for (int bj = 0; bj < 2; ++bj) pre[m][bj] = *(const u32x4*)(base + (size_t)(row0 + ai * HALF + m * 16) * 1024 + col0 + bj * HALF);
#pragma unroll
            for (int m = 0; m < 4; ++m) { float ss = 0.f;
#pragma unroll
                for (int bj = 0; bj < 2; ++bj) { const u32x4 b = pre[m][bj];
                    const f32x4 x0 = bf2f_lo((u32x2){b.x, b.y}) + acc[ai][bj][m][0] * r2[ai][m], x1 = bf2f_lo((u32x2){b.z, b.w}) + acc[ai][bj][m][1] * r2[ai][m];
                    ss += ((x0[0] * x0[0] + x0[1] * x0[1]) + (x0[2] * x0[2] + x0[3] * x0[3])) + ((x1[0] * x1[0] + x1[1] * x1[1]) + (x1[2] * x1[2] + x1[3] * x1[3]));
                    *(u32x4*)(out + (size_t)(row0 + ai * HALF + m * 16) * 1024 + col0 + bj * HALF) = pack8(x0, x1); }
                ss += __shfl_xor(ss, 16); ss += __shfl_xor(ss, 32);
                if (fq == 0) P[(ai * HALF + wr * 64 + m * 16 + fr) * 4 + wc] = ss; }
            asm volatile("" ::: "memory"); }
        asm volatile("s_waitcnt lgkmcnt(0)" ::: "memory"); __builtin_amdgcn_s_barrier(); asm volatile("" ::: "memory");
        if (wr == 0) { const int rl = wc * 64 + fq * 16 + fr; const f32x4 t = *(const PG8_LAS f32x4*)(P + rl * 4); rs[(size_t)(u.pm * BM + rl) * 4 + u.pn] = hsum4(t); }
    }
};
struct EpiResF {
    static constexpr bool PERM = false, AFTER_DRAIN = false;
    const bf16_t* base; float* out; const float* rs_in;
    __device__ __forceinline__ void operator()(const f32x4 (&acc)[2][2][4][2], const Unit& u, int wr, int wc, int fr, int fq) const {
        asm volatile("" : "+v"(fr), "+v"(fq));
        const int col0 = u.pn * BM + wc * 32 + 4 * fq;
#pragma unroll
        for (int ai = 0; ai < 2; ++ai) {
            u32x2 pre[4][2][2]; float r2[4];
#pragma unroll
            for (int m = 0; m < 4; ++m) { const float r_ = row_rstd(rs_in, u.pm * BM + ai * HALF + wr * 64 + m * 16 + fr); r2[m] = r_ * r_; }
#pragma unroll
            for (int m = 0; m < 4; ++m) { const size_t off = (size_t)(u.pm * BM + ai * HALF + wr * 64 + m * 16 + fr) * 1024 + col0;
#pragma unroll
                for (int bj = 0; bj < 2; ++bj)
#pragma unroll
                    for (int n = 0; n < 2; ++n) pre[m][bj][n] = *(const u32x2*)(base + off + bj * HALF + n * 16); }
#pragma unroll
            for (int m = 0; m < 4; ++m) { const size_t off = (size_t)(u.pm * BM + ai * HALF + wr * 64 + m * 16 + fr) * 1024 + col0;
#pragma unroll
                for (int bj = 0; bj < 2; ++bj)
#pragma unroll
                    for (int n = 0; n < 2; ++n) *(f32x4*)(out + off + bj * HALF + n * 16) = bf2f_lo(pre[m][bj][n]) + acc[ai][bj][m][n] * r2[m]; }
            asm volatile("" ::: "memory"); }
    }
};
struct EpiRelu2 {
    static constexpr bool PERM = true, AFTER_DRAIN = false;
    bf16_t* O; int ldc; int dry;
    __device__ __forceinline__ void operator()(const f32x4 (&acc)[2][2][4][2], const Unit& u, int wr, int wc, int fr, int fq) const {
        asm volatile("" : "+v"(fr), "+v"(fq));
        if (dry == 2) { if (O == nullptr) *(f32x4*)O = acc[0][0][0][0] + acc[1][1][3][1]; return; }
        const int row0 = u.pm * BM + wr * 64 + fr, col0 = u.pn * BM + wc * 32 + 8 * fq;
#pragma unroll
        for (int ai = 0; ai < 2; ++ai)
#pragma unroll
            for (int m = 0; m < 4; ++m) { bf16_t* rowp = O + (size_t)(row0 + ai * HALF + m * 16) * ldc + col0;
#pragma unroll
                for (int bj = 0; bj < 2; ++bj) { f32x4 v0 = acc[ai][bj][m][0], v1 = acc[ai][bj][m][1];
                    v0 = __builtin_elementwise_max(v0, (f32x4){0.f, 0.f, 0.f, 0.f}); v1 = __builtin_elementwise_max(v1, (f32x4){0.f, 0.f, 0.f, 0.f});
                    v0 = v0 * v0; v1 = v1 * v1; const u32x4 w8_ = pack8(v0, v1); if (!dry) __builtin_nontemporal_store(w8_, (u32x4*)(rowp + bj * HALF)); } }
    }
};
struct EpiQKVA {
    static constexpr bool PERM = true, AFTER_DRAIN = false;
    bf16_t* O; const float* qg; const float* kg; const float* cosT; const float* sinT; PG8_LAS float* P; const float* rs; int rs_row0;
    __device__ __forceinline__ void operator()(const f32x4 (&acc)[2][2][4][2], const Unit& u, int wr, int wc, int fr, int fq) const {
        asm volatile("" : "+v"(fr), "+v"(fq));
        const int c0 = u.pn * BM, which = c0 / 3072;
        float rr[2][4];
#pragma unroll
        for (int ai = 0; ai < 2; ++ai)
#pragma unroll
            for (int m = 0; m < 4; ++m) rr[ai][m] = row_rstd(rs, rs_row0 + u.pm * BM + ai * HALF + wr * 64 + m * 16 + fr);
        if (which == 2) {
            const int row0 = u.pm * BM + wr * 64 + fr, col0 = c0 + wc * 32 + 8 * fq;
#pragma unroll
            for (int ai = 0; ai < 2; ++ai)
#pragma unroll
                for (int m = 0; m < 4; ++m) { bf16_t* rowp = O + (size_t)(row0 + ai * HALF + m * 16) * 9216 + col0;
#pragma unroll
                    for (int bj = 0; bj < 2; ++bj) *(u32x4*)(rowp + bj * HALF) = pack8(acc[ai][bj][m][0] * rr[ai][m], acc[ai][bj][m][1] * rr[ai][m]); }
            return;
        }
        const int g = (c0 % 3072) / 1024; const float* gain = (which == 0 ? qg : kg) + g * 128;
        const int hh = wc >> 1, dm = 32 * (wc & 1) + 8 * fq;
        const f32x4 g0a = *(const f32x4*)(gain + dm), g0b = *(const f32x4*)(gain + dm + 4), g1a = *(const f32x4*)(gain + 64 + dm), g1b = *(const f32x4*)(gain + 64 + dm + 4);
        typedef _Float16 h8 __attribute__((ext_vector_type(8)));
        h8 cs[4], sn[4];
#define QK_TAB(ai) do { _Pragma("unroll") for (int m = 0; m < 4; ++m) { const int pos = (u.pm * BM + (ai) * HALF + wr * 64 + m * 16 + fr) & 8191; \
            cs[m] = *(const h8*)((const _Float16*)cosT + pos * 64 + dm); sn[m] = *(const h8*)((const _Float16*)sinT + pos * 64 + dm); } } while (0)
        QK_TAB(0);
        ss_exchange(acc, wr, wc, fr, fq, P);
#pragma unroll
        for (int ai = 0; ai < 2; ++ai) {
            if (ai == 1) { asm volatile("" ::: "memory"); QK_TAB(1); }
#pragma unroll
            for (int m = 0; m < 4; ++m) { const int rl = ai * HALF + wr * 64 + m * 16 + fr, row = u.pm * BM + rl;
                const f32x4 t0 = *(const PG8_LAS f32x4*)(P + (rl * 2 + 0) * 4), t1 = *(const PG8_LAS f32x4*)(P + (rl * 2 + 1) * 4);
                const float ssh = hh ? ((t0[2] + t0[3]) + (t1[2] + t1[3])) : ((t0[0] + t0[1]) + (t1[0] + t1[1]));
                const float rw = rr[ai][m], rstd = rw * rsqrtf(rw * rw * ssh * (1.0f / 128.0f) + RMS_EPS);
                const h8 ch = cs[m], sh = sn[m];
                const f32x4 ca = {(float)ch[0], (float)ch[1], (float)ch[2], (float)ch[3]}, cb = {(float)ch[4], (float)ch[5], (float)ch[6], (float)ch[7]};
                const f32x4 sa = {(float)sh[0], (float)sh[1], (float)sh[2], (float)sh[3]}, sb = {(float)sh[4], (float)sh[5], (float)sh[6], (float)sh[7]};
                const f32x4 x1a = acc[ai][0][m][0] * rstd * g0a, x1b = acc[ai][0][m][1] * rstd * g0b, x2a = acc[ai][1][m][0] * rstd * g1a, x2b = acc[ai][1][m][1] * rstd * g1b;
                bf16_t* op = O + (size_t)row * 9216 + c0 + hh * 128 + dm;
                *(u32x4*)op = pack8(x1a * ca - x2a * sa, x1b * cb - x2b * sb);
                *(u32x4*)(op + 64) = pack8(x2a * ca + x1a * sa, x2b * cb + x1b * sb); }
        }
#undef QK_TAB
    }
};
struct EpiLat {
    static constexpr bool PERM = true, AFTER_DRAIN = false;
    bf16_t* cqn; bf16_t* ckvn; float* kr; float* ssr; const float* qag; const float* kvag; const float* kg; const float* cos64; const float* sin64; PG8_LAS float* P; const float* rs;
    __device__ __forceinline__ void operator()(const f32x4 (&acc)[2][2][4][2], const Unit& u, int wr, int wc, int fr, int fq) const {
        asm volatile("" : "+v"(fr), "+v"(fq));
        float rr[2][4];
#pragma unroll
        for (int ai = 0; ai < 2; ++ai)
#pragma unroll
            for (int m = 0; m < 4; ++m) rr[ai][m] = row_rstd(rs, u.pm * BM + ai * HALF + wr * 64 + m * 16 + fr);
        ss_exchange(acc, wr, wc, fr, fq, P);
        const int col0 = wc * 32 + 8 * fq;
        if (u.pn == 0) {
            f32x4 ga[2][2];
#pragma unroll
            for (int bj = 0; bj < 2; ++bj) { ga[bj][0] = *(const f32x4*)(qag + bj * HALF + col0); ga[bj][1] = *(const f32x4*)(qag + bj * HALF + col0 + 4); }
#pragma unroll
            for (int ai = 0; ai < 2; ++ai)
#pragma unroll
                for (int m = 0; m < 4; ++m) { const int rl = ai * HALF + wr * 64 + m * 16 + fr, row = u.pm * BM + rl;
                    const f32x4 t0 = *(const PG8_LAS f32x4*)(P + (rl * 2 + 0) * 4), t1 = *(const PG8_LAS f32x4*)(P + (rl * 2 + 1) * 4);
                    const float rw = rr[ai][m], rstd = rw * rsqrtf(rw * rw * (hsum4(t0) + hsum4(t1)) * (1.0f / 256.0f) + RMS_EPS);
#pragma unroll
                    for (int bj = 0; bj < 2; ++bj) *(u32x4*)(cqn + (size_t)row * 256 + bj * HALF + col0) = pack8(acc[ai][bj][m][0] * rstd * ga[bj][0], acc[ai][bj][m][1] * rstd * ga[bj][1]);
                    asm volatile("" ::: "memory"); }
        } else {
            const f32x4 gv0 = *(const f32x4*)(kvag + col0), gv1 = *(const f32x4*)(kvag + col0 + 4);
            const int i0 = (16 * wc + 4 * fq) & 31;
            const f32x4 gk0 = *(const f32x4*)(kg + 128 + i0), gk1 = *(const f32x4*)(kg + 160 + i0);
#pragma unroll
            for (int ai = 0; ai < 2; ++ai)
#pragma unroll
                for (int m = 0; m < 4; ++m) { const int rl = ai * HALF + wr * 64 + m * 16 + fr, row = u.pm * BM + rl, pos = row & 8191;
                    const f32x4 t0 = *(const PG8_LAS f32x4*)(P + (rl * 2 + 0) * 4), t1 = *(const PG8_LAS f32x4*)(P + (rl * 2 + 1) * 4);
                    const float rw = rr[ai][m], rstd = rw * rsqrtf(rw * rw * hsum4(t0) * (1.0f / 128.0f) + RMS_EPS);
                    { const u32x4 w8 = pack8(acc[ai][0][m][0] * rstd * gv0, acc[ai][0][m][1] * rstd * gv1);
                      *(u32x4*)(ckvn + (size_t)row * 128 + col0) = w8; }
                    if (wc < 2) { const f32x4 cs = *(const f32x4*)(cos64 + pos * 32 + i0), sn = *(const f32x4*)(sin64 + pos * 32 + i0);
                        const f32x4 x1 = acc[ai][1][m][0] * rw * gk0, x2 = acc[ai][1][m][1] * rw * gk1;
                        *(f32x4*)(kr + (size_t)row * 64 + i0) = x1 * cs - x2 * sn; *(f32x4*)(kr + (size_t)row * 64 + 32 + i0) = x2 * cs + x1 * sn; }
                    if (wc == 0 && fq == 0) ssr[row] = rw * rw * hsum4(t1);
                    asm volatile("" ::: "memory"); }
        }
    }
};
struct EpiQB {
    static constexpr bool PERM = true, AFTER_DRAIN = false;
    bf16_t* Q; const float* qg; const float* cos64; const float* sin64; PG8_LAS float* P;
    __device__ __forceinline__ void operator()(const f32x4 (&acc)[2][2][4][2], const Unit& u, int wr, int wc, int fr, int fq) const {
        asm volatile("" : "+v"(fr), "+v"(fq));
        const int h = u.pn, col0 = wc * 32 + 8 * fq, i0 = (16 * wc + 4 * fq) & 31;
        const f32x4 ga = *(const f32x4*)(qg + col0), gb = *(const f32x4*)(qg + col0 + 4), gr0 = *(const f32x4*)(qg + 128 + i0), gr1 = *(const f32x4*)(qg + 160 + i0);
        f32x4 csv[2][4], snv[2][4];
        if (wc < 2) {
#pragma unroll
            for (int ai = 0; ai < 2; ++ai)
#pragma unroll
                for (int m = 0; m < 4; ++m) { const int s_ = (u.pm * BM + ai * HALF + wr * 64 + m * 16 + fr) & 8191; csv[ai][m] = *(const f32x4*)(cos64 + s_ * 32 + i0); snv[ai][m] = *(const f32x4*)(sin64 + s_ * 32 + i0); }
        }
        ss_exchange(acc, wr, wc, fr, fq, P);
#pragma unroll
        for (int ai = 0; ai < 2; ++ai)
#pragma unroll
            for (int m = 0; m < 4; ++m) { const int rl = ai * HALF + wr * 64 + m * 16 + fr, row = u.pm * BM + rl, b = row >> 13, s = row & 8191;
                const f32x4 t0 = *(const PG8_LAS f32x4*)(P + (rl * 2 + 0) * 4), t1 = *(const PG8_LAS f32x4*)(P + (rl * 2 + 1) * 4);
                const float rstd = rsqrtf((hsum4(t0) + hsum4(t1)) * (1.0f / 192.0f) + RMS_EPS) * (0.07216878364870322f * 1.4426950408889634f);
                bf16_t* qp = Q + ((size_t)(b * 8 + h) * 8192 + s) * 192;
                *(u32x4*)(qp + col0) = pack8(acc[ai][0][m][0] * rstd * ga, acc[ai][0][m][1] * rstd * gb);
                if (wc < 2) { const f32x4 cs = csv[ai][m], sn = snv[ai][m];
                    const f32x4 x1 = acc[ai][1][m][0] * rstd * gr0, x2 = acc[ai][1][m][1] * rstd * gr1;
                    *(u32x2*)(qp + 128 + i0) = pack4(x1 * cs - x2 * sn); *(u32x2*)(qp + 160 + i0) = pack4(x2 * cs + x1 * sn); } }
    }
};
struct EpiKVB {
    static constexpr bool PERM = true, AFTER_DRAIN = false;
    bf16_t* K; bf16_t* V; const float* kg; const float* kr; const float* ssr; PG8_LAS float* P;
    __device__ __forceinline__ void operator()(const f32x4 (&acc)[2][2][4][2], const Unit& u, int wr, int wc, int fr, int fq) const {
        asm volatile("" : "+v"(fr), "+v"(fq));
        const int h = u.pn, col0 = wc * 32 + 8 * fq, c4 = 4 * (4 * wc + fq);
        const f32x4 ga = *(const f32x4*)(kg + col0), gb = *(const f32x4*)(kg + col0 + 4);
        f32x4 krv[2][4]; float ssv[2][4];
#pragma unroll
        for (int ai = 0; ai < 2; ++ai)
#pragma unroll
            for (int m = 0; m < 4; ++m) { const int row = u.pm * BM + ai * HALF + wr * 64 + m * 16 + fr; ssv[ai][m] = ssr[row]; krv[ai][m] = *(const f32x4*)(kr + (size_t)row * 64 + c4); }
        ss_exchange(acc, wr, wc, fr, fq, P);
#pragma unroll
        for (int ai = 0; ai < 2; ++ai)
#pragma unroll
            for (int m = 0; m < 4; ++m) { const int rl = ai * HALF + wr * 64 + m * 16 + fr, row = u.pm * BM + rl, b = row >> 13, s = row & 8191;
                const f32x4 t0 = *(const PG8_LAS f32x4*)(P + (rl * 2 + 0) * 4);
                const float rstd = rsqrtf((hsum4(t0) + ssv[ai][m]) * (1.0f / 192.0f) + RMS_EPS);
                const size_t tok = (size_t)(b * 8 + h) * 8192 + s;
                bf16_t* kp = K + tok * 192;
                *(u32x4*)(kp + col0) = pack8(acc[ai][0][m][0] * rstd * ga, acc[ai][0][m][1] * rstd * gb);
                const f32x4 r4 = krv[ai][m] * rstd;
                *(u32x2*)(kp + 128 + c4) = pack4(r4);
                *(u32x4*)(V + tok * 128 + col0) = pack8(acc[ai][1][m][0], acc[ai][1][m][1]); }
    }
};

template <class Epi, class Sched, bool ALIGN_EPI = false, bool SP2 = false>
__device__ __forceinline__ void gemm_phase(PG8_LAS unsigned char* lds, const Gemm g, const Sched& S, const Epi& E, int wave_s) {
    int tid_l = wave_s * 64 + mk_lane(); asm volatile("" : "+v"(tid_l));
    const int tid = tid_l, wid = __builtin_amdgcn_readfirstlane(tid >> 6), lane = tid & 63, wr = wid >> 2, wc = wid & 3, fr = lane & 15, fq = lane >> 4;
    int K_l = g.K; asm volatile("" : "+s"(K_l));
    const int K = K_l, nt = K / BK;
    unsigned voffA[2], voffB[2];
#pragma unroll
    for (int i = 0; i < 2; ++i) { int R, C; stage_rc(tid * 16 + i * 8192, R, C); const int Rb = Epi::PERM ? ((R & ~31) + perm32(R & 31)) : R;
        voffA[i] = (unsigned)(R * K + C) * 2u; voffB[i] = (unsigned)(Rb * K + C) * 2u; }
    const size_t kstep = (size_t)(BK * 2);
    const size_t hstep = (size_t)HALF * K * 2;
    const size_t tstep = 2 * hstep;
    const unsigned ldsw = (unsigned)wid * 1024u;
    const int aoff = lds_byte(wr * 64 + fr, fq * 8), boff = lds_byte(wc * 32 + fr, fq * 8);
#define PG8_SA(b, h) (((b) * 2 + (h)) * HTB)
#define PG8_SB(b, h) ((4 + (b) * 2 + (h)) * HTB)
#define PG8_STAGE(bufoff, gbase, voff) do { _Pragma("unroll") for (int _i = 0; _i < 2; ++_i) \
        __builtin_amdgcn_global_load_lds((const unsigned*)((const char*)(gbase) + (voff)[_i]), (PG8_LAS unsigned*)(lds + (bufoff) + ldsw + _i * 8192), 16, 0, 0); } while (0)
#define PG8_LDA(dst, b, h) do { _Pragma("unroll") for (int m = 0; m < 4; ++m) _Pragma("unroll") for (int k = 0; k < 2; ++k) dst[m][k] = *(const PG8_LAS bf16x8*)(lds + PG8_SA(b, h) + aoff + m * 2048 + k * 1024); } while (0)
#define PG8_LDB(dst, b, h) do { _Pragma("unroll") for (int n = 0; n < 2; ++n) _Pragma("unroll") for (int k = 0; k < 2; ++k) dst[n][k] = *(const PG8_LAS bf16x8*)(lds + PG8_SB(b, h) + boff + n * 2048 + k * 1024); } while (0)
#define PG8_MMA(ai, bj, At, Bt) do { __builtin_amdgcn_s_setprio(1); _Pragma("unroll") for (int m = 0; m < 4; ++m) _Pragma("unroll") for (int n = 0; n < 2; ++n) _Pragma("unroll") for (int k = 0; k < 2; ++k) \
        acc[ai][bj][m][n] = __builtin_amdgcn_mfma_f32_16x16x32_bf16(Bt[n][k], At[m][k], acc[ai][bj][m][n], 0, 0, 0); __builtin_amdgcn_s_setprio(0); } while (0)
#define PG8_WAIT_V(n) asm volatile("s_waitcnt vmcnt(" #n ")" ::: "memory")
#define PG8_WAIT_L(n) asm volatile("s_waitcnt lgkmcnt(" #n ")" ::: "memory")
#define PG8_BAR __builtin_amdgcn_s_barrier()
#define PG8_SCHED __builtin_amdgcn_sched_barrier(0)
    Unit cur, nxt; int ui = 0;
    if (!S.next(0, cur)) return;
    f32x4 acc[2][2][4][2];
#pragma unroll
    for (int a = 0; a < 2; ++a)
#pragma unroll
        for (int b = 0; b < 2; ++b)
#pragma unroll
            for (int m = 0; m < 4; ++m)
#pragma unroll
                for (int n = 0; n < 2; ++n) acc[a][b][m][n] = (f32x4){0.f, 0.f, 0.f, 0.f};
    bf16x8 At[4][2], B0[2][2], B1[2][2];
    const char* cA = (const char*)g.A + (size_t)cur.pm * tstep; const char* cB = (const char*)g.Bt + (size_t)cur.pn * tstep;
    S.a_ready(cur);
    if constexpr (SP2) {
        PG8_STAGE(PG8_SB(0, 0), cB, voffB); PG8_STAGE(PG8_SB(0, 1), cB + hstep, voffB); PG8_STAGE(PG8_SA(0, 0), cA, voffA); PG8_STAGE(PG8_SA(0, 1), cA + hstep, voffA);
        if (wr == 1) PG8_BAR;
        PG8_WAIT_V(2); PG8_BAR;
        PG8_STAGE(PG8_SB(1, 0), cB + kstep, voffB); PG8_STAGE(PG8_SA(1, 0), cA + kstep, voffA); PG8_STAGE(PG8_SB(1, 1), cB + hstep + kstep, voffB);
        PG8_WAIT_V(6); PG8_BAR;
    } else {
        PG8_STAGE(PG8_SB(0, 0), cB, voffB); PG8_STAGE(PG8_SA(0, 0), cA, voffA); PG8_STAGE(PG8_SB(0, 1), cB + hstep, voffB); PG8_STAGE(PG8_SA(0, 1), cA + hstep, voffA);
        if (wr == 1) PG8_BAR;
        PG8_WAIT_V(4); PG8_BAR;
        PG8_STAGE(PG8_SB(1, 0), cB + kstep, voffB); PG8_STAGE(PG8_SA(1, 0), cA + kstep, voffA); PG8_STAGE(PG8_SB(1, 1), cB + hstep + kstep, voffB);
        PG8_WAIT_V(6); PG8_BAR;
    }
    for (;;) {
        const bool has_next = S.next(ui + 1, nxt);
        const char* nA = has_next ? (const char*)g.A + (size_t)nxt.pm * tstep : cA; const char* nB = has_next ? (const char*)g.Bt + (size_t)nxt.pn * tstep : cB;
        for (int t = 0; t < nt; t += 2) {
            const bool last = (t == nt - 2);
            const char* a1 = cA + (size_t)(t + 1) * kstep;
            const char* a2 = last ? nA : cA + (size_t)(t + 2) * kstep; const char* b2 = last ? nB : cB + (size_t)(t + 2) * kstep;
            const char* a3 = a2 + kstep; const char* b3 = b2 + kstep;
            if (last && has_next) S.a_ready(nxt);
            if constexpr (SP2) {
            PG8_LDB(B0, 0, 0); PG8_LDB(B1, 0, 1); PG8_SCHED; PG8_LDA(At, 0, 0); PG8_STAGE(PG8_SA(1, 1), a1 + hstep, voffA);
            PG8_WAIT_V(8); PG8_WAIT_L(0); PG8_BAR; PG8_MMA(0, 0, At, B0); PG8_MMA(0, 1, At, B1); PG8_BAR; PG8_SCHED;
            PG8_LDA(At, 0, 1); PG8_STAGE(PG8_SB(0, 0), b2, voffB); PG8_STAGE(PG8_SB(0, 1), b2 + hstep, voffB); PG8_STAGE(PG8_SA(0, 0), a2, voffA);
            PG8_WAIT_V(8); PG8_WAIT_L(0); PG8_BAR; PG8_MMA(1, 0, At, B0); PG8_MMA(1, 1, At, B1); PG8_BAR; PG8_SCHED;
            PG8_LDB(B0, 1, 0); PG8_LDB(B1, 1, 1); PG8_SCHED; PG8_LDA(At, 1, 0); PG8_STAGE(PG8_SA(0, 1), a2 + hstep, voffA);
            PG8_WAIT_V(8); PG8_WAIT_L(0); PG8_BAR; PG8_MMA(0, 0, At, B0); PG8_MMA(0, 1, At, B1); PG8_BAR; PG8_SCHED;
            PG8_LDA(At, 1, 1); PG8_STAGE(PG8_SB(1, 0), b3, voffB); PG8_STAGE(PG8_SB(1, 1), b3 + hstep, voffB); PG8_STAGE(PG8_SA(1, 0), a3, voffA);
            PG8_WAIT_V(8); PG8_WAIT_L(0); PG8_BAR; PG8_MMA(1, 0, At, B0); PG8_MMA(1, 1, At, B1); PG8_BAR; PG8_SCHED;
            } else {
            PG8_LDB(B0, 0, 0); PG8_SCHED; PG8_LDA(At, 0, 0); PG8_STAGE(PG8_SA(1, 1), a1 + hstep, voffA);
            PG8_WAIT_L(8); PG8_BAR; PG8_WAIT_L(0); PG8_MMA(0, 0, At, B0); PG8_BAR; PG8_SCHED;
            PG8_LDB(B1, 0, 1); PG8_STAGE(PG8_SB(0, 0), b2, voffB);
            PG8_BAR; PG8_WAIT_L(0); PG8_MMA(0, 1, At, B1); PG8_BAR;
            PG8_LDA(At, 0, 1); PG8_STAGE(PG8_SA(0, 0), a2, voffA);
            PG8_BAR; PG8_WAIT_L(0); PG8_MMA(1, 0, At, B0); PG8_BAR; PG8_SCHED;
            PG8_STAGE(PG8_SB(0, 1), b2 + hstep, voffB);
            PG8_WAIT_V(6); PG8_BAR; PG8_MMA(1, 1, At, B1); PG8_BAR;
            PG8_LDB(B0, 1, 0); PG8_SCHED; PG8_LDA(At, 1, 0); PG8_STAGE(PG8_SA(0, 1), a2 + hstep, voffA);
            PG8_WAIT_L(8); PG8_BAR; PG8_WAIT_L(0); PG8_MMA(0, 0, At, B0); PG8_BAR; PG8_SCHED;
            PG8_LDB(B1, 1, 1); PG8_STAGE(PG8_SB(1, 0), b3, voffB);
            PG8_BAR; PG8_WAIT_L(0); PG8_MMA(0, 1, At, B1); PG8_BAR;
            PG8_LDA(At, 1, 1); PG8_STAGE(PG8_SA(1, 0), a3, voffA);
            PG8_BAR; PG8_WAIT_L(0); PG8_MMA(1, 0, At, B0); PG8_BAR; PG8_SCHED;
            PG8_STAGE(PG8_SB(1, 1), b3 + hstep, voffB);
            PG8_WAIT_V(6); PG8_BAR; PG8_MMA(1, 1, At, B1); PG8_BAR;
            }
        }
        if constexpr (ALIGN_EPI) { if (wr == 0) PG8_BAR; }
        if constexpr (!Epi::AFTER_DRAIN) { E(acc, cur, wr, wc, fr, fq); S.done(cur); }
        if (!has_next) break;
#pragma unroll
        for (int a = 0; a < 2; ++a)
#pragma unroll
            for (int b = 0; b < 2; ++b)
#pragma unroll
                for (int m = 0; m < 4; ++m)
#pragma unroll
                    for (int n = 0; n < 2; ++n) acc[a][b][m][n] = (f32x4){0.f, 0.f, 0.f, 0.f};
        cur = nxt; cA = nA; cB = nB; ++ui;
        if constexpr (ALIGN_EPI) { if (wr == 1) PG8_BAR; }
    }
    PG8_WAIT_V(0);
    if constexpr (!ALIGN_EPI) { if (wr == 0) PG8_BAR; }
    PG8_BAR;
    if constexpr (Epi::AFTER_DRAIN) { E.fused(acc, cur, wr, wc, fr, fq, lds, wid, lane); S.done(cur); }
#undef PG8_SA
#undef PG8_SB
#undef PG8_STAGE
#undef PG8_LDA
#undef PG8_LDB
#undef PG8_MMA
#undef PG8_WAIT_V
#undef PG8_WAIT_L
#undef PG8_BAR
#undef PG8_SCHED
}
}
namespace att {
#define ATT_LAS __attribute__((address_space(3)))
typedef unsigned short bf16_t;
typedef short bf16x8 __attribute__((ext_vector_type(8)));
typedef short s16x4 __attribute__((ext_vector_type(4)));
typedef float f32x16 __attribute__((ext_vector_type(16)));
typedef unsigned u32x4 __attribute__((ext_vector_type(4)));
#define SBAR() __builtin_amdgcn_sched_barrier(0)
__device__ __forceinline__ int crow(int r, int hi) { return (r & 3) + 8 * (r >> 2) + 4 * hi; }
__device__ __forceinline__ unsigned cvtpk(float lo, float hi) { unsigned r; asm volatile("v_cvt_pk_bf16_f32 %0, %1, %2" : "=v"(r) : "v"(lo), "v"(hi)); return r; }
__device__ __forceinline__ unsigned short f2bf(float f) { return (unsigned short)(cvtpk(f, f) & 0xffffu); }

template <int THRON>
__device__ __forceinline__ void partialSM(f32x16& p0, f32x16& p1, float& m_reg, float& mn, float& alpha, float C, float thr_raw) {
  float pmax = p0[0];
#pragma unroll
  for (int r = 1; r < 16; ++r) pmax = fmaxf(pmax, p0[r]);
#pragma unroll
  for (int r = 0; r < 16; ++r) pmax = fmaxf(pmax, p1[r]);
  { auto rr = __builtin_amdgcn_permlane32_swap(__float_as_uint(pmax), __float_as_uint(pmax), false, false);
    pmax = fmaxf(__uint_as_float(rr[0]), __uint_as_float(rr[1])); }
  if (THRON && __builtin_expect(__all(pmax - m_reg <= thr_raw), 1)) { mn = m_reg; alpha = 1.f; }
  else { mn = fmaxf(m_reg, pmax); alpha = __builtin_amdgcn_exp2f((m_reg - mn) * C); m_reg = mn; }
  const float mnC = -mn * C;
#pragma unroll
  for (int r = 0; r < 16; ++r) p0[r] = fmaf(p0[r], C, mnC);
#pragma unroll
  for (int r = 0; r < 16; ++r) p1[r] = fmaf(p1[r], C, mnC);
#pragma unroll
  for (int r = 0; r < 16; ++r) p0[r] = __builtin_amdgcn_exp2f(p0[r]);
}
__device__ __forceinline__ void partialSM_ref(f32x16& p0, f32x16& p1, float& mref, f32x16& negm, float& alpha, float thr2, bool first, bool check) {
  if (!check) { alpha = 1.f;
#pragma unroll
    for (int r = 0; r < 16; ++r) p0[r] = __builtin_amdgcn_exp2f(p0[r]);
    return; }
  float pmax = p0[0];
#pragma unroll
  for (int r = 1; r < 16; ++r) pmax = fmaxf(pmax, p0[r]);
#pragma unroll
  for (int r = 0; r < 16; ++r) pmax = fmaxf(pmax, p1[r]);
  { auto rr = __builtin_amdgcn_permlane32_swap(__float_as_uint(pmax), __float_as_uint(pmax), false, false);
    pmax = fmaxf(__uint_as_float(rr[0]), __uint_as_float(rr[1])); }
  if (!first && __builtin_expect(__all(pmax <= thr2), 1)) { alpha = 1.f; }
  else { const float dl = first ? pmax : fmaxf(pmax, 0.f); mref += dl; alpha = first ? 1.f : __builtin_amdgcn_exp2f(-dl);
#pragma unroll
    for (int r = 0; r < 16; ++r) { p0[r] -= dl; p1[r] -= dl; }
#pragma unroll
    for (int r = 0; r < 16; ++r) negm[r] = -mref; }
#pragma unroll
  for (int r = 0; r < 16; ++r) p0[r] = __builtin_amdgcn_exp2f(p0[r]);
}
__device__ __forceinline__ void finishSM(f32x16& p0, f32x16& p1, float alpha, float& l_reg, bf16x8& pa0, bf16x8& pa1, bf16x8& pa2, bf16x8& pa3) {
#pragma unroll
  for (int r = 0; r < 16; ++r) p1[r] = __builtin_amdgcn_exp2f(p1[r]);
  float ps = 0;
#pragma unroll
  for (int r = 0; r < 16; ++r) ps += p0[r];
#pragma unroll
  for (int r = 0; r < 16; ++r) ps += p1[r];
  { auto rr = __builtin_amdgcn_permlane32_swap(__float_as_uint(ps), __float_as_uint(ps), false, false);
    ps = __uint_as_float(rr[0]) + __uint_as_float(rr[1]); }
  l_reg = l_reg * alpha + ps;
#define PK4(P, BASE, OUT) do { unsigned a0 = cvtpk(P[BASE + 0], P[BASE + 1]), a1 = cvtpk(P[BASE + 2], P[BASE + 3]);   \
    unsigned b0 = cvtpk(P[BASE + 4], P[BASE + 5]), b1 = cvtpk(P[BASE + 6], P[BASE + 7]);                              \
    auto r0 = __builtin_amdgcn_permlane32_swap(a0, b0, false, false); auto r1 = __builtin_amdgcn_permlane32_swap(a1, b1, false, false); \
    u32x4 w = {r0[0], r1[0], r0[1], r1[1]}; OUT = __builtin_bit_cast(bf16x8, w); } while (0)
  PK4(p0, 0, pa0); PK4(p0, 8, pa1); PK4(p1, 0, pa2); PK4(p1, 8, pa3);
#undef PK4
}
__device__ __forceinline__ void finishSM_np(f32x16& p0, f32x16& p1, float alpha, float& l_reg, bf16x8& pa0, bf16x8& pa1, bf16x8& pa2, bf16x8& pa3) {
#pragma unroll
  for (int r = 0; r < 16; ++r) p1[r] = __builtin_amdgcn_exp2f(p1[r]);
  float ps = 0;
#pragma unroll
  for (int r = 0; r < 16; ++r) ps += p0[r];
#pragma unroll
  for (int r = 0; r < 16; ++r) ps += p1[r];
  { auto rr = __builtin_amdgcn_permlane32_swap(__float_as_uint(ps), __float_as_uint(ps), false, false);
    ps = __uint_as_float(rr[0]) + __uint_as_float(rr[1]); }
  l_reg = l_reg * alpha + ps;
#define PK8(P, BASE, OUT) do { u32x4 w = {cvtpk(P[BASE + 0], P[BASE + 1]), cvtpk(P[BASE + 2], P[BASE + 3]), cvtpk(P[BASE + 4], P[BASE + 5]), cvtpk(P[BASE + 6], P[BASE + 7])}; OUT = __builtin_bit_cast(bf16x8, w); } while (0)
  PK8(p0, 0, pa0); PK8(p0, 8, pa1); PK8(p1, 0, pa2); PK8(p1, 8, pa3);
#undef PK8
}
template <int DQK> __device__ __forceinline__ constexpr int kstride() { return DQK * 2 + 16; }
template <int DQK> __device__ __forceinline__ int kswz(int row, int colB) { return row * kstride<DQK>() + colB; }
template <int DQK, int LA = 2> __device__ __forceinline__ void qkt(f32x16& p0, f32x16& p1, const ATT_LAS char* Ks, const bf16x8* qr, int r32, int hi) {
  constexpr int N = DQK / 16;
  const ATT_LAS char* k0 = Ks + r32 * kstride<DQK>(); const ATT_LAS char* k1 = Ks + (32 + r32) * kstride<DQK>(); const int sw = 0;
  bf16x8 kf[N][2];
  p0 = f32x16{}; p1 = f32x16{};
#pragma unroll
  for (int d0 = 0; d0 < LA; ++d0) { const int cb = ((d0 * 16 + hi * 8) * 2) ^ sw; kf[d0][0] = *(const ATT_LAS bf16x8*)(k0 + cb); kf[d0][1] = *(const ATT_LAS bf16x8*)(k1 + cb); }
  SBAR();
#pragma unroll
  for (int d0 = 0; d0 < N; ++d0) {
    if (d0 + LA < N) { const int cb = (((d0 + LA) * 16 + hi * 8) * 2) ^ sw; kf[d0 + LA][0] = *(const ATT_LAS bf16x8*)(k0 + cb); kf[d0 + LA][1] = *(const ATT_LAS bf16x8*)(k1 + cb); }
    SBAR();
    p0 = __builtin_amdgcn_mfma_f32_32x32x16_bf16(kf[d0][0], qr[d0], p0, 0, 0, 0);
    p1 = __builtin_amdgcn_mfma_f32_32x32x16_bf16(kf[d0][1], qr[d0], p1, 0, 0, 0);
    SBAR();
  }
}
template <int DQK, int LA = 2> __device__ __forceinline__ void qkt_c(f32x16& p0, f32x16& p1, const ATT_LAS char* Ks, const bf16x8* qr, int r32, int hi, const f32x16& cinit) {
  constexpr int N = DQK / 16;
  const int rp = (r32 & ~0xC) | ((r32 & 4) << 1) | ((r32 & 8) >> 1);
  const ATT_LAS char* k0 = Ks + rp * kstride<DQK>(); const ATT_LAS char* k1 = Ks + (32 + rp) * kstride<DQK>(); const int sw = 0;
  bf16x8 kf[N][2];
  p0 = cinit; p1 = cinit;
#pragma unroll
  for (int d0 = 0; d0 < LA; ++d0) { const int cb = ((d0 * 16 + hi * 8) * 2) ^ sw; kf[d0][0] = *(const ATT_LAS bf16x8*)(k0 + cb); kf[d0][1] = *(const ATT_LAS bf16x8*)(k1 + cb); }
  SBAR();
#pragma unroll
  for (int d0 = 0; d0 < N; ++d0) {
    if (d0 + LA < N) { const int cb = (((d0 + LA) * 16 + hi * 8) * 2) ^ sw; kf[d0 + LA][0] = *(const ATT_LAS bf16x8*)(k0 + cb); kf[d0 + LA][1] = *(const ATT_LAS bf16x8*)(k1 + cb); }
    SBAR();
    p0 = __builtin_amdgcn_mfma_f32_32x32x16_bf16(kf[d0][0], qr[d0], p0, 0, 0, 0);
    p1 = __builtin_amdgcn_mfma_f32_32x32x16_bf16(kf[d0][1], qr[d0], p1, 0, 0, 0);
    SBAR();
  }
}
__device__ __forceinline__ int v_st(int k, int c) { const int kk = (k & ~0xC) | ((k & 4) << 1) | ((k & 8) >> 1); return ((kk >> 3) * 4 + (c >> 5)) * 512 + ((kk & 7) * 32 + (c & 31)) * 2; }
__device__ __forceinline__ int v_rd_base(int lane) { return ((lane & 3) << 3) | (((lane >> 2) & 3) << 6) | (((lane >> 4) & 1) << 5) | (((lane >> 5) & 1) << 8); }
constexpr int v_rd_off(int d0, int ks, int half) { return d0 * 512 + ks * 4096 + half * 2048; }
template <int OFF> __device__ __forceinline__ s16x4 tr_read(int vb) { s16x4 r; asm volatile("ds_read_b64_tr_b16 %0, %1 offset:%2" : "=&v"(r) : "v"(vb), "i"(OFF) : "memory"); return r; }
template <int D0> __device__ __forceinline__ void pv_one(f32x16& od, int vb, bf16x8 pa0, bf16x8 pa1, bf16x8 pa2, bf16x8 pa3) {
  const s16x4 l0 = tr_read<v_rd_off(D0, 0, 0)>(vb), h0 = tr_read<v_rd_off(D0, 0, 1)>(vb), l1 = tr_read<v_rd_off(D0, 1, 0)>(vb), h1 = tr_read<v_rd_off(D0, 1, 1)>(vb);
  const s16x4 l2 = tr_read<v_rd_off(D0, 2, 0)>(vb), h2 = tr_read<v_rd_off(D0, 2, 1)>(vb), l3 = tr_read<v_rd_off(D0, 3, 0)>(vb), h3 = tr_read<v_rd_off(D0, 3, 1)>(vb);
  asm volatile("s_waitcnt lgkmcnt(0)" ::: "memory"); SBAR();
#define PK(L, H) (bf16x8){L[0], L[1], L[2], L[3], H[0], H[1], H[2], H[3]}
  od = __builtin_amdgcn_mfma_f32_32x32x16_bf16(pa0, PK(l0, h0), od, 0, 0, 0);
  od = __builtin_amdgcn_mfma_f32_32x32x16_bf16(pa1, PK(l1, h1), od, 0, 0, 0);
  od = __builtin_amdgcn_mfma_f32_32x32x16_bf16(pa2, PK(l2, h2), od, 0, 0, 0);
  od = __builtin_amdgcn_mfma_f32_32x32x16_bf16(pa3, PK(l3, h3), od, 0, 0, 0);
#undef PK
}
__device__ __forceinline__ void pv_d0(f32x16* o, int vb, bf16x8 pa0, bf16x8 pa1, bf16x8 pa2, bf16x8 pa3) {
  pv_one<0>(o[0], vb, pa0, pa1, pa2, pa3); pv_one<1>(o[1], vb, pa0, pa1, pa2, pa3); pv_one<2>(o[2], vb, pa0, pa1, pa2, pa3); pv_one<3>(o[3], vb, pa0, pa1, pa2, pa3);
}

template <int D0> __device__ __forceinline__ void pv_reads(s16x4 (&l)[4], s16x4 (&h)[4], int vb) {
  l[0] = tr_read<v_rd_off(D0, 0, 0)>(vb); h[0] = tr_read<v_rd_off(D0, 0, 1)>(vb); l[1] = tr_read<v_rd_off(D0, 1, 0)>(vb); h[1] = tr_read<v_rd_off(D0, 1, 1)>(vb);
  l[2] = tr_read<v_rd_off(D0, 2, 0)>(vb); h[2] = tr_read<v_rd_off(D0, 2, 1)>(vb); l[3] = tr_read<v_rd_off(D0, 3, 0)>(vb); h[3] = tr_read<v_rd_off(D0, 3, 1)>(vb);
}
__device__ __forceinline__ void pv_mma(f32x16& od, const s16x4 (&l)[4], const s16x4 (&h)[4], bf16x8 pa0, bf16x8 pa1, bf16x8 pa2, bf16x8 pa3) {
#define PK(L, H) (bf16x8){L[0], L[1], L[2], L[3], H[0], H[1], H[2], H[3]}
  od = __builtin_amdgcn_mfma_f32_32x32x16_bf16(pa0, PK(l[0], h[0]), od, 0, 0, 0);
  od = __builtin_amdgcn_mfma_f32_32x32x16_bf16(pa1, PK(l[1], h[1]), od, 0, 0, 0);
  od = __builtin_amdgcn_mfma_f32_32x32x16_bf16(pa2, PK(l[2], h[2]), od, 0, 0, 0);
  od = __builtin_amdgcn_mfma_f32_32x32x16_bf16(pa3, PK(l[3], h[3]), od, 0, 0, 0);
#undef PK
}
__device__ __forceinline__ void pv_d0_la(f32x16* o, int vb, bf16x8 pa0, bf16x8 pa1, bf16x8 pa2, bf16x8 pa3) {
  s16x4 la[4], ha[4], lb[4], hb[4];
  pv_reads<0>(la, ha, vb); pv_reads<1>(lb, hb, vb);
  asm volatile("s_waitcnt lgkmcnt(8)" ::: "memory"); SBAR(); pv_mma(o[0], la, ha, pa0, pa1, pa2, pa3); SBAR();
  pv_reads<2>(la, ha, vb);
  asm volatile("s_waitcnt lgkmcnt(8)" ::: "memory"); SBAR(); pv_mma(o[1], lb, hb, pa0, pa1, pa2, pa3); SBAR();
  pv_reads<3>(lb, hb, vb);
  asm volatile("s_waitcnt lgkmcnt(8)" ::: "memory"); SBAR(); pv_mma(o[2], la, ha, pa0, pa1, pa2, pa3); SBAR();
  asm volatile("s_waitcnt lgkmcnt(0)" ::: "memory"); SBAR(); pv_mma(o[3], lb, hb, pa0, pa1, pa2, pa3);
}

template <int DQK, bool BAND>
__device__ __forceinline__ void attn_unit(const bf16_t* Qb, long ldq, const bf16_t* Kb, long ldk, const bf16_t* Vb, long ldv, bf16_t* Ob, long ldo, float* lse, long ldl,
                                          int kt0, int kt1, int qtile0, float scale, ATT_LAS char* lds, int wave_s) {
  constexpr int KB_BYTES = 64 * DQK * 2, VB_BYTES = 64 * 128 * 2, KCH = DQK / 8, NKC = DQK / 64;
  int tid_l = wave_s * 64 + mk_lane(); asm volatile("" : "+v"(tid_l));
  const int tid = tid_l, wid = __builtin_amdgcn_readfirstlane(tid >> 6), lane = tid & 63, r32 = lane & 31, hi = lane >> 5;
  ATT_LAS char* V_lds = lds; ATT_LAS char* K_lds = lds + 2 * VB_BYTES;
  ATT_LAS float* wsf = (ATT_LAS float*)(lds + 2 * VB_BYTES + 2 * KB_BYTES) + wid * 64; ATT_LAS float* li_l = wsf; ATT_LAS float* al_l = wsf + 32;
  const float C = scale * 1.4426950408889634f, thr_raw = 8.0f / scale;
  bf16x8 qr[DQK / 16];
  { const bf16_t* Qw = Qb + (long)(wid * 32 + r32) * ldq + hi * 8;
#pragma unroll
    for (int d0 = 0; d0 < DQK / 16; ++d0) qr[d0] = *(const bf16x8*)(Qw + d0 * 16); }
  float m_reg = -1e30f, l_reg = 0.f; f32x16 o[4] = {};
  const int qb = qtile0 + (wid >> 1), qi = (wid & 1) * 32 + r32;
  const int vb0 = (int)(unsigned)(uintptr_t)V_lds + v_rd_base(lane);
  bf16x8 ks[NKC], vs[2];
  const int vrow = tid >> 4, vcol = (tid & 15) * 8;
#define SLOAD(t) do { _Pragma("unroll") for (int i_ = 0; i_ < NKC; ++i_) { const int id_ = tid + 512 * i_, row_ = id_ / KCH, c8_ = id_ % KCH; ks[i_] = *(const bf16x8*)(Kb + (long)((t) * 64 + row_) * ldk + c8_ * 8); } \
    _Pragma("unroll") for (int i_ = 0; i_ < 2; ++i_) vs[i_] = *(const bf16x8*)(Vb + (long)((t) * 64 + vrow + 32 * i_) * ldv + vcol); } while (0)
#define SWRITE(b) do { _Pragma("unroll") for (int i_ = 0; i_ < NKC; ++i_) { const int id_ = tid + 512 * i_, row_ = id_ / KCH, c8_ = id_ % KCH; *(ATT_LAS bf16x8*)(K_lds + (b) * KB_BYTES + kswz<DQK>(row_, c8_ * 16)) = ks[i_]; } \
    _Pragma("unroll") for (int i_ = 0; i_ < 2; ++i_) *(ATT_LAS bf16x8*)(V_lds + (b) * VB_BYTES + v_st(vrow + 32 * i_, vcol)) = vs[i_]; } while (0)
  SLOAD(kt0); SWRITE(0); __syncthreads();
  for (int t = kt0; t < kt1; ++t) {
    const int b = (t - kt0) & 1; const bool more = (t + 1 < kt1);
    if (more) SLOAD(t + 1);
    const bool act = !BAND || (t >= qb - 1 && t <= qb + 1);
    if (act) {
      f32x16 p0, p1; qkt<DQK>(p0, p1, K_lds + b * KB_BYTES, qr, r32, hi);
      if (BAND) {
        if (t == qb - 1) {
#pragma unroll
          for (int r = 0; r < 16; ++r) { const int k0 = crow(r, hi); if (k0 < qi) p0[r] = -1e30f; if (k0 + 32 < qi) p1[r] = -1e30f; }
        } else if (t == qb + 1) {
#pragma unroll
          for (int r = 0; r < 16; ++r) { const int k0 = crow(r, hi); if (k0 > qi) p0[r] = -1e30f; if (k0 + 32 > qi) p1[r] = -1e30f; }
        }
      }
      float mn, alpha; partialSM<1>(p0, p1, m_reg, mn, alpha, C, thr_raw);
      bf16x8 pa0, pa1, pa2, pa3; finishSM(p0, p1, alpha, l_reg, pa0, pa1, pa2, pa3);
      if (__any(alpha < 1.f)) { if (hi == 0) al_l[r32] = alpha; asm volatile("s_waitcnt lgkmcnt(0)" ::: "memory");
#pragma unroll
        for (int d = 0; d < 4; ++d)
#pragma unroll
          for (int r = 0; r < 16; ++r) o[d][r] *= al_l[crow(r, hi)]; }
      pv_d0(o, vb0 + b * VB_BYTES, pa0, pa1, pa2, pa3);
    }
    if (more) SWRITE(b ^ 1);
    __syncthreads();
  }
#undef SLOAD
#undef SWRITE
  if (hi == 0) li_l[r32] = l_reg;
  asm volatile("s_waitcnt lgkmcnt(0)" ::: "memory");
  float rli[16];
#pragma unroll
  for (int r = 0; r < 16; ++r) rli[r] = __builtin_amdgcn_rcpf(li_l[crow(r, hi)]);
  bf16_t* Ow = Ob + (long)(wid * 32) * ldo;
#pragma unroll
  for (int r = 0; r < 16; ++r) { const int orow = crow(r, hi);
#pragma unroll
    for (int d0 = 0; d0 < 4; ++d0) Ow[(long)orow * ldo + d0 * 32 + r32] = f2bf(o[d0][r] * rli[r]); }
  if (lse != nullptr && hi == 0) lse[(long)(wid * 32 + r32) * ldl] = m_reg * scale + __logf(l_reg);
}

__device__ __forceinline__ void glds16s(const void* gbase, int voff, unsigned lds_dst) { unsigned keep;
  asm volatile("s_mov_b32 %0, m0\n\ts_mov_b32 m0, %3\n\ts_nop 0\n\tglobal_load_lds_dwordx4 %1, %2\n\ts_mov_b32 m0, %0" : "=&s"(keep) : "v"(voff), "s"(gbase), "s"(lds_dst) : "memory"); }
__device__ __forceinline__ void glds16(const void* gsrc, unsigned lds_dst) { unsigned keep;
  asm volatile("s_mov_b32 %0, m0\n\ts_mov_b32 m0, %2\n\ts_nop 0\n\tglobal_load_lds_dwordx4 %1, off\n\ts_mov_b32 m0, %0" : "=&s"(keep) : "v"(gsrc), "s"(lds_dst) : "memory"); }
#define WAIT_BAR(N) asm volatile("s_waitcnt vmcnt(" #N ") lgkmcnt(0)\n\ts_barrier" ::: "memory")
#define WAIT_BAR2(N0, N) do { if (wid == 0) WAIT_BAR(N0); else WAIT_BAR(N); } while (0)
#ifndef MLA_LA
#define MLA_LA 1
#endif
#ifndef MLA_PP_LA
#define MLA_PP_LA 6
#endif
constexpr int MLA_KSLOT = 64 * 400, MLA_KTILE = 64 * 192 * 2, MLA_VSLOT = 64 * 128 * 2, MLA_K0 = 0, MLA_V0 = 3 * MLA_KSLOT, MLA_WS = MLA_V0 + 3 * MLA_VSLOT, MLA_LDS = MLA_WS + 8 * 256;
template <int MODE = 0> __device__ __forceinline__ void mla_unit(const bf16_t* Qb, const bf16_t* Kh, const bf16_t* Vh, bf16_t* Ob, long ldo, int NT, float scale, ATT_LAS char* lds, int wave_s, bool do_store = true) {
  int tid_l = wave_s * 64 + mk_lane(); asm volatile("" : "+v"(tid_l));
  const int tid = tid_l, wid = __builtin_amdgcn_readfirstlane(tid >> 6), lane = tid & 63, r32 = lane & 31, hi = lane >> 5;
  const unsigned lds0 = (unsigned)(uintptr_t)lds;
  ATT_LAS float* wsf = (ATT_LAS float*)(lds + MLA_WS) + wid * 64; ATT_LAS float* li_l = wsf; ATT_LAS float* al_l = wsf + 32;
  const float C = scale * 1.4426950408889634f, thr_raw = 8.0f / scale;
  int ksrc[4], vsrc[2];
#pragma unroll
  for (int i = 0; i < 4; ++i) { const int gch = 64 * (wid + 8 * i) + lane, row = gch / 25, cc = gch % 25; ksrc[i] = row * 384 + (cc < 24 ? cc * 16 : 0); }
#pragma unroll
  for (int i = 0; i < 2; ++i) { const int B = 1024 * (2 * wid + i) + 16 * lane, sub = B >> 9, e = (B & 511) >> 1, kk = (sub >> 2) * 8 + (e >> 5), c = (sub & 3) * 32 + (e & 31);
    const int k = (kk & ~0xC) | ((kk & 4) << 1) | ((kk & 8) >> 1); vsrc[i] = (k * 128 + c) * 2; }
#define DMA_K(t, slot) do { const int t_ = (t) < NT ? (t) : NT - 1; const char* g_ = (const char*)Kh + (long)t_ * MLA_KTILE; \
    _Pragma("unroll") for (int i_ = 0; i_ < 4; ++i_) if ((i_ < 3 || wid == 0) && !(MODE & 2)) glds16(g_ + ksrc[i_], (unsigned)__builtin_amdgcn_readfirstlane(lds0 + MLA_K0 + (slot) * MLA_KSLOT + 1024 * (wid + 8 * i_))); } while (0)
#define DMA_V(t, slot) do { const int t_ = (t) < NT ? (t) : NT - 1; const char* g_ = (const char*)Vh + (long)t_ * MLA_VSLOT; \
    _Pragma("unroll") for (int i_ = 0; i_ < 2; ++i_) if (!(MODE & 2)) glds16(g_ + vsrc[i_], (unsigned)__builtin_amdgcn_readfirstlane(lds0 + MLA_V0 + (slot) * MLA_VSLOT + 1024 * (2 * wid + i_))); } while (0)
  DMA_K(0, 0); DMA_V(0, 0); DMA_K(1, 1); DMA_V(1, 1); DMA_K(2, 2);
  bf16x8 qr[12];
  { const bf16_t* Qw = Qb + (long)(wid * 32 + r32) * 192 + hi * 8;
#pragma unroll
    for (int d0 = 0; d0 < 12; ++d0) qr[d0] = *(const bf16x8*)(Qw + d0 * 16); }
  float m_reg = -1e30f, l_reg = 0.f; f32x16 o[4] = {};
  const int vb0 = (int)(lds0 + MLA_V0) + v_rd_base(lane);
  f32x16 pA0, pA1, pB0, pB1; float mnA, mnB, alA, alB; bf16x8 pa0, pa1, pa2, pa3;
#define RESC(a) do { if (__any((a) < 1.f)) { if (hi == 0) al_l[r32] = (a); asm volatile("s_waitcnt lgkmcnt(0)" ::: "memory"); \
    _Pragma("unroll") for (int d = 0; d < 4; ++d) _Pragma("unroll") for (int r = 0; r < 16; ++r) o[d][r] *= al_l[crow(r, hi)]; } } while (0)
  WAIT_BAR(0);
  if (wid >= 4) __builtin_amdgcn_s_setprio(1);
  qkt<192, MLA_LA>(pA0, pA1, lds + MLA_K0, qr, r32, hi); partialSM<1>(pA0, pA1, m_reg, mnA, alA, C, thr_raw);
  WAIT_BAR(0);
  int s_m1 = 0, s_0 = 1, s_p1 = 2;
#define ROT() do { const int t_ = s_m1; s_m1 = s_0; s_0 = s_p1; s_p1 = t_; } while (0)
#define STEP(X0, X1, mnX, alX, Y0, Y1, alY, j) do { \
    SBAR(); qkt<192, MLA_LA>(X0, X1, lds + MLA_K0 + s_0 * MLA_KSLOT, qr, r32, hi); \
    if (MODE & 1) { pa0 = __builtin_bit_cast(bf16x8, (u32x4){__float_as_uint(Y0[0]), __float_as_uint(Y0[1]), __float_as_uint(Y0[2]), __float_as_uint(Y0[3])}); pa1 = __builtin_bit_cast(bf16x8, (u32x4){__float_as_uint(Y0[4]), __float_as_uint(Y0[5]), __float_as_uint(Y0[6]), __float_as_uint(Y0[7])}); \
      pa2 = __builtin_bit_cast(bf16x8, (u32x4){__float_as_uint(Y1[0]), __float_as_uint(Y1[1]), __float_as_uint(Y1[2]), __float_as_uint(Y1[3])}); pa3 = __builtin_bit_cast(bf16x8, (u32x4){__float_as_uint(Y1[4]), __float_as_uint(Y1[5]), __float_as_uint(Y1[6]), __float_as_uint(Y1[7])}); } \
    else finishSM(Y0, Y1, alY, l_reg, pa0, pa1, pa2, pa3); SBAR(); \
    DMA_K((j) + 2, s_m1); SBAR(); \
    pv_d0(o, vb0 + s_m1 * MLA_VSLOT, pa0, pa1, pa2, pa3); if (MODE & 1) { alX = 1.f; } else partialSM<1>(X0, X1, m_reg, mnX, alX, C, thr_raw); SBAR(); \
    DMA_V((j) + 1, s_p1); \
    WAIT_BAR2(6, 5); RESC(alX); ROT(); } while (0)
  for (int j = 1; j + 1 < NT; j += 2) {
    STEP(pB0, pB1, mnB, alB, pA0, pA1, alA, j);
    STEP(pA0, pA1, mnA, alA, pB0, pB1, alB, j + 1);
  }
  STEP(pB0, pB1, mnB, alB, pA0, pA1, alA, NT - 1);
  finishSM(pB0, pB1, alB, l_reg, pa0, pa1, pa2, pa3); SBAR();
  pv_d0(o, vb0 + s_m1 * MLA_VSLOT, pa0, pa1, pa2, pa3);
  __builtin_amdgcn_s_setprio(0);
  (void)mnA; (void)mnB;
#undef STEP
#undef ROT
#undef RESC
#undef DMA_K
#undef DMA_V
  if (hi == 0) li_l[r32] = l_reg;
  WAIT_BAR(0);
  float rli[16];
#pragma unroll
  for (int r = 0; r < 16; ++r) rli[r] = __builtin_amdgcn_rcpf(li_l[crow(r, hi)]);
  ATT_LAS bf16_t* stg = (ATT_LAS bf16_t*)(lds + MLA_K0) + wid * 4096;
#pragma unroll
  for (int r = 0; r < 16; ++r) { const int orow = crow(r, hi);
#pragma unroll
    for (int d0 = 0; d0 < 4; ++d0) stg[orow * 128 + d0 * 32 + r32] = f2bf(o[d0][r] * rli[r]); }
  asm volatile("s_waitcnt lgkmcnt(0)" ::: "memory");
  bf16_t* Ow = Ob + (long)(wid * 32) * ldo;
#pragma unroll
  for (int i = 0; i < 8; ++i) { const int row = i * 4 + (lane >> 4), ch = lane & 15; const u32x4 v = *(const ATT_LAS u32x4*)(stg + row * 128 + ch * 8); if (do_store) *(u32x4*)(Ow + (long)row * ldo + ch * 8) = v; }
  WAIT_BAR(0);
}

__device__ __forceinline__ void mla_unit_stag(const bf16_t* Qb, const bf16_t* Kh, const bf16_t* Vh, bf16_t* Ob, long ldo, int NT, float scale, ATT_LAS char* lds, int wave_s) {
  int tid_l = wave_s * 64 + mk_lane(); asm volatile("" : "+v"(tid_l));
  const int tid = tid_l, wid = __builtin_amdgcn_readfirstlane(tid >> 6), lane = tid & 63, r32 = lane & 31, hi = lane >> 5;
  const unsigned lds0 = (unsigned)(uintptr_t)lds;
  ATT_LAS float* wsf = (ATT_LAS float*)(lds + MLA_WS) + wid * 64; ATT_LAS float* li_l = wsf; ATT_LAS float* al_l = wsf + 32;
  const float C = scale * 1.4426950408889634f, thr_raw = 8.0f / scale;
  int ksrc[4], vsrc[2];
#pragma unroll
  for (int i = 0; i < 4; ++i) { const int gch = 64 * (wid + 8 * i) + lane, row = gch / 25, cc = gch % 25; ksrc[i] = row * 384 + (cc < 24 ? cc * 16 : 0); }
#pragma unroll
  for (int i = 0; i < 2; ++i) { const int B = 1024 * (2 * wid + i) + 16 * lane, sub = B >> 9, e = (B & 511) >> 1, kk = (sub >> 2) * 8 + (e >> 5), c = (sub & 3) * 32 + (e & 31);
    const int k = (kk & ~0xC) | ((kk & 4) << 1) | ((kk & 8) >> 1); vsrc[i] = (k * 128 + c) * 2; }
#define DMA_K(t, slot) do { const int t_ = (t) < NT ? (t) : NT - 1; const char* g_ = (const char*)Kh + (long)t_ * MLA_KTILE; \
    _Pragma("unroll") for (int i_ = 0; i_ < 4; ++i_) if (i_ < 3 || wid == 0) glds16(g_ + ksrc[i_], (unsigned)__builtin_amdgcn_readfirstlane(lds0 + MLA_K0 + (slot) * MLA_KSLOT + 1024 * (wid + 8 * i_))); } while (0)
#define DMA_V(t, slot) do { const int t_ = (t) < NT ? (t) : NT - 1; const char* g_ = (const char*)Vh + (long)t_ * MLA_VSLOT; \
    _Pragma("unroll") for (int i_ = 0; i_ < 2; ++i_) glds16(g_ + vsrc[i_], (unsigned)__builtin_amdgcn_readfirstlane(lds0 + MLA_V0 + (slot) * MLA_VSLOT + 1024 * (2 * wid + i_))); } while (0)
  DMA_K(0, 0); DMA_V(0, 0); DMA_K(1, 1); DMA_V(1, 1); DMA_K(2, 2);
  bf16x8 qr[12];
  { const bf16_t* Qw = Qb + (long)(wid * 32 + r32) * 192 + hi * 8;
#pragma unroll
    for (int d0 = 0; d0 < 12; ++d0) qr[d0] = *(const bf16x8*)(Qw + d0 * 16); }
  float m_reg = -1e30f, l_reg = 0.f; f32x16 o[4] = {};
  const int vb0 = (int)(lds0 + MLA_V0) + v_rd_base(lane);
  f32x16 pA0, pA1, pB0, pB1; float mnA, mnB, alA, alB; bf16x8 pa0, pa1, pa2, pa3;
#define RESC(a) do { if (__any((a) < 1.f)) { if (hi == 0) al_l[r32] = (a); asm volatile("s_waitcnt lgkmcnt(0)" ::: "memory"); \
    _Pragma("unroll") for (int d = 0; d < 4; ++d) _Pragma("unroll") for (int r = 0; r < 16; ++r) o[d][r] *= al_l[crow(r, hi)]; } } while (0)
  WAIT_BAR(0);
  int s_m1 = 0, s_0 = 1, s_p1 = 2;
#define ROT() do { const int t_ = s_m1; s_m1 = s_0; s_0 = s_p1; s_p1 = t_; } while (0)
#define STEPA(X0, X1, mnX, alX, Y0, Y1, alY, j) do { \
    SBAR(); qkt<192, MLA_LA>(X0, X1, lds + MLA_K0 + s_0 * MLA_KSLOT, qr, r32, hi); \
    finishSM(Y0, Y1, alY, l_reg, pa0, pa1, pa2, pa3); SBAR(); \
    DMA_K((j) + 2, s_m1); SBAR(); \
    pv_d0(o, vb0 + s_m1 * MLA_VSLOT, pa0, pa1, pa2, pa3); partialSM<1>(X0, X1, m_reg, mnX, alX, C, thr_raw); SBAR(); \
    DMA_V((j) + 1, s_p1); \
    WAIT_BAR2(6, 5); RESC(alX); ROT(); } while (0)
#define STEPB(X0, X1, Y0, Y1, j) do { float mnY_, alY_; \
    SBAR(); partialSM<1>(Y0, Y1, m_reg, mnY_, alY_, C, thr_raw); (void)mnY_; RESC(alY_); \
    finishSM(Y0, Y1, alY_, l_reg, pa0, pa1, pa2, pa3); SBAR(); \
    DMA_K((j) + 2, s_m1); SBAR(); \
    pv_d0(o, vb0 + s_m1 * MLA_VSLOT, pa0, pa1, pa2, pa3); SBAR(); \
    qkt<192, MLA_LA>(X0, X1, lds + MLA_K0 + s_0 * MLA_KSLOT, qr, r32, hi); SBAR(); \
    DMA_V((j) + 1, s_p1); \
    WAIT_BAR2(6, 5); ROT(); } while (0)
  if (wid < 4) {
    qkt<192, MLA_LA>(pA0, pA1, lds + MLA_K0, qr, r32, hi); partialSM<1>(pA0, pA1, m_reg, mnA, alA, C, thr_raw);
    WAIT_BAR(0);
    for (int j = 1; j + 1 < NT; j += 2) {
      STEPA(pB0, pB1, mnB, alB, pA0, pA1, alA, j);
      STEPA(pA0, pA1, mnA, alA, pB0, pB1, alB, j + 1);
    }
    STEPA(pB0, pB1, mnB, alB, pA0, pA1, alA, NT - 1);
    finishSM(pB0, pB1, alB, l_reg, pa0, pa1, pa2, pa3); SBAR();
    pv_d0(o, vb0 + s_m1 * MLA_VSLOT, pa0, pa1, pa2, pa3);
  } else {
    __builtin_amdgcn_s_setprio(1);
    qkt<192, MLA_LA>(pA0, pA1, lds + MLA_K0, qr, r32, hi);
    WAIT_BAR(0);
    for (int j = 1; j + 1 < NT; j += 2) {
      STEPB(pB0, pB1, pA0, pA1, j);
      STEPB(pA0, pA1, pB0, pB1, j + 1);
    }
    STEPB(pB0, pB1, pA0, pA1, NT - 1);
    partialSM<1>(pB0, pB1, m_reg, mnB, alB, C, thr_raw); RESC(alB);
    finishSM(pB0, pB1, alB, l_reg, pa0, pa1, pa2, pa3); SBAR();
    pv_d0(o, vb0 + s_m1 * MLA_VSLOT, pa0, pa1, pa2, pa3);
  }
#undef STEPA
#undef STEPB
  __builtin_amdgcn_s_setprio(0);
  (void)mnA; (void)mnB;
#undef ROT
#undef RESC
#undef DMA_K
#undef DMA_V
  if (hi == 0) li_l[r32] = l_reg;
  WAIT_BAR(0);
  float rli[16];
#pragma unroll
  for (int r = 0; r < 16; ++r) rli[r] = __builtin_amdgcn_rcpf(li_l[crow(r, hi)]);
  ATT_LAS bf16_t* stg = (ATT_LAS bf16_t*)(lds + MLA_K0) + wid * 4096;
#pragma unroll
  for (int r = 0; r < 16; ++r) { const int orow = crow(r, hi);
#pragma unroll
    for (int d0 = 0; d0 < 4; ++d0) stg[orow * 128 + d0 * 32 + r32] = f2bf(o[d0][r] * rli[r]); }
  asm volatile("s_waitcnt lgkmcnt(0)" ::: "memory");
  bf16_t* Ow = Ob + (long)(wid * 32) * ldo;
#pragma unroll
  for (int i = 0; i < 8; ++i) { const int row = i * 4 + (lane >> 4), ch = lane & 15; const u32x4 v = *(const ATT_LAS u32x4*)(stg + row * 128 + ch * 8); *(u32x4*)(Ow + (long)row * ldo + ch * 8) = v; }
  WAIT_BAR(0);
}

__device__ __forceinline__ void mla_unit_pp(const bf16_t* Qb, const bf16_t* Kh, const bf16_t* Vh, bf16_t* Ob, long ldo, int NT, float scale, ATT_LAS char* lds, int wave_s) {
  int tid_l = wave_s * 64 + mk_lane(); asm volatile("" : "+v"(tid_l));
  const int tid = tid_l, wid = __builtin_amdgcn_readfirstlane(tid >> 6), lane = tid & 63, r32 = lane & 31, hi = lane >> 5;
  const bool H1 = wid >= 4;
  const unsigned lds0 = (unsigned)(uintptr_t)lds;
  ATT_LAS float* wsf = (ATT_LAS float*)(lds + MLA_WS) + wid * 64; ATT_LAS float* li_l = wsf; ATT_LAS float* al_l = wsf + 32;
  (void)scale;
  int ksrc[4], vsrc[2];
#pragma unroll
  for (int i = 0; i < 4; ++i) { const int gch = 64 * (wid + 8 * i) + lane, row = gch / 25, cc = gch % 25; ksrc[i] = row * 384 + (cc < 24 ? cc * 16 : 0); }
#pragma unroll
  for (int i = 0; i < 2; ++i) { const int B = 1024 * (2 * wid + i) + 16 * lane, sub = B >> 9, e = (B & 511) >> 1, kk = (sub >> 2) * 8 + (e >> 5), c = (sub & 3) * 32 + (e & 31);
    const int k = (kk & ~0xC) | ((kk & 4) << 1) | ((kk & 8) >> 1); vsrc[i] = (k * 128 + c) * 2; }
#define DMA_T(t, slot) do { const int t_ = (t) < NT ? (t) : NT - 1; const char* gk_ = (const char*)Kh + (long)t_ * MLA_KTILE; const char* gv_ = (const char*)Vh + (long)t_ * MLA_VSLOT; \
    _Pragma("unroll") for (int i_ = 0; i_ < 4; ++i_) if (i_ < 3 || wid == 0) glds16s(gk_, ksrc[i_], (unsigned)__builtin_amdgcn_readfirstlane(lds0 + MLA_K0 + (slot) * MLA_KSLOT + 1024 * (wid + 8 * i_))); \
    _Pragma("unroll") for (int i_ = 0; i_ < 2; ++i_) glds16s(gv_, vsrc[i_], (unsigned)__builtin_amdgcn_readfirstlane(lds0 + MLA_V0 + (slot) * MLA_VSLOT + 1024 * (2 * wid + i_))); } while (0)
  DMA_T(0, 0); DMA_T(1, 1);
  bf16x8 qr[12];
  { const bf16_t* Qw = Qb + (long)(wid * 32 + r32) * 192 + hi * 8;
#pragma unroll
    for (int d0 = 0; d0 < 12; ++d0) qr[d0] = *(const bf16x8*)(Qw + d0 * 16); }
  float mref = 0.f, l_reg = 0.f; f32x16 o[4] = {}; f32x16 negm = {};
  const float thr2 = 8.0f * 1.4426950408889634f;
  const int vb0 = (int)(lds0 + MLA_V0) + v_rd_base(lane);
  WAIT_BAR(0);
  if (H1) WAIT_BAR2(6, 5);
  int s_0 = 0, s_2 = 2;
  for (int j = 0; j < NT; ++j) {
    if (H1) DMA_T(j + 2, s_2);
    f32x16 p0, p1; float alpha;
    SBAR(); __builtin_amdgcn_s_setprio(1);
    qkt_c<192, MLA_PP_LA>(p0, p1, lds + MLA_K0 + s_0 * MLA_KSLOT, qr, r32, hi, negm);
    __builtin_amdgcn_s_setprio(0);
    partialSM_ref(p0, p1, mref, negm, alpha, thr2, j == 0, (j & 7) == 0);
    WAIT_BAR2(6, 5);
    if (!H1) DMA_T(j + 2, s_2);
    bf16x8 pa0, pa1, pa2, pa3; finishSM_np(p0, p1, alpha, l_reg, pa0, pa1, pa2, pa3);
    if (__any(alpha < 1.f)) { if (hi == 0) al_l[r32] = alpha; asm volatile("s_waitcnt lgkmcnt(0)" ::: "memory");
#pragma unroll
      for (int d = 0; d < 4; ++d)
#pragma unroll
        for (int r = 0; r < 16; ++r) o[d][r] *= al_l[crow(r, hi)]; }
    SBAR(); __builtin_amdgcn_s_setprio(1);
    pv_d0_la(o, vb0 + s_0 * MLA_VSLOT, pa0, pa1, pa2, pa3);
    __builtin_amdgcn_s_setprio(0);
    WAIT_BAR2(6, 5);
    s_2 = s_0; s_0 = (s_0 == 2) ? 0 : s_0 + 1;
  }
  if (!H1) WAIT_BAR2(6, 5);
#undef DMA_T
  if (hi == 0) li_l[r32] = l_reg;
  WAIT_BAR(0);
  float rli[16];
#pragma unroll
  for (int r = 0; r < 16; ++r) rli[r] = __builtin_amdgcn_rcpf(li_l[crow(r, hi)]);
  ATT_LAS bf16_t* stg = (ATT_LAS bf16_t*)(lds + MLA_K0) + wid * 4096;
#pragma unroll
  for (int r = 0; r < 16; ++r) { const int orow = crow(r, hi);
#pragma unroll
    for (int d0 = 0; d0 < 4; ++d0) stg[orow * 128 + d0 * 32 + r32] = f2bf(o[d0][r] * rli[r]); }
  asm volatile("s_waitcnt lgkmcnt(0)" ::: "memory");
  bf16_t* Ow = Ob + (long)(wid * 32) * ldo;
#pragma unroll
  for (int i = 0; i < 8; ++i) { const int row = i * 4 + (lane >> 4), ch = lane & 15; const u32x4 v = *(const ATT_LAS u32x4*)(stg + row * 128 + ch * 8); *(u32x4*)(Ow + (long)row * ldo + ch * 8) = v; }
  WAIT_BAR(0);
}

constexpr int DIL_KB = 64 * 272, DIL_SLOT = DIL_KB + 16384, DIL_WS = 3 * DIL_SLOT, DIL_STG = DIL_WS + 8 * 256, DIL_LDS = DIL_STG + 8 * 4096;
__device__ __forceinline__ void dil_unit(const bf16_t* Qs, const bf16_t* Ks, const bf16_t* Vs, bf16_t* Os, float* lses, long ld, long ldl, int qb_first, int nqb, int L64, float scale, ATT_LAS char* lds, int wave_s, bool dry = false) {
  int tid_l = wave_s * 64 + mk_lane(); asm volatile("" : "+v"(tid_l));
  const int tid = tid_l, wid = __builtin_amdgcn_readfirstlane(tid >> 6), lane = tid & 63, r32 = lane & 31, hi = lane >> 5, pair = wid >> 1, sub = wid & 1;
  const unsigned lds0 = (unsigned)(uintptr_t)lds;
  ATT_LAS float* wsf = (ATT_LAS float*)(lds + DIL_WS) + wid * 64; ATT_LAS float* li_l = wsf; ATT_LAS float* al_l = wsf + 32;
  ATT_LAS bf16_t* stg = (ATT_LAS bf16_t*)(lds + DIL_STG) + wid * 2048;
  const float C = scale * 1.4426950408889634f, thr_raw = 8.0f / scale;
  const int kt_lo = qb_first > 0 ? qb_first - 1 : 0, qb_end = qb_first + nqb, kt_hi = qb_end + 1 < L64 ? qb_end + 1 : L64;
  const long ld2 = ld * 2, ts = 64 * ld2;
  long koff[3], voff[2];
#pragma unroll
  for (int i = 0; i < 3; ++i) { const int gch = 64 * (wid + 8 * i) + lane, row = gch / 17, cc = gch % 17; koff[i] = row * ld2 + (cc < 16 ? cc * 16 : 0); }
#pragma unroll
  for (int i = 0; i < 2; ++i) { const int B = 1024 * (2 * wid + i) + 16 * lane, sb = B >> 9, e = (B & 511) >> 1, kk = (sb >> 2) * 8 + (e >> 5), c = (sb & 3) * 32 + (e & 31);
    const int k = (kk & ~0xC) | ((kk & 4) << 1) | ((kk & 8) >> 1); voff[i] = k * ld2 + c * 2; }
#define DMA_T(t, slot) do { const int t_ = (t) < kt_hi ? (t) : kt_hi - 1; const char* gk_ = (const char*)Ks + t_ * ts; const char* gv_ = (const char*)Vs + t_ * ts; \
    _Pragma("unroll") for (int i_ = 0; i_ < 3; ++i_) if (i_ < 2 || wid == 0) glds16(gk_ + koff[i_], (unsigned)__builtin_amdgcn_readfirstlane(lds0 + (slot) * DIL_SLOT + 1024 * (wid + 8 * i_))); \
    _Pragma("unroll") for (int i_ = 0; i_ < 2; ++i_) glds16(gv_ + voff[i_], (unsigned)__builtin_amdgcn_readfirstlane(lds0 + (slot) * DIL_SLOT + DIL_KB + 1024 * (2 * wid + i_))); } while (0)
  DMA_T(kt_lo, 0); DMA_T(kt_lo + 1, 1);
  int qb = qb_first + pair; bool have = qb < qb_end;
  bf16x8 qr[8];
#define QLOAD() do { const bf16_t* Qw_ = Qs + (long)(qb * 64 + sub * 32 + r32) * ld + hi * 8; \
    _Pragma("unroll") for (int d0 = 0; d0 < 8; ++d0) qr[d0] = *(const bf16x8*)(Qw_ + d0 * 16); } while (0)
#define QPIN() do { _Pragma("unroll") for (int d0 = 0; d0 < 8; ++d0) asm volatile("" : "+v"(qr[d0])); } while (0)
  if (have) QLOAD();
  float m_reg = -1e30f, l_reg = 0.f; f32x16 o[4] = {};
  const int qi = sub * 32 + r32;
  const int vb0 = (int)lds0 + DIL_KB + v_rd_base(lane);
#define BLOCK_EPI() do { if (hi == 0) li_l[r32] = l_reg; asm volatile("s_waitcnt lgkmcnt(0)" ::: "memory"); \
    float rli[16]; _Pragma("unroll") for (int r = 0; r < 16; ++r) rli[r] = __builtin_amdgcn_rcpf(li_l[crow(r, hi)]); \
    bf16_t* Ow_ = Os + (long)(qb * 64 + sub * 32) * ld; \
    _Pragma("unroll") for (int hf = 0; hf < 2; ++hf) { \
      _Pragma("unroll") for (int r = 0; r < 16; ++r) { const int orow = crow(r, hi); \
        _Pragma("unroll") for (int dd = 0; dd < 2; ++dd) stg[orow * 64 + dd * 32 + r32] = f2bf(o[hf * 2 + dd][r] * rli[r]); } \
      asm volatile("s_waitcnt lgkmcnt(0)" ::: "memory"); \
      _Pragma("unroll") for (int i = 0; i < 4; ++i) { const int row = i * 8 + (lane >> 3), ch = lane & 7; const u32x4 v = *(const ATT_LAS u32x4*)(stg + row * 64 + ch * 8); \
        if (!dry) *(u32x4*)(Ow_ + (long)row * ld + hf * 64 + ch * 8) = v; } \
      asm volatile("s_waitcnt lgkmcnt(0)" ::: "memory"); } \
    if (hi == 0 && !dry) lses[(long)(qb * 64 + sub * 32 + r32) * ldl] = m_reg * scale + __logf(l_reg); } while (0)
  WAIT_BAR(0);
  int s_0 = 0, s_1 = 1, s_2 = 2;
  for (int t = kt_lo; t < kt_hi; ++t) {
    if (have && t >= qb - 1 && t <= qb + 1) {
      f32x16 p0, p1; qkt<128>(p0, p1, lds + s_0 * DIL_SLOT, qr, r32, hi);
      if (t == qb - 1) {
#pragma unroll
        for (int r = 0; r < 16; ++r) { const int k0 = crow(r, hi); if (k0 < qi) p0[r] = -1e30f; if (k0 + 32 < qi) p1[r] = -1e30f; }
      } else if (t == qb + 1) {
#pragma unroll
        for (int r = 0; r < 16; ++r) { const int k0 = crow(r, hi); if (k0 > qi) p0[r] = -1e30f; if (k0 + 32 > qi) p1[r] = -1e30f; }
      }
      float mn, alpha; partialSM<1>(p0, p1, m_reg, mn, alpha, C, thr_raw); (void)mn;
      bf16x8 pa0, pa1, pa2, pa3; finishSM(p0, p1, alpha, l_reg, pa0, pa1, pa2, pa3);
      if (__any(alpha < 1.f)) { if (hi == 0) al_l[r32] = alpha; asm volatile("s_waitcnt lgkmcnt(0)" ::: "memory");
#pragma unroll
        for (int d = 0; d < 4; ++d)
#pragma unroll
          for (int r = 0; r < 16; ++r) o[d][r] *= al_l[crow(r, hi)]; }
      pv_d0(o, vb0 + s_0 * DIL_SLOT, pa0, pa1, pa2, pa3);
    } else if (have && t == qb + 2) {
      BLOCK_EPI();
      qb += 4; have = qb < qb_end; m_reg = -1e30f; l_reg = 0.f;
#pragma unroll
      for (int d = 0; d < 4; ++d) o[d] = f32x16{};
      if (have) { QLOAD(); QPIN(); }
    }
    DMA_T(t + 2, s_2);
    WAIT_BAR2(5, 4);
    { const int t_ = s_0; s_0 = s_1; s_1 = s_2; s_2 = t_; }
  }
  if (have) BLOCK_EPI();
  WAIT_BAR(0);
#undef DMA_T
#undef QLOAD
#undef QPIN
#undef BLOCK_EPI
}
#undef WAIT_BAR
#undef SBAR
}

#define LAS __attribute__((address_space(3)))
typedef unsigned short bf16;
typedef float f32x4 __attribute__((ext_vector_type(4)));
typedef unsigned v4u __attribute__((ext_vector_type(4)));
typedef unsigned v2u __attribute__((ext_vector_type(2)));
typedef short bf16x8 __attribute__((ext_vector_type(8)));

constexpr int NWAVES = 8, NTHR = 512;
constexpr int BATCH = 8, SEQ = 8192, DM = 1024, M = BATCH * SEQ, FF = 4096;
#ifndef MK_NCH
#define MK_NCH 4
#endif
constexpr int NCH = MK_NCH, MH = M / NCH, BPC = BATCH / NCH;
constexpr int NQKV = 9216;
constexpr size_t MiB = 1u << 20;
constexpr size_t WS_WQKV = 1 * MiB, WS_WOA = 19 * MiB, WS_W1 = 21 * MiB, WS_W2 = 37 * MiB, WS_WIN = 53 * MiB, WS_WQB = 54 * MiB, WS_WKVB = 55 * MiB, WS_WOB = 56 * MiB;
constexpr size_t WS_COS128 = 58 * MiB, WS_SIN128 = 60 * MiB, WS_COS64 = 62 * MiB, WS_SIN64 = 63 * MiB;
constexpr size_t WS_LSE = 64 * MiB, WS_SSR = 67 * MiB;
constexpr size_t WS_RS = 68 * MiB, WS_RS2 = 70 * MiB;
constexpr size_t WS_HN = 128 * MiB;
constexpr size_t WS_QKVH = 256 * MiB;
constexpr size_t WS_ACT = 256 * MiB;
constexpr size_t WS_CQN = 256 * MiB, WS_CKVN = 288 * MiB, WS_KR = 320 * MiB;
constexpr size_t WS_Q = 384 * MiB, WS_K = 576 * MiB, WS_V = 768 * MiB;
constexpr size_t WS_AO = 896 * MiB;
constexpr size_t WS_END = 1024 * MiB;
constexpr int RING_BYTES = 131072, XCH_OFF = RING_BYTES, LDS_BYTES = 147456;

#define RLX_AGENT __ATOMIC_RELAXED, __HIP_MEMORY_SCOPE_AGENT
#define XB_TMO      128
#define XB_XCNT(j)  (256  + 64 * (j))
#define XB_XSUB(j)  (1280 + 64 * (j))
#define XB_XGEN(j)  (2304 + 64 * (j))
#define XB_TOP      3328
#define XB_TOPGEN   3392
#define XCD_BAR_WORDS 3456
#define XB_SPIN_CAP (1u << 18)

__device__ __forceinline__ unsigned xb_ld(unsigned* p)              { return __hip_atomic_load(p, __ATOMIC_RELAXED, __HIP_MEMORY_SCOPE_AGENT); }
__device__ __forceinline__ unsigned xb_add(unsigned* p, unsigned v) { return __hip_atomic_fetch_add(p, v, __ATOMIC_RELAXED, __HIP_MEMORY_SCOPE_AGENT); }
__device__ __forceinline__ unsigned xb_xcc_id() { return (unsigned)__builtin_amdgcn_s_getreg((3 << 11) | 20) & 0xFu; }
#define XB_SPIN(cond, bar) do { unsigned _sp = 0; while (cond) { __builtin_amdgcn_s_sleep(1); \
    if ((++_sp & 255u) == 0u) { if (xb_ld(&(bar)[XB_TMO])) break; if (_sp > XB_SPIN_CAP) { atomicAdd(&(bar)[XB_TMO], 1u); break; } } } } while (0)

struct XcdBarrier {
    unsigned* bar; unsigned x; int wave;
    volatile LAS unsigned* st;
};

__device__ __forceinline__ XcdBarrier xcd_barrier_post(unsigned* bar, volatile LAS unsigned* st, int wave_s) {
    XcdBarrier b; b.bar = bar; b.x = xb_xcc_id(); b.st = st; b.wave = wave_s;
    if (wave_s == 0 && mk_lane() == 0) (void)xb_add(&bar[XB_XCNT(b.x)], 1u);
    return b;
}
__device__ __forceinline__ void xcd_barrier_complete(unsigned* bar, unsigned x, unsigned& nloc, unsigned& nx) {
    const unsigned G = gridDim.x * gridDim.y * gridDim.z;
    unsigned sum, cnt, mine, sp = 0u;
    for (;;) {
        sum = 0u; cnt = 0u; mine = 0u;
#pragma unroll
        for (unsigned j = 0; j < 16; ++j) { const unsigned c = xb_ld(&bar[XB_XCNT(j)]); sum += c; cnt += (c > 0u) ? 1u : 0u; mine = (j == x) ? c : mine; }
        if (sum == G) break;
        __builtin_amdgcn_s_sleep(1);
        if ((++sp & 255u) == 0u) { if (xb_ld(&bar[XB_TMO])) break; if (sp > XB_SPIN_CAP) { atomicAdd(&bar[XB_TMO], 1u); break; } }
    }
    nloc = mine > 0u ? mine : 1u; nx = cnt > 0u ? cnt : 1u;
}

__device__ __forceinline__ void xcd_barrier(const XcdBarrier& b) {
    asm volatile("s_waitcnt vmcnt(0)" ::: "memory");
    __syncthreads();
    if (b.wave == 0 && mk_lane() == 0) {
        unsigned* bar = b.bar;
        __builtin_amdgcn_s_waitcnt(0);
        unsigned nloc = b.st[0], nx = b.st[1];
        if (nloc == 0u) { xcd_barrier_complete(bar, b.x, nloc, nx); b.st[0] = nloc; b.st[1] = nx; }
        const unsigned old = xb_add(&bar[XB_XSUB(b.x)], 1u);
        const unsigned gen = old / nloc;
        if (old + 1u == (gen + 1u) * nloc) {
            __builtin_amdgcn_fence(__ATOMIC_RELEASE, "agent");
            asm volatile("s_waitcnt vmcnt(0)" ::: "memory");
            const unsigned og = xb_add(&bar[XB_TOP], 1u);
            const unsigned tg = og / nx;
            if (og + 1u == (tg + 1u) * nx) xb_add(&bar[XB_TOPGEN], 1u);
            else XB_SPIN(xb_ld(&bar[XB_TOPGEN]) == tg, bar);
            __builtin_amdgcn_fence(__ATOMIC_ACQUIRE, "agent");
            xb_add(&bar[XB_XGEN(b.x)], 1u);
            asm volatile("s_waitcnt vmcnt(0)" ::: "memory");
        } else {
            XB_SPIN(xb_ld(&bar[XB_XGEN(b.x)]) == gen, bar);
            __builtin_amdgcn_fence(__ATOMIC_ACQUIRE, "agent");
            asm volatile("s_waitcnt vmcnt(0)" ::: "memory");
        }
    }
    __syncthreads();
}

constexpr size_t WS_BAR = 0, BAR_ZERO_BYTES = 16384;

#ifndef STAG_SLEEPS
#define STAG_SLEEPS 1
#endif
__device__ __forceinline__ void stagger(int bx) { if (STAG_SLEEPS > 0) for (int i = 0; i < bx; ++i) __builtin_amdgcn_s_sleep(STAG_SLEEPS); }
__device__ __forceinline__ unsigned char* ws_fresh(unsigned char* w) { asm volatile("" : "+s"(w)); return w; }
struct Params {
  const float* x; const float* norm_mix; const float* norm_ffn; const float* a_w_qkv; const float* a_q_gain; const float* a_k_gain; const float* a_w_o;
  const float* b_w_in; const float* b_q_a_gain; const float* b_w_qb; const float* b_kv_a_gain; const float* b_w_kvb; const float* b_q_gain; const float* b_k_gain; const float* b_w_o;
  const float* ffn_w1; const float* ffn_w2; float* out; unsigned char* ws;
};

__device__ __forceinline__ unsigned f2bf_rne(float f) { unsigned u = __builtin_bit_cast(unsigned, f); return (u + 0x7fffu + ((u >> 16) & 1u)) >> 16; }
__device__ __forceinline__ unsigned pk2(float lo, float hi) { return f2bf_rne(lo) | (f2bf_rne(hi) << 16); }
__device__ __forceinline__ float wave_sum(float v) {
#pragma unroll
  for (int o = 1; o < 64; o <<= 1) v += __shfl_xor(v, o);
  return v;
}
__device__ __forceinline__ int rope_perm128(int p) { const int wc = p >> 5, fq = (p >> 3) & 3, n = (p >> 2) & 1, j = p & 3; return 16 * wc + 4 * fq + j + 64 * n; }
__device__ __forceinline__ int rope_perm64(int p) { const int wc = p >> 5, fq = (p >> 3) & 3, n = (p >> 2) & 1, j = p & 3; return wc >= 2 ? -1 : 16 * wc + 4 * fq + j + 32 * n; }
template <int MAP> __device__ __forceinline__ int src_col(int n) {
  if (MAP == 1) { if (n >= 6144) return n; const int p = n & 255, bj = p >> 7, pp = p & 127; return (n - p) + (pp >> 6) * 128 + (pp & 63) + 64 * bj; }
  if (MAP == 2) { if (n < 384) return n; const int q = rope_perm64(n - 384); return q < 0 ? -1 : 384 + q; }
  if (MAP == 3) { const int h = n >> 8, p = n & 255; if (p < 128) return h * 192 + p; const int q = rope_perm64(p - 128); return q < 0 ? -1 : h * 192 + 128 + q; }
  if (MAP == 4) { const int p = n & 255, bj = p >> 7, wc = (p >> 5) & 3, i = p & 31; return (n - p) + wc * 64 + bj * 32 + i; }
  return n;
}
template <int MAP> __device__ __forceinline__ void wt_convert(const float* W, int Klog, int Nlog, int Kphys, int Nphys, bf16* WT, int gw, int NGW, int lane, const float* gain = nullptr) {
  const int nkb = Kphys / 8, nnb = Nphys / 64;
#pragma unroll 4
  for (int it = gw; it < nkb * nnb; it += NGW) {
    const int nb = it % nnb, kb = it / nnb, n = nb * 64 + lane, src = src_col<MAP>(n), k0 = kb * 8;
    float v[8];
#pragma unroll
    for (int i = 0; i < 8; ++i) v[i] = (src >= 0 && k0 + i < Klog) ? W[(size_t)(k0 + i) * Nlog + src] : 0.f;
    if (gain != nullptr) {
#pragma unroll
      for (int i = 0; i < 8; ++i) v[i] *= gain[k0 + i]; }
    v4u o; o.x = pk2(v[0], v[1]); o.y = pk2(v[2], v[3]); o.z = pk2(v[4], v[5]); o.w = pk2(v[6], v[7]);
    *(v4u*)(WT + (size_t)n * Kphys + k0) = o;
  }
}
__device__ __forceinline__ void rope_table(float* cosT, float* sinT, int half_d, int gtid, int NGT, bool as_half = false) {
  for (int id = gtid; id < SEQ * half_d; id += NGT) {
    const int pos = id / half_d, i = id % half_d;
    const float freq = powf(10000.0f, -(float)i / (float)half_d);
    const float angf = (float)pos * freq;
    const double a = (double)angf, k = rint(a * 0.15915494309189535), red = a - k * 6.283185307179586;
    const float r = (float)red;
    if (as_half) { ((_Float16*)cosT)[id] = (_Float16)cosf(r); ((_Float16*)sinT)[id] = (_Float16)sinf(r); } else { cosT[id] = cosf(r); sinT[id] = sinf(r); }
  }
}
__device__ __forceinline__ void xb_rows(const float* src, bf16* dst, float* rs, int gw, int NGW, int lane) {
#pragma unroll 4
  for (int row = gw; row < M; row += NGW) {
    const f32x4* xr = (const f32x4*)(src + (size_t)row * DM) + lane;
    f32x4 v[4]; float s = 0.f;
#pragma unroll
    for (int j = 0; j < 4; ++j) { v[j] = xr[64 * j]; s += (v[j][0] * v[j][0] + v[j][1] * v[j][1]) + (v[j][2] * v[j][2] + v[j][3] * v[j][3]); }
    s = wave_sum(s);
    v2u* o8 = (v2u*)(dst + (size_t)row * DM) + lane;
#pragma unroll
    for (int j = 0; j < 4; ++j) { v2u w; w.x = pk2(v[j][0], v[j][1]); w.y = pk2(v[j][2], v[j][3]); o8[64 * j] = w; }
    if (lane < 4) rs[(size_t)row * 4 + lane] = lane == 0 ? s : 0.f;
  }
}
__device__ __forceinline__ void merge_half(const bf16* qkvh, const float* lse, bf16* ao_half, int gtid, int NGT) {
  for (int id = gtid; id < MH * 128; id += NGT) {
    const int tok = id >> 7, c8 = id & 127, h = c8 >> 4;
    const float l0 = lse[((size_t)0 * MH + tok) * 8 + h], l1 = lse[((size_t)1 * MH + tok) * 8 + h], l2 = lse[((size_t)2 * MH + tok) * 8 + h];
    const float mx = fmaxf(l0, fmaxf(l1, l2));
    float w0 = __expf(l0 - mx), w1 = __expf(l1 - mx), w2 = __expf(l2 - mx);
    const float inv = 1.0f / (w0 + w1 + w2); w0 *= inv; w1 *= inv; w2 *= inv;
    const bf16* p = qkvh + (size_t)tok * NQKV + c8 * 8;
    const v4u a = *(const v4u*)p, b = *(const v4u*)(p + 1024), c = *(const v4u*)(p + 2048);
    v4u o;
#pragma unroll
    for (int e = 0; e < 4; ++e) {
      const float alo = __uint_as_float(a[e] << 16), ahi = __uint_as_float(a[e] & 0xffff0000u);
      const float blo = __uint_as_float(b[e] << 16), bhi = __uint_as_float(b[e] & 0xffff0000u);
      const float clo = __uint_as_float(c[e] << 16), chi = __uint_as_float(c[e] & 0xffff0000u);
      o[e] = pk2(w0 * alo + w1 * blo + w2 * clo, w0 * ahi + w1 * bhi + w2 * chi);
    }
    *(v4u*)(ao_half + (size_t)tok * DM + c8 * 8) = o;
  }
}

__global__ void __launch_bounds__(NTHR) fwd_megakernel(Params p) {
  extern __shared__ __attribute__((aligned(16))) unsigned char lds_raw[];
  cg::grid_group grid = cg::this_grid();
  LAS unsigned char* lds = (LAS unsigned char*)lds_raw;
  LAS float* XP = (LAS float*)(lds + XCH_OFF);
  const int G = gridDim.x, bx = blockIdx.x, NGW = G * NWAVES, NGT = G * NTHR;
  volatile LAS unsigned* bst = (volatile LAS unsigned*)(lds + XCH_OFF + 8192);
  const int wave_s = __builtin_amdgcn_readfirstlane((int)threadIdx.x >> 6);
  if (wave_s == 0 && mk_lane() < 4) bst[mk_lane()] = 0u;
  __syncthreads();
  XcdBarrier xbar = xcd_barrier_post((unsigned*)(p.ws + WS_BAR), bst, wave_s);
#define GRID_BAR() xcd_barrier(xbar)
#define FRESH_IDS() int tid_f = wave_s * 64 + mk_lane(); asm volatile("" : "+v"(tid_f)); const int lane = tid_f & 63, gw = bx * NWAVES + wave_s, gtid = bx * NTHR + tid_f; (void)lane; (void)gw; (void)gtid
  unsigned char* ws = p.ws;
  bf16* WQKV = (bf16*)(ws + WS_WQKV); bf16* WOA = (bf16*)(ws + WS_WOA); bf16* W1 = (bf16*)(ws + WS_W1); bf16* W2 = (bf16*)(ws + WS_W2);
  bf16* WIN = (bf16*)(ws + WS_WIN); bf16* WQB = (bf16*)(ws + WS_WQB); bf16* WKVB = (bf16*)(ws + WS_WKVB); bf16* WOB = (bf16*)(ws + WS_WOB);
  float* COS128 = (float*)(ws + WS_COS128); float* SIN128 = (float*)(ws + WS_SIN128); float* COS64 = (float*)(ws + WS_COS64); float* SIN64 = (float*)(ws + WS_SIN64);
  float* LSE = (float*)(ws + WS_LSE); float* SSR = (float*)(ws + WS_SSR);
  bf16* HN = (bf16*)(ws + WS_HN); float* RS = (float*)(ws + WS_RS); float* RS2 = (float*)(ws + WS_RS2); bf16* QKVH = (bf16*)(ws + WS_QKVH); bf16* ACT = (bf16*)(ws + WS_ACT);
  bf16* CQN = (bf16*)(ws + WS_CQN); bf16* CKVN = (bf16*)(ws + WS_CKVN); float* KR = (float*)(ws + WS_KR);
  bf16* QB = (bf16*)(ws + WS_Q); bf16* KB = (bf16*)(ws + WS_K); bf16* VB = (bf16*)(ws + WS_V); bf16* AO = (bf16*)(ws + WS_AO);

#ifndef SEL
#define SEL 0xffff
#endif
#ifndef PROBE_EW_REPS
#define PROBE_EW_REPS 1
#endif
#ifndef PROBE_GEMM_REPS
#define PROBE_GEMM_REPS 1
#endif
#if SEL & 1
  for (int rep_ = 0; rep_ < PROBE_EW_REPS; ++rep_)
  { FRESH_IDS();
  wt_convert<1>(p.a_w_qkv, DM, NQKV, DM, NQKV, WQKV, gw, NGW, lane, p.norm_mix);
  wt_convert<0>(p.a_w_o, DM, DM, DM, DM, WOA, gw, NGW, lane);
  wt_convert<0>(p.ffn_w1, DM, FF, DM, FF, W1, gw, NGW, lane, p.norm_ffn);
  wt_convert<0>(p.ffn_w1 + (size_t)DM * FF, DM, FF, DM, FF, W1 + (size_t)DM * FF, gw, NGW, lane, p.norm_ffn + DM);
  wt_convert<0>(p.ffn_w2, FF, DM, FF, DM, W2, gw, NGW, lane);
  wt_convert<0>(p.ffn_w2 + (size_t)DM * FF, FF, DM, FF, DM, W2 + (size_t)DM * FF, gw, NGW, lane);
  wt_convert<2>(p.b_w_in, DM, 448, DM, 512, WIN, gw, NGW, lane, p.norm_mix + DM);
  wt_convert<3>(p.b_w_qb, 256, 1536, 256, 2048, WQB, gw, NGW, lane);
  wt_convert<0>(p.b_w_kvb, 128, 2048, 128, 2048, WKVB, gw, NGW, lane);
  wt_convert<0>(p.b_w_o, DM, DM, DM, DM, WOB, gw, NGW, lane);
  rope_table(COS128, SIN128, 64, gtid, NGT, true);
  rope_table(COS64, SIN64, 32, gtid, NGT);
  xb_rows(p.x, HN, RS, gw, NGW, lane); }
#endif
  grid.sync();

#ifdef PROBE_EXTRA_SYNCS
  for (int i_ = 0; i_ < PROBE_EXTRA_SYNCS; ++i_) grid.sync();
#endif
  for (int layer = 0; layer < 2; ++layer) {
    if (layer == 0) {
      for (int half = 0; half < NCH; ++half) {
        for (int rep_ = 0; rep_ < PROBE_GEMM_REPS; ++rep_)
        { pg8::Gemm g{HN + (size_t)half * MH * DM, WQKV, MH, NQKV, DM}; pg8::StaticOrder S; S.init(MH, NQKV, G, bx);
          pg8::EpiQKVA E{QKVH, p.a_q_gain, p.a_k_gain, COS128, SIN128, XP, RS, half * MH};
          pg8::gemm_phase<pg8::EpiQKVA, pg8::StaticOrder, true, true>(lds, g, S, E, wave_s); }
        GRID_BAR();
        int uid0 = bx; asm volatile("" : "+s"(uid0));
        for (int uid = uid0; uid < BPC * 256; uid += G) {
          int g, r, nqb, L64, rem;
          if (uid < BPC * 64) { g = 0; r = 1; nqb = 16; L64 = 128; rem = uid; } else if (uid < BPC * 128) { g = 1; r = 4; nqb = 16; L64 = 32; rem = uid - BPC * 64; } else { g = 2; r = 16; nqb = 8; L64 = 8; rem = uid - BPC * 128; }
          const int per = (g == 2) ? 16 : 8, sub_i = rem % per, bhh = rem / per, h = bhh & 7, bl = bhh >> 3;
          const int nch = L64 / nqb, c = sub_i / nch, ch = sub_i % nch;
          const long ld = (long)r * NQKV;
          const bf16* qp = QKVH + ((size_t)bl * SEQ + c) * NQKV + g * 1024 + h * 128;
          att::dil_unit(qp, qp + 3072, qp + 6144, (bf16*)qp, LSE + ((size_t)g * MH + (size_t)bl * SEQ + c) * 8 + h, ld, (long)r * 8, ch * nqb, nqb, L64, 0.08838834764831845f, (LAS char*)lds, wave_s);
        }
        GRID_BAR();
        for (int rep_ = 0; rep_ < PROBE_EW_REPS; ++rep_) { FRESH_IDS(); merge_half(QKVH, LSE, AO + (size_t)half * MH * DM, gtid, NGT); }
        GRID_BAR();
      }
    } else {
#if SEL & 16
      for (int rep_ = 0; rep_ < PROBE_GEMM_REPS; ++rep_)
      { pg8::Gemm g{HN, WIN, M, 512, DM}; pg8::StaticOrder S; S.init(M, 512, G, bx);
        pg8::EpiLat E{CQN, CKVN, KR, SSR, p.b_q_a_gain, p.b_kv_a_gain, p.b_k_gain, COS64, SIN64, XP, RS};
        pg8::gemm_phase<pg8::EpiLat, pg8::StaticOrder, true, true>(lds, g, S, E, wave_s); }
#endif
      GRID_BAR();
#if SEL & 32
      for (int rep_ = 0; rep_ < PROBE_GEMM_REPS; ++rep_) {
      { pg8::Gemm g{CQN, WQB, M, 2048, 256}; pg8::StaticOrder S; S.init(M, 2048, G, bx);
        pg8::EpiQB E{QB, p.b_q_gain, COS64, SIN64, XP};
        pg8::gemm_phase<pg8::EpiQB, pg8::StaticOrder, true, true>(lds, g, S, E, wave_s); }
#if SEL & 64
      { pg8::Gemm g{CKVN, WKVB, M, 2048, 128  }; pg8::StaticOrder S; S.init(M, 2048, G, bx);
        pg8::EpiKVB E{KB, VB, p.b_k_gain, KR, SSR, XP};
        pg8::gemm_phase<pg8::EpiKVB, pg8::StaticOrder, true, true>(lds, g, S, E, wave_s); }
      }
#endif
#endif
      GRID_BAR();
#if SEL & 128
#ifndef PROBE_MLA_REPS
#define PROBE_MLA_REPS 1
#endif
#ifdef PROBE_CLOCK
      const unsigned long long pc0_ = __builtin_amdgcn_s_memtime(), pr0_ = __builtin_amdgcn_s_memrealtime();
#endif
      for (int rep_ = 0; rep_ < PROBE_MLA_REPS; ++rep_)
      { const int xcd = bx & 7, loc = bx >> 3;
        for (int i = 0; ; ++i) {
          int bh, qb;
          if (G == 256) { if (i >= 8) break; bh = i * 8 + xcd; qb = loc; }
          else { const int uid = i * G + bx; if (uid >= 64 * 32) break; bh = uid >> 5; qb = uid & 31; }
          const int b = bh >> 3, h = bh & 7;
#ifndef PROBE_MLA_MODE
#define PROBE_MLA_MODE 0
#endif
          if (PROBE_MLA_REPS > 1 && rep_ == 0)
          att::mla_unit<PROBE_MLA_MODE>(QB + ((size_t)bh * SEQ + 256 * qb) * 192, KB + (size_t)bh * SEQ * 192, VB + (size_t)bh * SEQ * 128,
                        AO + ((size_t)b * SEQ + 256 * qb) * DM + h * 128, DM, SEQ / 64, 0.07216878364870322f, (LAS char*)lds, wave_s, p.ws == nullptr);
          else
          att::mla_unit_pp(QB + ((size_t)bh * SEQ + 256 * qb) * 192, KB + (size_t)bh * SEQ * 192, VB + (size_t)bh * SEQ * 128,
                        AO + ((size_t)b * SEQ + 256 * qb) * DM + h * 128, DM, SEQ / 64, 0.07216878364870322f, (LAS char*)lds, wave_s);
        } }
#endif
#ifdef PROBE_CLOCK
      { const unsigned long long pc1_ = __builtin_amdgcn_s_memtime(), pr1_ = __builtin_amdgcn_s_memrealtime();
        if (bx == PROBE_CLOCK && wave_s == 0 && mk_lane() == 0) { const float mhz_ = (float)(pc1_ - pc0_) * 100.0f / (float)(pr1_ - pr0_); ((float*)(p.ws + WS_BAR + 14336))[0] = (mhz_ > 1450.f ? 1000.f : 0.f) + (mhz_ > 1750.f ? 1000.f : 0.f) + (mhz_ > 2050.f ? 1000.f : 0.f) + (mhz_ > 2300.f ? 1000.f : 0.f); } }
#endif
      GRID_BAR();
    }
    { pg8::Gemm g{AO, layer == 0 ? WOA : WOB, M, DM, DM}; pg8::StaticOrder S; S.init(M, DM, G, bx);
      pg8::EpiResB E{HN, HN, RS2, XP, nullptr};
      pg8::gemm_phase<pg8::EpiResB, pg8::StaticOrder, true, true>(lds, g, S, E, wave_s); }
    GRID_BAR();
#ifndef PROBE_FFN1_REPS
#define PROBE_FFN1_REPS 1
#endif
#ifndef PROBE_FFN1_DRY
#define PROBE_FFN1_DRY 1
#endif
#ifdef STAG_FFN1
    for (int i_ = 0; i_ < bx; ++i_) __builtin_amdgcn_s_sleep(STAG_FFN1);
#endif
    for (int rep_ = 0; rep_ < PROBE_FFN1_REPS; ++rep_)
    { pg8::Gemm g{HN, W1 + (size_t)layer * DM * FF, M, FF, DM}; pg8::StaticOrder S; S.init(M, FF, G, bx);
      pg8::EpiRelu2 E{ACT, FF, (PROBE_FFN1_REPS > 1 && rep_ == 0) ? PROBE_FFN1_DRY : 0};
      pg8::gemm_phase<pg8::EpiRelu2, pg8::StaticOrder, true, true>(lds, g, S, E, wave_s); }
    GRID_BAR();
    if (layer == 0) {
      { pg8::Gemm g{ACT, W2, M, DM, FF}; pg8::StaticOrder S; S.init(M, DM, G, bx);
        pg8::EpiResB E{HN, HN, RS, XP, RS2};
        pg8::gemm_phase<pg8::EpiResB, pg8::StaticOrder, true, true>(lds, g, S, E, wave_s); }
      GRID_BAR();
    } else {
      pg8::Gemm g{ACT, W2 + (size_t)DM * FF, M, DM, FF}; pg8::StaticOrder S; S.init(M, DM, G, bx);
      pg8::EpiResF E{HN, p.out, RS2};
      pg8::gemm_phase<pg8::EpiResF, pg8::StaticOrder, true, true>(lds, g, S, E, wave_s);
    }
  }
#ifdef PROBE_CLOCK
  GRID_BAR();
  if (bx == 0 && wave_s == 0 && mk_lane() == 0) p.out[0] += ((float*)(p.ws + WS_BAR + 14336))[0];
#endif
}

extern "C" void kernel_launch(void* const* d_in, const int* in_sizes, int n_in, void* d_out, int out_size, void* d_ws, size_t ws_size, hipStream_t stream) {
  static int grid_blocks = 0;
  if (grid_blocks == 0) {
    if (n_in != 17 || in_sizes[0] != M * DM || out_size != M * DM || ws_size < WS_END) {
      fprintf(stderr, "kernel_launch: unexpected shapes: n_in %d in0 %d out %d ws %zu (need >= %zu)\n", n_in, n_in > 0 ? in_sizes[0] : -1, out_size, ws_size, (size_t)WS_END); grid_blocks = -1; return; }
    int dev = 0, cus = 0, per_cu = 0;
    hipGetDevice(&dev); hipDeviceGetAttribute(&cus, hipDeviceAttributeMultiprocessorCount, dev);
    if (hipFuncSetAttribute((const void*)fwd_megakernel, hipFuncAttributeMaxDynamicSharedMemorySize, LDS_BYTES) != hipSuccess) { fprintf(stderr, "kernel_launch: hipFuncSetAttribute failed\n"); grid_blocks = -1; return; }
    if (hipOccupancyMaxActiveBlocksPerMultiprocessor(&per_cu, (const void*)fwd_megakernel, NTHR, LDS_BYTES) != hipSuccess || per_cu < 1) { fprintf(stderr, "kernel_launch: occupancy query gives %d\n", per_cu); per_cu = 1; }
    (void)hipGetLastError();
    grid_blocks = cus * per_cu;
  }
  if (grid_blocks < 0) return;
  Params p{};
  p.x = (const float*)d_in[0]; p.norm_mix = (const float*)d_in[1]; p.norm_ffn = (const float*)d_in[2]; p.a_w_qkv = (const float*)d_in[3]; p.a_q_gain = (const float*)d_in[4];
  p.a_k_gain = (const float*)d_in[5]; p.a_w_o = (const float*)d_in[6]; p.b_w_in = (const float*)d_in[7]; p.b_q_a_gain = (const float*)d_in[8]; p.b_w_qb = (const float*)d_in[9];
  p.b_kv_a_gain = (const float*)d_in[10]; p.b_w_kvb = (const float*)d_in[11]; p.b_q_gain = (const float*)d_in[12]; p.b_k_gain = (const float*)d_in[13]; p.b_w_o = (const float*)d_in[14];
  p.ffn_w1 = (const float*)d_in[15]; p.ffn_w2 = (const float*)d_in[16]; p.out = (float*)d_out; p.ws = (unsigned char*)d_ws;
  if (hipMemsetAsync((char*)d_ws + WS_BAR, 0, BAR_ZERO_BYTES, stream) != hipSuccess) { fprintf(stderr, "kernel_launch: memset failed\n"); return; }
  void* args[] = {&p};
  hipError_t e = hipLaunchCooperativeKernel((const void*)fwd_megakernel, dim3(grid_blocks), dim3(NTHR), args, LDS_BYTES, stream);
  if (e != hipSuccess) fprintf(stderr, "kernel_launch: cooperative launch failed: %s (grid %d)\n", hipGetErrorString(e), grid_blocks);
}
```
